# Optimizing an MI355X kernel written in HIP

```python
import math
import jax, jax.numpy as jnp
from jax import lax
import numpy as np

D_MODEL = 2048
BATCH = 4
SEQ = 4096
DEPTH = 2

GDN_QK_HEADS = 8
GDN_V_HEADS = 16
GDN_HEAD_DIM = 128
GDN_CONV = 4
GDN_CHUNK = 64
SWA_Q_HEADS = 32
SWA_KV_HEADS = 4
SWA_HEAD_DIM = 64
SWA_WINDOW = 128
REL_BUCKETS = 32
REL_MAX_DIST = 128
D_FF_DENSE = 128 * ((8 * D_MODEL // 3 + 127) // 128)
N_EXPERTS = 8
TOP_K = 2
D_FF_EXPERT = 7 * D_MODEL // 2
MOE_BLOCK = 256
NORM_EPS = 1e-6

GDN_KEY_DIM = GDN_QK_HEADS * GDN_HEAD_DIM
GDN_VAL_DIM = GDN_V_HEADS * GDN_HEAD_DIM
GDN_CONV_DIM = 2 * GDN_KEY_DIM + GDN_VAL_DIM
SWA_Q_DIM = SWA_Q_HEADS * SWA_HEAD_DIM
SWA_KV_DIM = SWA_KV_HEADS * SWA_HEAD_DIM
IN_SIZES = (GDN_KEY_DIM, GDN_KEY_DIM, GDN_VAL_DIM, GDN_VAL_DIM, GDN_V_HEADS, GDN_V_HEADS,
            SWA_Q_DIM, SWA_KV_DIM, SWA_KV_DIM, D_MODEL, D_MODEL)
D_IN = sum(IN_SIZES)

kernel_name = "hybrid_gdn_swa_sink_moe_block"


def rmsnorm(x, g):
    x32 = x.astype(jnp.float32)
    y = x32 * lax.rsqrt(jnp.mean(x32 * x32, axis=-1, keepdims=True) + NORM_EPS)
    return (y * g.astype(jnp.float32)).astype(x.dtype)


def l2norm(t):
    return t * lax.rsqrt(jnp.sum(t * t, axis=-1, keepdims=True) + 1e-6)


def causal_conv_silu(u, w):
    K = w.shape[0]
    S = u.shape[1]
    up = jnp.pad(u, ((0, 0), (K - 1, 0), (0, 0)))
    y = up[:, 0:S] * w[0]
    for j in range(1, K):
        y = y + up[:, j:j + S] * w[j]
    return jax.nn.silu(y)


def gated_delta_rule(q, k, v, g, beta):
    B, S, H, dk = q.shape
    dv = v.shape[-1]
    C = GDN_CHUNK
    N = S // C

    def chunks(t):
        return t.reshape(B, N, C, H, -1).transpose(1, 0, 3, 2, 4)

    qc, kc, vc = chunks(q), chunks(k), chunks(v)
    gc = jnp.cumsum(chunks(g[..., None])[..., 0], axis=-1)
    bc = chunks(beta[..., None])
    causal = jnp.tril(jnp.ones((C, C), bool))
    strict = jnp.tril(jnp.ones((C, C), bool), -1)
    decay = jnp.exp(jnp.where(causal, gc[..., :, None] - gc[..., None, :], -jnp.inf))
    kb = kc * bc
    vb = vc * bc
    a_mat = jnp.where(strict, jnp.einsum('nbhcd,nbhsd->nbhcs', kb, kc) * decay, 0.0) + jnp.eye(C, dtype=q.dtype)
    rhs = jnp.concatenate([vb, kb * jnp.exp(gc)[..., None]], axis=-1)
    sol = lax.linalg.triangular_solve(a_mat, rhs, left_side=True, lower=True)
    u, w = sol[..., :dv], sol[..., dv:]
    qk = jnp.einsum('nbhcd,nbhsd->nbhcs', qc, kc) * decay
    q_dec = qc * jnp.exp(gc)[..., None]
    k_dec = kc * jnp.exp(gc[..., -1:] - gc)[..., None]
    g_last = jnp.exp(gc[..., -1])

    def step(state, xs):
        u_n, w_n, qk_n, q_n, k_n, gl_n = xs
        v_new = u_n - jnp.einsum('bhcd,bhde->bhce', w_n, state)
        o = jnp.einsum('bhcd,bhde->bhce', q_n, state) + jnp.einsum('bhcs,bhse->bhce', qk_n, v_new)
        state = state * gl_n[..., None, None] + jnp.einsum('bhcd,bhce->bhde', k_n, v_new)
        return state, o

    s0 = jnp.zeros((B, H, dk, dv), q.dtype)
    _, o = lax.scan(step, s0, (u, w, qk, q_dec, k_dec, g_last))
    return o.transpose(1, 0, 3, 2, 4).reshape(B, S, H, dv)


def t5_bucket(dist):
    max_exact = REL_BUCKETS // 2
    large = max_exact + (jnp.log(jnp.maximum(dist, 1).astype(jnp.float32) / max_exact)
                         / math.log(REL_MAX_DIST / max_exact) * (REL_BUCKETS - max_exact)).astype(jnp.int32)
    large = jnp.minimum(large, REL_BUCKETS - 1)
    return jnp.where(dist < max_exact, dist, large)


def sliding_window_sink_attention(q, k, v, sinks, rel_bias):
    B, S, Hq, dh = q.shape
    Hkv = k.shape[2]
    G = Hq // Hkv
    W = SWA_WINDOW
    NB = S // W
    qb = q.reshape(B, NB, W, Hkv, G, dh)

    def band(t):
        cur = t.reshape(B, NB, W, Hkv, dh)
        prev = jnp.pad(t, ((0, 0), (W, 0), (0, 0), (0, 0)))[:, :S].reshape(B, NB, W, Hkv, dh)
        return jnp.concatenate([prev, cur], axis=2)

    kb, vb = band(k), band(v)
    logits = jnp.einsum('bnqhgd,bnkhd->bhgnqk', qb, kb).astype(jnp.float32) * (dh ** -0.5)
    qi = jnp.arange(W)[:, None]
    ki = jnp.arange(2 * W)[None, :]
    dist = qi + W - ki
    in_window = (dist >= 0) & (dist < W)
    valid = in_window[None] & ((jnp.arange(NB)[:, None, None] > 0) | (ki >= W)[None])
    bias = rel_bias.astype(jnp.float32)[t5_bucket(jnp.clip(dist, 0, W - 1))]
    bias = bias.transpose(2, 0, 1).reshape(Hkv, G, 1, W, 2 * W)
    logits = jnp.where(valid, logits + bias, -jnp.inf)
    sink = sinks.astype(jnp.float32).reshape(Hkv, G, 1, 1, 1)
    m = jnp.maximum(jnp.max(logits, axis=-1, keepdims=True), sink)
    p = jnp.exp(logits - m)
    probs = p / (jnp.sum(p, axis=-1, keepdims=True) + jnp.exp(sink - m))
    out = jnp.einsum('bhgnqk,bnkhd->bnqhgd', probs.astype(v.dtype), vb)
    return out.reshape(B, S, Hq * dh)


def swiglu(h, w_gate, w_up, w_down):
    return (jax.nn.silu(h @ w_gate) * (h @ w_up)) @ w_down


def moe_swiglu(h, router_w, w_gate, w_up, w_down):
    B, S, D = h.shape
    T = B * S
    TK = T * TOP_K
    ht = h.reshape(T, D)
    logits = (ht @ router_w).astype(jnp.float32)
    top_logit, top_e = lax.top_k(logits, TOP_K)
    top_w = jax.nn.softmax(top_logit, axis=-1).astype(h.dtype)
    flat_e = top_e.reshape(TK).astype(jnp.int32)
    order = jnp.argsort(flat_e).astype(jnp.int32)
    sorted_e = flat_e[order]
    sorted_tok = order // TOP_K
    counts = jnp.bincount(flat_e, length=N_EXPERTS).astype(jnp.int32)
    padded = (counts + MOE_BLOCK - 1) // MOE_BLOCK * MOE_BLOCK
    start = jnp.cumsum(counts) - counts
    pad_end = jnp.cumsum(padded)
    pad_start = pad_end - padded
    dest = pad_start[sorted_e] + jnp.arange(TK, dtype=jnp.int32) - start[sorted_e]
    n_rows = TK + N_EXPERTS * MOE_BLOCK
    n_blocks = n_rows // MOE_BLOCK
    row_tok = jnp.full((n_rows,), T, jnp.int32).at[dest].set(sorted_tok)
    xg = jnp.concatenate([ht, jnp.zeros((1, D), ht.dtype)], axis=0)[row_tok]
    block_e = jnp.minimum(jnp.searchsorted(pad_end, jnp.arange(n_blocks, dtype=jnp.int32) * MOE_BLOCK,
                                           side='right'), N_EXPERTS - 1).astype(jnp.int32)

    def expert_block(args):
        xb, e = args
        return swiglu(xb, w_gate[e], w_up[e], w_down[e])

    yg = lax.map(expert_block, (xg.reshape(n_blocks, MOE_BLOCK, D), block_e)).reshape(n_rows, D)
    dest_tok = jnp.zeros((TK,), jnp.int32).at[order].set(dest)
    y = jnp.einsum('tkd,tk->td', yg[dest_tok].reshape(T, TOP_K, D), top_w)
    return y.reshape(B, S, D)


def setup_inputs(seed: int = 0) -> dict:
    key = jax.random.key(seed)
    ks = jax.random.split(key, 24)
    f32 = jnp.float32
    L = DEPTH
    Ld = (DEPTH + 1) // 2
    Lm = DEPTH // 2

    def nrm(k, shape, fan_in):
        return jax.random.normal(k, shape, f32) * (fan_in ** -0.5)

    def gain(k, shape):
        return 1.0 + 0.02 * jax.random.normal(k, shape, f32)

    dt = jnp.exp(jax.random.uniform(ks[5], (L, GDN_V_HEADS), f32, math.log(1e-3), math.log(1e-1)))
    return {
        "x": jax.random.normal(ks[0], (BATCH, SEQ, D_MODEL), f32),
        "ln_mix_g": gain(ks[1], (L, D_MODEL)),
        "w_in": nrm(ks[2], (L, D_MODEL, D_IN), D_MODEL),
        "conv_w": nrm(ks[3], (L, GDN_CONV, GDN_CONV_DIM), GDN_CONV),
        "a_log": jnp.log(jax.random.uniform(ks[4], (L, GDN_V_HEADS), f32, 1.0, 16.0)),
        "dt_bias": dt + jnp.log(-jnp.expm1(-dt)),
        "gdn_norm_g": gain(ks[6], (L, GDN_HEAD_DIM)),
        "sinks": jax.random.normal(ks[7], (L, SWA_Q_HEADS), f32),
        "rel_bias": 0.5 * jax.random.normal(ks[8], (REL_BUCKETS, SWA_Q_HEADS), f32),
        "w_proj_gdn": nrm(ks[9], (L, GDN_VAL_DIM, D_MODEL), GDN_VAL_DIM),
        "w_proj_swa": nrm(ks[10], (L, SWA_Q_DIM, D_MODEL), SWA_Q_DIM),
        "w_out": nrm(ks[11], (L, D_MODEL, D_MODEL), D_MODEL),
        "ln_ffn_g": gain(ks[12], (L, D_MODEL)),
        "ffn_w_gate": nrm(ks[13], (Ld, D_MODEL, D_FF_DENSE), D_MODEL),
        "ffn_w_up": nrm(ks[14], (Ld, D_MODEL, D_FF_DENSE), D_MODEL),
        "ffn_w_down": nrm(ks[15], (Ld, D_FF_DENSE, D_MODEL), D_FF_DENSE),
        "router_w": nrm(ks[16], (Lm, D_MODEL, N_EXPERTS), D_MODEL),
        "moe_w_gate": nrm(ks[17], (Lm, N_EXPERTS, D_MODEL, D_FF_EXPERT), D_MODEL),
        "moe_w_up": nrm(ks[18], (Lm, N_EXPERTS, D_MODEL, D_FF_EXPERT), D_MODEL),
        "moe_w_down": nrm(ks[19], (Lm, N_EXPERTS, D_FF_EXPERT, D_MODEL), D_FF_EXPERT),
        "ln_final_g": gain(ks[20], (D_MODEL,)),
    }


def reference(x, ln_mix_g, w_in, conv_w, a_log, dt_bias, gdn_norm_g, sinks, rel_bias,
              w_proj_gdn, w_proj_swa, w_out, ln_ffn_g, ffn_w_gate, ffn_w_up, ffn_w_down,
              router_w, moe_w_gate, moe_w_up, moe_w_down, ln_final_g):
    B, S, _ = x.shape
    f32 = jnp.float32
    splits = np.cumsum(IN_SIZES)[:-1].tolist()
    rep = GDN_V_HEADS // GDN_QK_HEADS
    for i in range(DEPTH):
        h = rmsnorm(x, ln_mix_g[i])
        proj = h @ w_in[i]
        q, k, v, z, b, a, sq, sk, sv, gate_a, gate_b = jnp.split(proj, splits, axis=-1)

        qkv = causal_conv_silu(jnp.concatenate([q, k, v], axis=-1), conv_w[i]).astype(f32)
        gq, gk, gv = jnp.split(qkv, [GDN_KEY_DIM, 2 * GDN_KEY_DIM], axis=-1)
        gq = jnp.repeat(l2norm(gq.reshape(B, S, GDN_QK_HEADS, GDN_HEAD_DIM)), rep, axis=2) * (GDN_HEAD_DIM ** -0.5)
        gk = jnp.repeat(l2norm(gk.reshape(B, S, GDN_QK_HEADS, GDN_HEAD_DIM)), rep, axis=2)
        gv = gv.reshape(B, S, GDN_V_HEADS, GDN_HEAD_DIM)
        beta = jax.nn.sigmoid(b.astype(f32))
        g = -jnp.exp(a_log[i].astype(f32)) * jax.nn.softplus(a.astype(f32) + dt_bias[i].astype(f32))
        o_a = gated_delta_rule(gq, gk, gv, g, beta)
        o_a = o_a * lax.rsqrt(jnp.mean(o_a * o_a, axis=-1, keepdims=True) + NORM_EPS) * gdn_norm_g[i].astype(f32)
        o_a = o_a * jax.nn.silu(z.astype(f32).reshape(B, S, GDN_V_HEADS, GDN_HEAD_DIM))
        o_a = o_a.reshape(B, S, GDN_VAL_DIM).astype(x.dtype)

        o_b = sliding_window_sink_attention(sq.reshape(B, S, SWA_Q_HEADS, SWA_HEAD_DIM),
                                            sk.reshape(B, S, SWA_KV_HEADS, SWA_HEAD_DIM),
                                            sv.reshape(B, S, SWA_KV_HEADS, SWA_HEAD_DIM),
                                            sinks[i], rel_bias)

        y = jax.nn.sigmoid(gate_a) * (o_a @ w_proj_gdn[i]) + jax.nn.sigmoid(gate_b) * (o_b @ w_proj_swa[i])
        x = x + y @ w_out[i]

        h = rmsnorm(x, ln_ffn_g[i])
        j = i // 2
        if i % 2 == 0:
            x = x + swiglu(h, ffn_w_gate[j], ffn_w_up[j], ffn_w_down[j])
        else:
            x = x + moe_swiglu(h, router_w[j], moe_w_gate[j], moe_w_up[j], moe_w_down[j])
    return rmsnorm(x, ln_final_g)
```

```cpp
#include <hip/hip_runtime.h>
#include <cstdio>
#include <cstdint>

#ifndef MK_ONE_LAUNCH
#define MK_ONE_LAUNCH 1
#endif
#ifndef PROBE_PHASE
#define PROBE_PHASE -1
#endif
#ifndef DUPMASK
#define DUPMASK 0
#endif
#define DUP(k, call) do { call; if ((DUPMASK >> (k)) & 1) { call; } } while (0)

namespace pg8 {
#define PG8_LAS __attribute__((address_space(3)))
typedef unsigned short bf16_t;
typedef short bf16x8 __attribute__((ext_vector_type(8)));
typedef float f32x4 __attribute__((ext_vector_type(4)));
typedef float f32x2 __attribute__((ext_vector_type(2)));
typedef unsigned u32x4 __attribute__((ext_vector_type(4)));
typedef unsigned u32x2 __attribute__((ext_vector_type(2)));
typedef __bf16 bfx2_t __attribute__((ext_vector_type(2)));
typedef int i32x8 __attribute__((ext_vector_type(8)));
typedef int i32x4v __attribute__((ext_vector_type(4)));
constexpr int BM = 256, BK = 64, HALF = 128, HTB = HALF * BK * 2, STAGE_BYTES = 8 * HTB, NXCD = 8, WGM = 8;

__host__ __device__ __forceinline__ int lds_byte(int r, int c) { const int st = (r >> 4) * 2 + (c >> 5), rr = r & 15, cc = c & 31, ob = rr * 64 + cc * 2; return st * 1024 + (ob ^ (((ob >> 9) & 1) << 5)); }
__host__ __device__ __forceinline__ void stage_rc(int b, int& R, int& C) { const int st = b / 1024, sb = b % 1024, swz = sb ^ (((sb >> 9) & 1) << 5); R = (st >> 1) * 16 + swz / 64; C = (st & 1) * 32 + (swz % 64) / 2; }
__host__ __device__ __forceinline__ int perm32(int rho) { const int n = rho >> 4, i = rho & 15; return 8 * (i >> 2) + 4 * n + (i & 3); }

__device__ __forceinline__ unsigned pk2(float lo, float hi) { f32x2 v = {lo, hi}; return __builtin_bit_cast(unsigned, __builtin_convertvector(v, bfx2_t)); }
__device__ __forceinline__ float bflo(unsigned w) { return __builtin_bit_cast(float, w << 16); }
__device__ __forceinline__ float bfhi(unsigned w) { return __builtin_bit_cast(float, w & 0xffff0000u); }
__device__ __forceinline__ float fsigmoid(float x) { return __builtin_amdgcn_rcpf(1.0f + __expf(-x)); }

__device__ __forceinline__ unsigned pk4_fp8(float a, float b, float c, float d) { unsigned w = 0; w = __builtin_amdgcn_cvt_pk_fp8_f32(a, b, w, false); w = __builtin_amdgcn_cvt_pk_fp8_f32(c, d, w, true); return w; }
struct Unit { int pm, pn, pnb; };
struct Gemm { const bf16_t* A; const bf16_t* Bt; int M, N, K; };

struct StaticOrder {
    int nM, nN, nwg, G, c;
    __host__ __device__ void init(int M, int N, int G_, int c_) { nM = M / BM; nN = N / BM; nwg = nM * nN; G = G_; c = c_; }
    __host__ __device__ bool next(int i, Unit& u) const {
        const long L = (long)i * G + c; if (L >= nwg) return false;
        int wgid = (int)L; { const int q = nwg / NXCD, r = nwg % NXCD, xcd = wgid % NXCD, off = wgid / NXCD; wgid = (xcd < r ? xcd * (q + 1) : r * (q + 1) + (xcd - r) * q) + off; }
        const int nig = WGM * nN, gid = wgid / nig, fm = gid * WGM, gsz = (nM - fm) < WGM ? (nM - fm) : WGM;
        u.pm = fm + ((wgid % nig) % gsz); u.pn = (wgid % nig) / gsz; u.pnb = u.pn; return true;
    }
    __device__ __forceinline__ void a_ready(const Unit&) const {}
    __device__ __forceinline__ void done(const Unit&) const {}
};
struct MoeOrder {
    int G, c, nN; const PG8_LAS int* tab;
    __device__ __forceinline__ void init(const unsigned* cnt, int nN_, int G_, int c_, PG8_LAS int* tab_) {
        G = G_; c = c_; nN = nN_; tab = tab_;
        if (threadIdx.x == 0) { int us = 0, bs = 0; tab_[0] = 0; tab_[16] = 0;
            for (int e = 0; e < 8; ++e) { const int nb = (int)((cnt[e] + 255u) >> 8); bs += nb; us += nb * nN_; tab_[e + 1] = us; tab_[17 + e] = bs; } }
        __syncthreads();
    }
    __device__ __forceinline__ bool next(int i, Unit& u) const {
        const int L = i * G + c; if (L >= tab[8]) return false;
        int e = 0;
#pragma unroll
        for (int k = 1; k < 8; ++k) e += (L >= tab[k]) ? 1 : 0;
        const int us = tab[e], bs = tab[16 + e], nbe = tab[17 + e] - bs;
        const int r = L - us, pn = r / nbe, blk = r - pn * nbe;
        u.pm = __builtin_amdgcn_readfirstlane(bs + blk); u.pn = __builtin_amdgcn_readfirstlane(pn); u.pnb = __builtin_amdgcn_readfirstlane(e * nN + pn); return true;
    }
    __device__ __forceinline__ void a_ready(const Unit&) const {}
    __device__ __forceinline__ void done(const Unit&) const {}
};

struct EpiStoreBf16 {
    static constexpr bool PERM = true, AFTER_DRAIN = false;
    bf16_t* O; int ldc;
    __device__ __forceinline__ void operator()(const f32x4 (&acc)[2][2][4][2], const Unit& u, int wr, int wc, int fr, int fq) const {
        const int row0 = u.pm * BM + wr * 64 + fr, col0 = u.pn * BM + wc * 32 + 8 * fq;
#pragma unroll
        for (int ai = 0; ai < 2; ++ai)
#pragma unroll
            for (int m = 0; m < 4; ++m) { bf16_t* rowp = O + (size_t)(row0 + ai * HALF + m * 16) * ldc + col0;
#pragma unroll
                for (int bj = 0; bj < 2; ++bj) { const f32x4 v0 = acc[ai][bj][m][0], v1 = acc[ai][bj][m][1];
                    u32x4 w; w.x = pk2(v0[0], v0[1]); w.y = pk2(v0[2], v0[3]); w.z = pk2(v1[0], v1[1]); w.w = pk2(v1[2], v1[3]);
                    *(u32x4*)(rowp + bj * HALF) = w; } }
    }
};
struct EpiStoreBf16I8 {
    static constexpr bool PERM = true, AFTER_DRAIN = false;
    bf16_t* O; int ldc; const float* rs; const float* cs;
    __device__ __forceinline__ void operator()(const f32x4 (&acc)[2][2][4][2], const Unit& u, int wr, int wc, int fr, int fq) const {
        const int row0 = u.pm * BM + wr * 64 + fr, col0 = u.pn * BM + wc * 32 + 8 * fq;
        f32x4 cv[2][2];
#pragma unroll
        for (int bj = 0; bj < 2; ++bj)
#pragma unroll
            for (int n = 0; n < 2; ++n) cv[bj][n] = *(const f32x4*)(cs + col0 + bj * HALF + 4 * n);
        float rsv[2][4];
#pragma unroll
        for (int ai = 0; ai < 2; ++ai)
#pragma unroll
            for (int m = 0; m < 4; ++m) rsv[ai][m] = rs[row0 + ai * HALF + m * 16];
#pragma unroll
        for (int ai = 0; ai < 2; ++ai)
#pragma unroll
            for (int m = 0; m < 4; ++m) { const int row = row0 + ai * HALF + m * 16; const float r = rsv[ai][m]; bf16_t* rowp = O + (size_t)row * ldc + col0;
#pragma unroll
                for (int bj = 0; bj < 2; ++bj) { const i32x4v a0 = __builtin_bit_cast(i32x4v, acc[ai][bj][m][0]), a1 = __builtin_bit_cast(i32x4v, acc[ai][bj][m][1]);
                    const f32x4 v0 = __builtin_convertvector(a0, f32x4) * cv[bj][0] * r, v1 = __builtin_convertvector(a1, f32x4) * cv[bj][1] * r;
                    u32x4 w; w.x = pk2(v0[0], v0[1]); w.y = pk2(v0[2], v0[3]); w.z = pk2(v1[0], v1[1]); w.w = pk2(v1[2], v1[3]);
                    *(u32x4*)(rowp + bj * HALF) = w; } }
    }
};
struct EpiSwiGLUF8 {
    static constexpr bool PERM = true, AFTER_DRAIN = false;
    unsigned char* Hd; int ldc; float osc;
    __device__ __forceinline__ void operator()(const f32x4 (&acc)[2][2][4][2], const Unit& u, int wr, int wc, int fr, int fq) const {
        const int row0 = u.pm * BM + wr * 64 + fr, col0 = u.pn * HALF + wc * 32 + 8 * fq;
#pragma unroll
        for (int ai = 0; ai < 2; ++ai)
#pragma unroll
            for (int m = 0; m < 4; ++m) { unsigned char* rowp = Hd + (size_t)(row0 + ai * HALF + m * 16) * ldc + col0;
                float o[8];
#pragma unroll
                for (int n = 0; n < 2; ++n)
#pragma unroll
                    for (int i = 0; i < 4; ++i) { const float g = acc[ai][0][m][n][i], up = acc[ai][1][m][n][i]; o[4 * n + i] = g * up * fsigmoid(g) * osc; }
                u32x2 w; w.x = pk4_fp8(o[0], o[1], o[2], o[3]); w.y = pk4_fp8(o[4], o[5], o[6], o[7]);
                *(u32x2*)rowp = w; }
    }
};
template <bool OUTF8> struct EpiSwiGLUI8 {
    static constexpr bool PERM = true, AFTER_DRAIN = false;
    void* Hd; int ldc; const float* rs; const float* cs; float osc;
    __device__ __forceinline__ void operator()(const f32x4 (&acc)[2][2][4][2], const Unit& u, int wr, int wc, int fr, int fq) const {
        const int row0 = u.pm * BM + wr * 64 + fr, col0 = u.pn * HALF + wc * 32 + 8 * fq, ccol = u.pnb * BM + wc * 32 + 8 * fq;
        f32x4 cv[2][2]; float rsv[2][4];
#pragma unroll
        for (int bj = 0; bj < 2; ++bj)
#pragma unroll
            for (int n = 0; n < 2; ++n) cv[bj][n] = *(const f32x4*)(cs + ccol + bj * HALF + 4 * n);
#pragma unroll
        for (int ai = 0; ai < 2; ++ai)
#pragma unroll
            for (int m = 0; m < 4; ++m) rsv[ai][m] = rs[row0 + ai * HALF + m * 16];
#pragma unroll
        for (int ai = 0; ai < 2; ++ai)
#pragma unroll
            for (int m = 0; m < 4; ++m) { const int row = row0 + ai * HALF + m * 16; const float r = rsv[ai][m];
                float o[8];
#pragma unroll
                for (int n = 0; n < 2; ++n) { const f32x4 gv = __builtin_convertvector(__builtin_bit_cast(i32x4v, acc[ai][0][m][n]), f32x4) * cv[0][n] * r, uv = __builtin_convertvector(__builtin_bit_cast(i32x4v, acc[ai][1][m][n]), f32x4) * cv[1][n] * r;
#pragma unroll
                    for (int i = 0; i < 4; ++i) o[4 * n + i] = gv[i] * uv[i] * fsigmoid(gv[i]); }
                if constexpr (OUTF8) { u32x2 w; w.x = pk4_fp8(o[0] * osc, o[1] * osc, o[2] * osc, o[3] * osc); w.y = pk4_fp8(o[4] * osc, o[5] * osc, o[6] * osc, o[7] * osc);
                    *(u32x2*)((unsigned char*)Hd + (size_t)row * ldc + col0) = w; }
                else { u32x4 w; w.x = pk2(o[0], o[1]); w.y = pk2(o[2], o[3]); w.z = pk2(o[4], o[5]); w.w = pk2(o[6], o[7]); *(u32x4*)((bf16_t*)Hd + (size_t)row * ldc + col0) = w; } }
    }
};
struct EpiResF32 {
    static constexpr bool PERM = false, AFTER_DRAIN = false;
    const float* base; float* out; int ldc;
    __device__ __forceinline__ void operator()(const f32x4 (&acc)[2][2][4][2], const Unit& u, int wr, int wc, int fr, int fq) const {
        const int row0 = u.pm * BM + wr * 64 + fr, col0 = u.pn * BM + wc * 32 + 4 * fq;
#pragma unroll
        for (int ai = 0; ai < 2; ++ai) {
            f32x4 b[4][2][2];
#pragma unroll
            for (int m = 0; m < 4; ++m) { const size_t off = (size_t)(row0 + ai * HALF + m * 16) * ldc + col0;
#pragma unroll
                for (int bj = 0; bj < 2; ++bj)
#pragma unroll
                    for (int n = 0; n < 2; ++n) b[m][bj][n] = *(const f32x4*)(base + off + bj * HALF + n * 16); }
            asm volatile("" ::: "memory");
#pragma unroll
            for (int m = 0; m < 4; ++m) { const size_t off = (size_t)(row0 + ai * HALF + m * 16) * ldc + col0;
#pragma unroll
                for (int bj = 0; bj < 2; ++bj)
#pragma unroll
                    for (int n = 0; n < 2; ++n) *(f32x4*)(out + off + bj * HALF + n * 16) = b[m][bj][n] + acc[ai][bj][m][n]; }
            asm volatile("" ::: "memory");
        }
    }
};
struct EpiGateA {
    static constexpr bool PERM = true, AFTER_DRAIN = false;
    bf16_t* Y; int ldc; const bf16_t* gate; int ldg;
    __device__ __forceinline__ void operator()(const f32x4 (&acc)[2][2][4][2], const Unit& u, int wr, int wc, int fr, int fq) const {
        const int row0 = u.pm * BM + wr * 64 + fr, col0 = u.pn * BM + wc * 32 + 8 * fq;
        u32x4 gws[2][4][2];
#pragma unroll
        for (int ai = 0; ai < 2; ++ai)
#pragma unroll
            for (int m = 0; m < 4; ++m)
#pragma unroll
                for (int bj = 0; bj < 2; ++bj) gws[ai][m][bj] = *(const u32x4*)(gate + (size_t)(row0 + ai * HALF + m * 16) * ldg + col0 + bj * HALF);
        asm volatile("" ::: "memory");
#pragma unroll
        for (int ai = 0; ai < 2; ++ai)
#pragma unroll
            for (int m = 0; m < 4; ++m) { const int row = row0 + ai * HALF + m * 16;
#pragma unroll
                for (int bj = 0; bj < 2; ++bj) { const u32x4 gw = gws[ai][m][bj];
                    const f32x4 v0 = acc[ai][bj][m][0], v1 = acc[ai][bj][m][1];
                    u32x4 w;
                    w.x = pk2(v0[0] * fsigmoid(bflo(gw.x)), v0[1] * fsigmoid(bfhi(gw.x))); w.y = pk2(v0[2] * fsigmoid(bflo(gw.y)), v0[3] * fsigmoid(bfhi(gw.y)));
                    w.z = pk2(v1[0] * fsigmoid(bflo(gw.z)), v1[1] * fsigmoid(bfhi(gw.z))); w.w = pk2(v1[2] * fsigmoid(bflo(gw.w)), v1[3] * fsigmoid(bfhi(gw.w)));
                    *(u32x4*)(Y + (size_t)row * ldc + col0 + bj * HALF) = w; } }
    }
};
struct EpiGateB {
    static constexpr bool PERM = true, AFTER_DRAIN = false;
    bf16_t* Y; int ldc; const bf16_t* gate; int ldg;
    __device__ __forceinline__ void operator()(const f32x4 (&acc)[2][2][4][2], const Unit& u, int wr, int wc, int fr, int fq) const {
        const int row0 = u.pm * BM + wr * 64 + fr, col0 = u.pn * BM + wc * 32 + 8 * fq;
#pragma unroll
        for (int ai = 0; ai < 2; ++ai) {
            u32x4 gws[4][2], pp[4][2];
#pragma unroll
            for (int m = 0; m < 4; ++m)
#pragma unroll
                for (int bj = 0; bj < 2; ++bj) { const int row = row0 + ai * HALF + m * 16; gws[m][bj] = *(const u32x4*)(gate + (size_t)row * ldg + col0 + bj * HALF); pp[m][bj] = *(const u32x4*)(Y + (size_t)row * ldc + col0 + bj * HALF); }
            asm volatile("" ::: "memory");
#pragma unroll
            for (int m = 0; m < 4; ++m) { const int row = row0 + ai * HALF + m * 16;
#pragma unroll
                for (int bj = 0; bj < 2; ++bj) { const u32x4 gw = gws[m][bj], p = pp[m][bj];
                    const f32x4 v0 = acc[ai][bj][m][0], v1 = acc[ai][bj][m][1];
                    u32x4 w;
                    w.x = pk2(bflo(p.x) + v0[0] * fsigmoid(bflo(gw.x)), bfhi(p.x) + v0[1] * fsigmoid(bfhi(gw.x))); w.y = pk2(bflo(p.y) + v0[2] * fsigmoid(bflo(gw.y)), bfhi(p.y) + v0[3] * fsigmoid(bfhi(gw.y)));
                    w.z = pk2(bflo(p.z) + v1[0] * fsigmoid(bflo(gw.z)), bfhi(p.z) + v1[1] * fsigmoid(bfhi(gw.z))); w.w = pk2(bflo(p.w) + v1[2] * fsigmoid(bflo(gw.w)), bfhi(p.w) + v1[3] * fsigmoid(bfhi(gw.w)));
                    *(u32x4*)(Y + (size_t)row * ldc + col0 + bj * HALF) = w; } }
            asm volatile("" ::: "memory");
        }
    }
};

template <class Epi, class Sched, bool ALIGN_EPI = false, bool SP2 = false, int MODE = 0  >
__device__ __forceinline__ void gemm_phase(PG8_LAS unsigned char* lds, const Gemm g, const Sched& S, const Epi& E, const int sw = 0x7f7f7f7f, const int sa = 0x7f7f7f7f) {
    constexpr bool F8 = (MODE == 1);
    const int tid = threadIdx.x, wid = __builtin_amdgcn_readfirstlane(tid >> 6), lane = tid & 63, wr = wid >> 2, wc = wid & 3, fr = lane & 15, fq = lane >> 4;
    const int K = g.K, nt = K / BK;
    unsigned voffA, voffB;
    { int R, C; stage_rc(tid * 16, R, C); const int Rb = Epi::PERM ? ((R & ~31) + perm32(R & 31)) : R;
      voffA = (unsigned)(R * K + C) * 2u; voffB = (unsigned)(Rb * K + C) * 2u; }
    const unsigned rstep = 64u * (unsigned)K * 2u;
    const unsigned kstep = (unsigned)(BK * 2);
    const unsigned hstep = (unsigned)HALF * (unsigned)K * 2u;
    const unsigned tstep = 2u * hstep;
    const __amdgpu_buffer_rsrc_t rsA = __builtin_amdgcn_make_buffer_rsrc((void*)g.A, 0, 0xFFFFFFFF, 0x00020000), rsB = __builtin_amdgcn_make_buffer_rsrc((void*)g.Bt, 0, 0xFFFFFFFF, 0x00020000);
    const unsigned ldsw = (unsigned)wid * 1024u;
    const int aoff = lds_byte(wr * 64 + fr, fq * 8), boff = lds_byte(wc * 32 + fr, fq * 8);
#define PG8_SA(b, h) (((b) * 2 + (h)) * HTB)
#define PG8_SB(b, h) ((4 + (b) * 2 + (h)) * HTB)
#define PG8_STAGE(bufoff, rs, soff, voff) do { _Pragma("unroll") for (int _i = 0; _i < 2; ++_i) \
        __builtin_amdgcn_raw_ptr_buffer_load_lds(rs, (PG8_LAS void*)(lds + (bufoff) + ldsw + _i * 8192), 16, (int)(voff), (int)((soff) + _i * rstep), 0, 0); } while (0)
#define PG8_LD8(p_) __builtin_shufflevector(*(const PG8_LAS i32x4v*)(p_), *(const PG8_LAS i32x4v*)((p_) + 1024), 0, 1, 2, 3, 4, 5, 6, 7)
#define PG8_LDA(dst, b, h) do { _Pragma("unroll") for (int m = 0; m < 4; ++m) { if constexpr (F8) dst##8[m] = PG8_LD8(lds + PG8_SA(b, h) + aoff + m * 2048); \
        else { _Pragma("unroll") for (int k = 0; k < 2; ++k) dst[m][k] = *(const PG8_LAS bf16x8*)(lds + PG8_SA(b, h) + aoff + m * 2048 + k * 1024); } } } while (0)
#define PG8_LDB(dst, b, h) do { _Pragma("unroll") for (int n = 0; n < 2; ++n) { if constexpr (F8) dst##8[n] = PG8_LD8(lds + PG8_SB(b, h) + boff + n * 2048); \
        else { _Pragma("unroll") for (int k = 0; k < 2; ++k) dst[n][k] = *(const PG8_LAS bf16x8*)(lds + PG8_SB(b, h) + boff + n * 2048 + k * 1024); } } } while (0)
#define PG8_CAT(x0, x1) __builtin_shufflevector(__builtin_bit_cast(i32x4v, x0), __builtin_bit_cast(i32x4v, x1), 0, 1, 2, 3, 4, 5, 6, 7)
#define PG8_MMA(ai, bj, At, Bt) do { __builtin_amdgcn_s_setprio(1); _Pragma("unroll") for (int m = 0; m < 4; ++m) _Pragma("unroll") for (int n = 0; n < 2; ++n) { \
        if constexpr (F8) acc[ai][bj][m][n] = __builtin_amdgcn_mfma_scale_f32_16x16x128_f8f6f4(Bt##8[n], At##8[m], acc[ai][bj][m][n], 0, 0, 0, sw, 0, sa); \
        else if constexpr (MODE == 2) { _Pragma("unroll") for (int k = 0; k < 2; ++k) acc[ai][bj][m][n] = __builtin_bit_cast(f32x4, __builtin_amdgcn_mfma_i32_16x16x64_i8(__builtin_bit_cast(i32x4v, Bt[n][k]), __builtin_bit_cast(i32x4v, At[m][k]), __builtin_bit_cast(i32x4v, acc[ai][bj][m][n]), 0, 0, 0)); } \
        else { _Pragma("unroll") for (int k = 0; k < 2; ++k) acc[ai][bj][m][n] = __builtin_amdgcn_mfma_f32_16x16x32_bf16(Bt[n][k], At[m][k], acc[ai][bj][m][n], 0, 0, 0); } } \
        __builtin_amdgcn_s_setprio(0); } while (0)
#define PG8_WAIT_V(n) asm volatile("s_waitcnt vmcnt(" #n ")" ::: "memory")
#define PG8_WAIT_L(n) asm volatile("s_waitcnt lgkmcnt(" #n ")" ::: "memory")
#define PG8_BAR __builtin_amdgcn_s_barrier()
#define PG8_SCHED __builtin_amdgcn_sched_barrier(0)
    Unit cur, nxt; int ui = 0;
    if (!S.next(0, cur)) return;
    f32x4 acc[2][2][4][2];
#pragma unroll
    for (int a = 0; a < 2; ++a)
#pragma unroll
        for (int b = 0; b < 2; ++b)
#pragma unroll
            for (int m = 0; m < 4; ++m)
#pragma unroll
                for (int n = 0; n < 2; ++n) acc[a][b][m][n] = (f32x4){0.f, 0.f, 0.f, 0.f};
    bf16x8 At[4][2], B0[2][2], B1[2][2]; i32x8 At8[4], B08[2], B18[2];
    unsigned cA = (unsigned)cur.pm * tstep, cB = (unsigned)cur.pnb * tstep;
    S.a_ready(cur);
    if constexpr (SP2) {
        PG8_STAGE(PG8_SB(0, 0), rsB, cB, voffB); PG8_STAGE(PG8_SB(0, 1), rsB, cB + hstep, voffB); PG8_STAGE(PG8_SA(0, 0), rsA, cA, voffA); PG8_STAGE(PG8_SA(0, 1), rsA, cA + hstep, voffA);
        if (wr == 1) PG8_BAR;
        PG8_WAIT_V(2); PG8_BAR;
        PG8_STAGE(PG8_SB(1, 0), rsB, cB + kstep, voffB); PG8_STAGE(PG8_SA(1, 0), rsA, cA + kstep, voffA); PG8_STAGE(PG8_SB(1, 1), rsB, cB + hstep + kstep, voffB);
        PG8_WAIT_V(6); PG8_BAR;
    } else {
        PG8_STAGE(PG8_SB(0, 0), rsB, cB, voffB); PG8_STAGE(PG8_SA(0, 0), rsA, cA, voffA); PG8_STAGE(PG8_SB(0, 1), rsB, cB + hstep, voffB); PG8_STAGE(PG8_SA(0, 1), rsA, cA + hstep, voffA);
        if (wr == 1) PG8_BAR;
        PG8_WAIT_V(4); PG8_BAR;
        PG8_STAGE(PG8_SB(1, 0), rsB, cB + kstep, voffB); PG8_STAGE(PG8_SA(1, 0), rsA, cA + kstep, voffA); PG8_STAGE(PG8_SB(1, 1), rsB, cB + hstep + kstep, voffB);
        PG8_WAIT_V(6); PG8_BAR;
    }
    for (;;) {
        const bool has_next = S.next(ui + 1, nxt);
        const unsigned nA = has_next ? (unsigned)nxt.pm * tstep : cA, nB = has_next ? (unsigned)nxt.pnb * tstep : cB;
        for (int t = 0; t < nt; t += 2) {
            const bool last = (t == nt - 2);
            const unsigned a1 = cA + (unsigned)(t + 1) * kstep;
            const unsigned a2 = last ? nA : cA + (unsigned)(t + 2) * kstep, b2 = last ? nB : cB + (unsigned)(t + 2) * kstep;
            const unsigned a3 = a2 + kstep, b3 = b2 + kstep;
            if (last && has_next) S.a_ready(nxt);
            if constexpr (SP2) {
            PG8_LDB(B0, 0, 0); PG8_LDB(B1, 0, 1); PG8_SCHED; PG8_LDA(At, 0, 0); PG8_STAGE(PG8_SA(1, 1), rsA, a1 + hstep, voffA);
            PG8_WAIT_V(8); PG8_WAIT_L(0); PG8_BAR; PG8_MMA(0, 0, At, B0); PG8_MMA(0, 1, At, B1); PG8_BAR; PG8_SCHED;
            PG8_LDA(At, 0, 1); PG8_STAGE(PG8_SB(0, 0), rsB, b2, voffB); PG8_STAGE(PG8_SB(0, 1), rsB, b2 + hstep, voffB); PG8_STAGE(PG8_SA(0, 0), rsA, a2, voffA);
            PG8_WAIT_V(8); PG8_WAIT_L(0); PG8_BAR; PG8_MMA(1, 0, At, B0); PG8_MMA(1, 1, At, B1); PG8_BAR; PG8_SCHED;
            PG8_LDB(B0, 1, 0); PG8_LDB(B1, 1, 1); PG8_SCHED; PG8_LDA(At, 1, 0); PG8_STAGE(PG8_SA(0, 1), rsA, a2 + hstep, voffA);
            PG8_WAIT_V(8); PG8_WAIT_L(0); PG8_BAR; PG8_MMA(0, 0, At, B0); PG8_MMA(0, 1, At, B1); PG8_BAR; PG8_SCHED;
            PG8_LDA(At, 1, 1); PG8_STAGE(PG8_SB(1, 0), rsB, b3, voffB); PG8_STAGE(PG8_SB(1, 1), rsB, b3 + hstep, voffB); PG8_STAGE(PG8_SA(1, 0), rsA, a3, voffA);
            PG8_WAIT_V(8); PG8_WAIT_L(0); PG8_BAR; PG8_MMA(1, 0, At, B0); PG8_MMA(1, 1, At, B1); PG8_BAR; PG8_SCHED;
            } else {
            PG8_LDB(B0, 0, 0); PG8_SCHED; PG8_LDA(At, 0, 0); PG8_STAGE(PG8_SA(1, 1), rsA, a1 + hstep, voffA);
            PG8_WAIT_L(8); PG8_BAR; PG8_WAIT_L(0); PG8_MMA(0, 0, At, B0); PG8_BAR; PG8_SCHED;
            PG8_LDB(B1, 0, 1); PG8_STAGE(PG8_SB(0, 0), rsB, b2, voffB);
            PG8_BAR; PG8_WAIT_L(0); PG8_MMA(0, 1, At, B1); PG8_BAR;
            PG8_LDA(At, 0, 1); PG8_STAGE(PG8_SA(0, 0), rsA, a2, voffA);
            PG8_BAR; PG8_WAIT_L(0); PG8_MMA(1, 0, At, B0); PG8_BAR; PG8_SCHED;
            PG8_STAGE(PG8_SB(0, 1), rsB, b2 + hstep, voffB);
            PG8_WAIT_V(6); PG8_BAR; PG8_MMA(1, 1, At, B1); PG8_BAR;
            PG8_LDB(B0, 1, 0); PG8_SCHED; PG8_LDA(At, 1, 0); PG8_STAGE(PG8_SA(0, 1), rsA, a2 + hstep, voffA);
            PG8_WAIT_L(8); PG8_BAR; PG8_WAIT_L(0); PG8_MMA(0, 0, At, B0); PG8_BAR; PG8_SCHED;
            PG8_LDB(B1, 1, 1); PG8_STAGE(PG8_SB(1, 0), rsB, b3, voffB);
            PG8_BAR; PG8_WAIT_L(0); PG8_MMA(0, 1, At, B1); PG8_BAR;
            PG8_LDA(At, 1, 1); PG8_STAGE(PG8_SA(1, 0), rsA, a3, voffA);
            PG8_BAR; PG8_WAIT_L(0); PG8_MMA(1, 0, At, B0); PG8_BAR; PG8_SCHED;
            PG8_STAGE(PG8_SB(1, 1), rsB, b3 + hstep, voffB);
            PG8_WAIT_V(6); PG8_BAR; PG8_MMA(1, 1, At, B1); PG8_BAR;
            }
        }
        if constexpr (ALIGN_EPI) { if (wr == 0) PG8_BAR; }
        if constexpr (!Epi::AFTER_DRAIN) { E(acc, cur, wr, wc, fr, fq); S.done(cur); }
        if (!has_next) break;
#pragma unroll
        for (int a = 0; a < 2; ++a)
#pragma unroll
            for (int b = 0; b < 2; ++b)
#pragma unroll
                for (int m = 0; m < 4; ++m)
#pragma unroll
                    for (int n = 0; n < 2; ++n) acc[a][b][m][n] = (f32x4){0.f, 0.f, 0.f, 0.f};
        cur = nxt; cA = nA; cB = nB; ++ui;
        if constexpr (ALIGN_EPI) { if (wr == 1) PG8_BAR; }
    }
    PG8_WAIT_V(0);
    if constexpr (!ALIGN_EPI) { if (wr == 0) PG8_BAR; }
    PG8_BAR;
#undef PG8_SA
#undef PG8_SB
#undef PG8_STAGE
#undef PG8_LDA
#undef PG8_LDB
#undef PG8_MMA
#undef PG8_CAT
#undef PG8_WAIT_V
#undef PG8_WAIT_L
#undef PG8_BAR
#undef PG8_SCHED
}
}

#define PG8_SP2 true
#define PG8_ALIGN true

constexpr int NWAVES = 8;
constexpr int NB = 4, SEQ = 4096, T = NB * SEQ, D = 2048;
constexpr int NPROJ = 13056;
constexpr int CQ = 0, CK = 1024, CV = 2048, CZ = 4096, CSQ = 6144, CSK = 8192, CSV = 8448, CGA = 8704, CGB = 10752, CBETA = 12800, CALPHA = 12816;
constexpr int D_IN = 12832;
constexpr int FFD = 5504, FFD2 = 11008, FFE = 7168, FFE2 = 14336, NE = 8;
constexpr int MOE_ROWS = 2 * T + NE * 256;
constexpr float NORM_EPS = 1e-6f;

constexpr size_t WS_CTL = 0, CTL_ZERO_BYTES = 1u << 20;
constexpr size_t SZ_WIN = (size_t)NPROJ * D * 2, SZ_SQ = (size_t)D * D * 2;
constexpr size_t WS_WIN = CTL_ZERO_BYTES;
constexpr size_t WS_WPG = WS_WIN + 2 * SZ_WIN;
constexpr size_t WS_WPS = WS_WPG + 2 * SZ_SQ;
constexpr size_t WS_WO = WS_WPS + 2 * SZ_SQ;
constexpr size_t WS_WGU = WS_WO + 2 * SZ_SQ;
constexpr size_t WS_WDN = WS_WGU + (size_t)FFD2 * D * 2;
constexpr size_t WS_MGU = WS_WDN + (size_t)D * FFD * 2;
constexpr size_t WS_MDN = WS_MGU + (size_t)NE * FFE2 * D * 2;
constexpr size_t WS_H = WS_MDN + (size_t)NE * D * FFE * 2;
constexpr size_t WS_R1 = WS_H + (size_t)T * D * 2;
constexpr size_t SZ_R1 = (size_t)MOE_ROWS * FFE * 2;
constexpr size_t WS_MIX = WS_R1 + SZ_R1;
constexpr size_t WS_QN = WS_MIX;
constexpr size_t WS_KN = WS_QN + (size_t)T * 1024 * 2;
constexpr size_t WS_V = WS_KN + (size_t)T * 1024 * 2;
constexpr size_t WS_ORAW = WS_V + (size_t)T * 2048 * 2;
constexpr size_t WS_OA = WS_ORAW + (size_t)T * 2048 * 4;
constexpr size_t WS_OB = WS_OA + (size_t)T * 2048 * 2;
constexpr size_t WS_G = WS_OB + (size_t)T * 2048 * 2;
constexpr size_t WS_BETA = WS_G + (size_t)T * 16 * 4;
constexpr size_t WS_MIX_END = WS_BETA + (size_t)T * 16 * 4;
constexpr size_t WS_Y = WS_QN;
constexpr size_t WS_YP = WS_ORAW;
constexpr size_t WS_XG = WS_MIX;
constexpr size_t WS_YG = WS_MIX + ((size_t)160 << 20);
constexpr size_t WS_IDX = WS_MIX_END;
constexpr size_t WS_TOPW = WS_IDX + (size_t)NE * T * 4;
constexpr size_t WS_SLOT = WS_TOPW + (size_t)T * 2 * 4;
constexpr size_t WS_QKB = WS_SLOT + (size_t)T * 2 * 4;
constexpr size_t WS_KTB = WS_QKB + (size_t)4096 * 4096 * 2;
constexpr size_t WS_EG = WS_KTB + (size_t)2048 * 8192 * 2;
constexpr size_t WS_EK = WS_EG + (size_t)T * 16 * 4;
constexpr size_t WS_RS = WS_EK + (size_t)T * 16 * 4;
constexpr size_t WS_CS = WS_RS + (size_t)T * 4;
constexpr size_t WS_CSF = WS_CS + (size_t)2 * NPROJ * 4;
constexpr size_t WS_CSM = WS_CSF + (size_t)FFD2 * 4;
constexpr size_t WS_RSF = WS_CSM + (size_t)NE * FFE2 * 4;
constexpr size_t WS_RSX = WS_RSF + (size_t)T * 4;
constexpr size_t WS_END = WS_RSX + (size_t)MOE_ROWS * 4;
constexpr size_t WS_WB = WS_R1 + (size_t)T * NPROJ * 2;
constexpr size_t WS_UTB = WS_ORAW;
static_assert(WS_WB + (size_t)4096 * 8192 * 2 <= WS_R1 + SZ_R1, "W tiles fit behind proj");
static_assert(WS_XG + (size_t)MOE_ROWS * D * 2 <= WS_YG && WS_YG + (size_t)MOE_ROWS * D * 2 <= WS_MIX_END, "moe overlays");
static_assert((size_t)T * NPROJ * 2 <= SZ_R1, "proj fits R1");
constexpr int CW_CNT = 64;
constexpr int CW_BAR = 4096;

constexpr int RING_OFF = 0, RING_BYTES = 155648;
constexpr int LDSCTL_OFF = RING_BYTES, MISC_OFF = LDSCTL_OFF + 320;
constexpr int LDS_BYTES = 163840;

#define GAS __attribute__((address_space(1)))
#define LAS __attribute__((address_space(3)))
typedef unsigned short bf16;
typedef unsigned v4u __attribute__((ext_vector_type(4)));
typedef unsigned v2u __attribute__((ext_vector_type(2)));
typedef float f32x4 __attribute__((ext_vector_type(4)));
typedef short bf16x8 __attribute__((ext_vector_type(8)));
using pg8::pk2; using pg8::bflo; using pg8::bfhi; using pg8::fsigmoid;
#define LDS_WAIT() asm volatile("s_waitcnt lgkmcnt(0)" ::: "memory")
#define VM_WAIT() asm volatile("s_waitcnt vmcnt(0)" ::: "memory")

#define XB_TMO      128
#define XB_XCNT(j)  (256  + 64 * (j))
#define XB_XSUB(j)  (1280 + 64 * (j))
#define XB_XGEN(j)  (2304 + 64 * (j))
#define XB_TOP      3328
#define XB_TOPGEN   3392
#define XCD_BAR_WORDS 3456
#define XB_SPIN_CAP (1u << 21)

__device__ __forceinline__ unsigned xb_ld(unsigned* p)              { return __hip_atomic_load(p, __ATOMIC_RELAXED, __HIP_MEMORY_SCOPE_AGENT); }
__device__ __forceinline__ unsigned xb_add(unsigned* p, unsigned v) { return __hip_atomic_fetch_add(p, v, __ATOMIC_RELAXED, __HIP_MEMORY_SCOPE_AGENT); }
__device__ __forceinline__ unsigned xb_xcc_id() { return (unsigned)__builtin_amdgcn_s_getreg((3 << 11) | 20) & 0xFu; }
#define XB_SPIN(cond, bar) do { unsigned _sp = 0; while (cond) { __builtin_amdgcn_s_sleep(1); \
    if ((++_sp & 255u) == 0u) { if (xb_ld(&(bar)[XB_TMO])) break; if (_sp > XB_SPIN_CAP) { atomicAdd(&(bar)[XB_TMO], 1u); break; } } } } while (0)

struct XcdBarrier { unsigned* bar; unsigned x; volatile LAS unsigned* st; };

__device__ __forceinline__ XcdBarrier xcd_barrier_post(unsigned* bar, volatile LAS unsigned* st) {
    XcdBarrier b; b.bar = bar; b.x = xb_xcc_id(); b.st = st;
    if (threadIdx.x == 0) (void)xb_add(&bar[XB_XCNT(b.x)], 1u);
    return b;
}
__device__ __forceinline__ void xcd_barrier_complete(unsigned* bar, unsigned x, unsigned& nloc, unsigned& nx) {
    const unsigned G = gridDim.x * gridDim.y * gridDim.z;
    unsigned sum, cnt, mine, sp = 0u;
    for (;;) {
        sum = 0u; cnt = 0u; mine = 0u;
#pragma unroll
        for (unsigned j = 0; j < 16; ++j) { const unsigned c = xb_ld(&bar[XB_XCNT(j)]); sum += c; cnt += (c > 0u) ? 1u : 0u; mine = (j == x) ? c : mine; }
        if (sum == G) break;
        __builtin_amdgcn_s_sleep(1);
        if ((++sp & 255u) == 0u) { if (xb_ld(&bar[XB_TMO])) break; if (sp > XB_SPIN_CAP) { atomicAdd(&bar[XB_TMO], 1u); break; } }
    }
    nloc = mine > 0u ? mine : 1u; nx = cnt > 0u ? cnt : 1u;
}
__device__ __forceinline__ void xcd_barrier(const XcdBarrier& b) {
    asm volatile("s_waitcnt vmcnt(0)" ::: "memory");
    __syncthreads();
    if (threadIdx.x == 0) {
        unsigned* bar = b.bar;
        __builtin_amdgcn_s_waitcnt(0);
        unsigned nloc = b.st[0], nx = b.st[1];
        if (nloc == 0u) { xcd_barrier_complete(bar, b.x, nloc, nx); b.st[0] = nloc; b.st[1] = nx; }
        const unsigned old = xb_add(&bar[XB_XSUB(b.x)], 1u);
        const unsigned gen = old / nloc;
        if (old + 1u == (gen + 1u) * nloc) {
            __builtin_amdgcn_fence(__ATOMIC_RELEASE, "agent");
            asm volatile("s_waitcnt vmcnt(0)" ::: "memory");
            const unsigned og = xb_add(&bar[XB_TOP], 1u);
            const unsigned tg = og / nx;
            if (og + 1u == (tg + 1u) * nx) xb_add(&bar[XB_TOPGEN], 1u);
            else XB_SPIN(xb_ld(&bar[XB_TOPGEN]) == tg, bar);
            __builtin_amdgcn_fence(__ATOMIC_ACQUIRE, "agent");
            xb_add(&bar[XB_XGEN(b.x)], 1u);
            asm volatile("s_waitcnt vmcnt(0)" ::: "memory");
        } else {
            XB_SPIN(xb_ld(&bar[XB_XGEN(b.x)]) == gen, bar);
            __builtin_amdgcn_fence(__ATOMIC_ACQUIRE, "agent");
            asm volatile("s_waitcnt vmcnt(0)" ::: "memory");
        }
    }
    __syncthreads();
}

struct Args {
    const float* in[21]; float* out; unsigned char* ws; int ph_lo, ph_hi, li, pad;
};
struct Frame {
    LAS unsigned char* lds;
    volatile LAS unsigned* MISC;
    unsigned* ctl;
    int tid, lane, wave, vcu, G;
};

__device__ __forceinline__ float wave_sum(float v) {
#pragma unroll
    for (int o = 1; o < 64; o <<= 1) v += __shfl_xor(v, o);
    return v;
}
template <int CTRL> __device__ __forceinline__ float dpp_f(float x) { return __builtin_bit_cast(float, __builtin_amdgcn_update_dpp(0, __builtin_bit_cast(int, x), CTRL, 0xF, 0xF, false)); }
__device__ __forceinline__ float reduce16(float x) {
    x += dpp_f<0x128>(x); x += dpp_f<0x124>(x); x += dpp_f<0x122>(x); x += dpp_f<0x121>(x); return x;
}
__device__ __forceinline__ float fsilu(float x) { return x * fsigmoid(x); }

__device__ __forceinline__ void transpose_item(const float* W, int ldw, int k0, int ns0, bf16* WT, int K, int nd0, bool zero, LAS float* scr, int lane) {
    if (!zero) {
#pragma unroll 8
        for (int i = 0; i < 32; ++i) { const int kk = 2 * i + (lane >> 5); scr[kk * 33 + (lane & 31)] = W[(size_t)(k0 + kk) * ldw + ns0 + (lane & 31)]; }
    }
    LDS_WAIT(); asm volatile("" ::: "memory");
    const int c = lane & 7;
#pragma unroll
    for (int j = 0; j < 4; ++j) { const int n = (lane >> 3) + 8 * j; const LAS float* s = scr + (8 * c) * 33 + n;
        v4u o;
        if (zero) { o = (v4u){0u, 0u, 0u, 0u}; }
        else { o.x = pk2(s[0 * 33], s[1 * 33]); o.y = pk2(s[2 * 33], s[3 * 33]); o.z = pk2(s[4 * 33], s[5 * 33]); o.w = pk2(s[6 * 33], s[7 * 33]); }
        *(GAS v4u*)(WT + (size_t)(nd0 + n) * K + k0 + 8 * c) = o; }
    LDS_WAIT(); asm volatile("" ::: "memory");
}
__device__ __forceinline__ void transpose_item_f8(const float* W, int ldw, int k0, int ns0, unsigned char* WT, int K, int nd0, float wsc, LAS float* scr, int lane) {
#pragma unroll 8
    for (int i = 0; i < 32; ++i) { const int kk = 2 * i + (lane >> 5); scr[kk * 33 + (lane & 31)] = W[(size_t)(k0 + kk) * ldw + ns0 + (lane & 31)]; }
    LDS_WAIT(); asm volatile("" ::: "memory");
    const int c = lane & 7;
#pragma unroll
    for (int j = 0; j < 4; ++j) { const int n = (lane >> 3) + 8 * j; const LAS float* s = scr + (8 * c) * 33 + n;
        v2u o; o.x = pg8::pk4_fp8(s[0 * 33] * wsc, s[1 * 33] * wsc, s[2 * 33] * wsc, s[3 * 33] * wsc); o.y = pg8::pk4_fp8(s[4 * 33] * wsc, s[5 * 33] * wsc, s[6 * 33] * wsc, s[7 * 33] * wsc);
        *(GAS v2u*)(WT + (size_t)(nd0 + n) * K + k0 + 8 * c) = o; }
    LDS_WAIT(); asm volatile("" ::: "memory");
}
constexpr float W8_SCALE = 64.f; constexpr int W8_E8M0 = 0x79797979;
constexpr float X8_SCALE = 4.f, H8_SCALE = 4.f; constexpr int X8_E8M0 = 0x7d7d7d7d, H8_E8M0 = 0x7d7d7d7d;
__device__ __forceinline__ void tr_plain_f8(const float* W, int K, int N, unsigned char* WT, int item, LAS float* scr, int lane) {
    const int nblk = N / 32, kb = item / nblk, nb = item % nblk;
    transpose_item_f8(W, N, 64 * kb, 32 * nb, WT, K, 32 * nb, W8_SCALE, scr, lane);
}
__device__ __forceinline__ void tr_gu_f8(const float* Wg, const float* Wu, int K, int F, unsigned char* WT, int item, LAS float* scr, int lane) {
    const int nblk = (2 * F) / 32, kb = item / nblk, nb = item % nblk, nd0 = 32 * nb, pn = nd0 >> 8, j = nd0 & 255;
    const float* W = (j < 128) ? Wg : Wu; const int ns0 = 128 * pn + (j & 127);
    transpose_item_f8(W, F, 64 * kb, ns0, WT, K, nd0, W8_SCALE, scr, lane);
}
__device__ __forceinline__ void tr_plain(const float* W, int K, int N, bf16* WT, int item, LAS float* scr, int lane) {
    const int nblk = N / 32, kb = item / nblk, nb = item % nblk;
    transpose_item(W, N, 64 * kb, 32 * nb, WT, K, 32 * nb, false, scr, lane);
}
__device__ __forceinline__ void w_i8_core(const Frame& F, const float* Wblk  , int ldw, bool zero, unsigned char* WTrow0  , float* CSblk, LAS float* mxs  ) {
    const int lane = F.lane, n = lane & 31, kq = lane >> 5;
    const int k0 = 256 * F.wave + 128 * kq;
    const float* Wc = Wblk + (size_t)k0 * ldw + n;
    float v[128]; float mx = 0.f;
#pragma unroll
    for (int i = 0; i < 128; ++i) { v[i] = zero ? 0.f : Wc[(size_t)i * ldw]; mx = fmaxf(mx, fabsf(v[i])); }
    mxs[(2 * F.wave + kq) * 32 + n] = mx;
    __syncthreads();
    float cm = 0.f;
#pragma unroll
    for (int j = 0; j < 16; ++j) cm = fmaxf(cm, mxs[j * 32 + n]);
    const float iv = cm > 0.f ? 127.f / cm : 0.f;
    if (F.wave == 0 && lane < 32) CSblk[n] = cm * (1.f / 127.f);
    v4u* op = (v4u*)(WTrow0 + (size_t)n * D + k0);
#pragma unroll
    for (int q = 0; q < 8; ++q) { unsigned wd[4];
#pragma unroll
        for (int d = 0; d < 4; ++d) { const int q0 = (int)__builtin_rintf(v[16 * q + 4 * d] * iv) & 255, q1 = (int)__builtin_rintf(v[16 * q + 4 * d + 1] * iv) & 255, q2 = (int)__builtin_rintf(v[16 * q + 4 * d + 2] * iv) & 255, q3 = (int)__builtin_rintf(v[16 * q + 4 * d + 3] * iv) & 255;
            wd[d] = (unsigned)(q0 | (q1 << 8) | (q2 << 16) | (q3 << 24)); }
        op[q] = (v4u){wd[0], wd[1], wd[2], wd[3]}; }
    __syncthreads();
}
__device__ __forceinline__ void win_i8_item(const Frame& F, const float* W, unsigned char* WT, float* CS, int nb, LAS float* mxs) {
    const int nd0 = 32 * nb; const bool zero = nd0 >= 12832; const int ns0 = nd0 < 6144 ? nd0 : (nd0 < 12800 ? nd0 + 32 : (zero ? 0 : nd0 - 12800 + 6144));
    w_i8_core(F, W + ns0, D_IN, zero, WT + (size_t)nd0 * D, CS + nd0, mxs);
}
__device__ __forceinline__ void wgu_i8_item(const Frame& F, const float* Wg, const float* Wu, int Fh, unsigned char* WT, float* CS, int nb, LAS float* mxs) {
    const int nd0 = 32 * nb, pn = nd0 >> 8, j = nd0 & 255;
    w_i8_core(F, ((j < 128) ? Wg : Wu) + 128 * pn + (j & 127), Fh, false, WT + (size_t)nd0 * D, CS + nd0, mxs);
}
template <bool ROUTER, bool OUT8 = false>
__device__ __forceinline__ void rms_row(const Frame& F, const float* xrow, const float* gain, bf16* orow, const LAS float* rwT, int t, unsigned* cnt, int* idx, float* topw, int* slot, LAS void* cnt_lds = nullptr, int rec = 0) {
    const f32x4* xr = (const f32x4*)xrow + F.lane; const f32x4* gr = (const f32x4*)gain + F.lane;
    f32x4 v[8]; float ss = 0.f;
#pragma unroll
    for (int j = 0; j < 8; ++j) { v[j] = xr[64 * j]; ss += (v[j].x * v[j].x + v[j].y * v[j].y) + (v[j].z * v[j].z + v[j].w * v[j].w); }
    const float r = __builtin_amdgcn_rsqf(wave_sum(ss) * (1.f / D) + NORM_EPS);
    if constexpr (OUT8) {
        float am = 0.f;
#pragma unroll
        for (int j = 0; j < 8; ++j) { v[j] = v[j] * r * gr[64 * j]; am = fmaxf(am, fmaxf(fmaxf(fabsf(v[j].x), fabsf(v[j].y)), fmaxf(fabsf(v[j].z), fabsf(v[j].w)))); }
#pragma unroll
        for (int o = 1; o < 64; o <<= 1) am = fmaxf(am, __shfl_xor(am, o));
        const float iv = am > 0.f ? 127.f / am : 0.f;
        unsigned* o4 = (unsigned*)orow + F.lane;
#pragma unroll
        for (int j = 0; j < 8; ++j) { const int q0 = (int)__builtin_rintf(v[j].x * iv) & 255, q1 = (int)__builtin_rintf(v[j].y * iv) & 255, q2 = (int)__builtin_rintf(v[j].z * iv) & 255, q3 = (int)__builtin_rintf(v[j].w * iv) & 255;
            o4[64 * j] = (unsigned)(q0 | (q1 << 8) | (q2 << 16) | (q3 << 24)); }
        if (F.lane == 0) topw[t] = am * (1.f / 127.f);
    } else {
        v2u* o8 = (v2u*)orow + F.lane;
#pragma unroll
        for (int j = 0; j < 8; ++j) { v[j] = v[j] * r * gr[64 * j]; v2u w; w.x = pk2(v[j].x, v[j].y); w.y = pk2(v[j].z, v[j].w); o8[64 * j] = w; }
    }
    if constexpr (ROUTER) {
        float lg[8];
#pragma unroll
        for (int e = 0; e < 8; ++e) { float s = 0.f;
#pragma unroll
            for (int j = 0; j < 8; ++j) { const f32x4 w = *(const LAS f32x4*)(rwT + e * D + 4 * F.lane + 256 * j); s += (v[j].x * w.x + v[j].y * w.y) + (v[j].z * w.z + v[j].w * w.w); }
            lg[e] = wave_sum(s); asm volatile("" ::: "memory"); }
        int e1 = 0; float l1 = lg[0];
#pragma unroll
        for (int e = 1; e < 8; ++e) if (lg[e] > l1) { l1 = lg[e]; e1 = e; }
        int e2 = -1; float l2 = -3.0e38f;
#pragma unroll
        for (int e = 0; e < 8; ++e) if (e != e1 && lg[e] > l2) { l2 = lg[e]; e2 = e; }
        if (F.lane == 0) {
            const float w1 = 1.f / (1.f + __expf(l2 - l1)), w2 = 1.f - w1;
            LAS unsigned* lcnt = (LAS unsigned*)cnt_lds; LAS int* lrec = (LAS int*)cnt_lds + 16;
            const unsigned p1 = __hip_atomic_fetch_add(lcnt + e1, 1u, __ATOMIC_RELAXED, __HIP_MEMORY_SCOPE_WORKGROUP), p2 = __hip_atomic_fetch_add(lcnt + e2, 1u, __ATOMIC_RELAXED, __HIP_MEMORY_SCOPE_WORKGROUP);
            lrec[2 * rec] = (e1 << 16) | (int)p1; lrec[2 * rec + 1] = (e2 << 16) | (int)p2;
            topw[2 * t] = w1; topw[2 * t + 1] = w2;
        }
    }
}

__device__ __forceinline__ void unpack8(const v4u w, float (&f)[8]) { f[0] = bflo(w.x); f[1] = bfhi(w.x); f[2] = bflo(w.y); f[3] = bfhi(w.y); f[4] = bflo(w.z); f[5] = bfhi(w.z); f[6] = bflo(w.w); f[7] = bfhi(w.w); }

__host__ __device__ constexpr int pi5(int p) { return 4 * (p >> 3) + (p & 3) + 16 * ((p >> 2) & 1); }
__host__ __device__ constexpr int pinv5(int a) { return 8 * ((a & 15) >> 2) + (a & 3) + 4 * (a >> 4); }
constexpr int PS = 136, PQ = 72;
__device__ __forceinline__ void gdn_prep_phase(const Frame& F, const bf16* PROJ, const float* convw, const float* a_log, const float* dt_bias,
                                               bf16* QN, bf16* WB, bf16* UTB, bf16* QKB, bf16* KTB, float* EG, float* EK) {
    LAS unsigned char* L = F.lds;
    LAS bf16* KS = (LAS bf16*)L; LAS bf16* QS = (LAS bf16*)(L + 17408);
    constexpr int OVS = 34816, OAM = 69632, OQK = 104448, OVEC = 122880;
    const int tid = F.tid, lane = F.lane, w = F.wave, c = lane & 15, gq = lane >> 4;
    for (int unit = F.vcu; unit < NB * 64 * 8; unit += F.G) {
        const int hq = unit & 7, n = (unit >> 3) & 63, b = unit >> 9;
        const size_t t0 = (size_t)b * SEQ + (size_t)n * 64;
        {
            const int m = tid >> 7, r = (tid >> 4) & 7, g16 = tid & 15;
            const int col = (m == 0 ? CQ + hq * 128 : m == 1 ? CK + hq * 128 : CV + (2 * hq + (m - 2)) * 128) + 8 * g16;
            float wt[4][8];
#pragma unroll
            for (int tap = 0; tap < 4; ++tap) { const f32x4 a = *(const f32x4*)(convw + tap * 4096 + col), bb = *(const f32x4*)(convw + tap * 4096 + col + 4);
                wt[tap][0] = a.x; wt[tap][1] = a.y; wt[tap][2] = a.z; wt[tap][3] = a.w; wt[tap][4] = bb.x; wt[tap][5] = bb.y; wt[tap][6] = bb.z; wt[tap][7] = bb.w; }
            const bf16* pr = PROJ + (t0 + 8 * r) * NPROJ + col;
            float x0[8], x1[8], x2[8];
            if (r == 0 && (t0 & (SEQ - 1)) == 0) {
#pragma unroll
                for (int i = 0; i < 8; ++i) { x0[i] = 0.f; x1[i] = 0.f; x2[i] = 0.f; }
            } else { unpack8(*(const v4u*)(pr - 3 * (size_t)NPROJ), x0); unpack8(*(const v4u*)(pr - 2 * (size_t)NPROJ), x1); unpack8(*(const v4u*)(pr - (size_t)NPROJ), x2); }
            const float qs = (m == 0) ? 0.08838834764831845f : 1.0f;
            const int pm_ = g16 & 3, ppos = 32 * (g16 >> 2) + 16 * (pm_ & 1) + 4 * (pm_ >> 1);
            LAS bf16* dst = (m == 0) ? QS : (m == 1) ? KS : (LAS bf16*)(L + OVS + (m - 2) * 17408);
#pragma unroll
            for (int j = 0; j < 8; ++j) {
                float x3[8]; unpack8(*(const v4u*)(pr + (size_t)j * NPROJ), x3);
                float y[8]; float ss = 0.f;
#pragma unroll
                for (int i = 0; i < 8; ++i) { float a = wt[0][i] * x0[i] + wt[1][i] * x1[i] + wt[2][i] * x2[i] + wt[3][i] * x3[i]; a = fsilu(a); y[i] = a; ss += a * a; }
                if (m < 2) { const float sc = __builtin_amdgcn_rsqf(reduce16(ss) + 1e-6f) * qs;
#pragma unroll
                    for (int i = 0; i < 8; ++i) y[i] *= sc; }
                v4u o; o.x = pk2(y[0], y[1]); o.y = pk2(y[2], y[3]); o.z = pk2(y[4], y[5]); o.w = pk2(y[6], y[7]);
                const int tok = 8 * r + j;
                if (m < 2) { v2u lo, hi2; lo.x = o.x; lo.y = o.y; hi2.x = o.z; hi2.y = o.w; *(LAS v2u*)(dst + tok * PS + ppos) = lo; *(LAS v2u*)(dst + tok * PS + ppos + 8) = hi2; }
                else *(LAS v4u*)(dst + tok * PS + 8 * g16) = o;
#pragma unroll
                for (int i = 0; i < 8; ++i) { x0[i] = x1[i]; x1[i] = x2[i]; x2[i] = x3[i]; }
            }
        }
        __syncthreads();
        if (w < 2) {
            const int h = 2 * hq + w; LAS float* GC = (LAS float*)(L + OVEC + w * 768);
            const float braw = bflo((unsigned)PROJ[(t0 + lane) * NPROJ + CBETA + h]), araw = bflo((unsigned)PROJ[(t0 + lane) * NPROJ + CALPHA + h]);
            const float xx = araw + dt_bias[h]; const float sp = xx > 20.f ? xx : log1pf(__expf(xx));
            float g = -__expf(a_log[h]) * sp;
#pragma unroll
            for (int o = 1; o < 64; o <<= 1) { const float y = __shfl_up(g, o); if (lane >= o) g += y; }
            const float last = __shfl(g, 63), eg = __expf(g), ek = __expf(last - g);
            GC[lane] = g; GC[64 + lane] = eg; GC[128 + lane] = fsigmoid(braw);
            EG[(t0 + lane) * 16 + h] = eg; EK[(t0 + lane) * 16 + h] = ek;
        }
        {
#pragma unroll
            for (int i = 0; i < 2; ++i) { const int ch = tid + 512 * i, tok = ch >> 4, part = ch & 15; *(v4u*)(QN + (t0 + tok) * 1024 + hq * 128 + part * 8) = *(const LAS v4u*)(QS + tok * PS + part * 8); }
            if (tid < 256) { const int pcol = tid >> 1, half = tid & 1, dk = (pcol & 96) + pi5(pcol & 31);
                v4u* kp = (v4u*)(KTB + ((size_t)(b * 8 + hq) * 64 + n) * 8192 + (size_t)dk * 64 + 32 * half);
#pragma unroll
                for (int q8 = 0; q8 < 4; ++q8) { unsigned e[8];
#pragma unroll
                    for (int i = 0; i < 8; ++i) e[i] = (unsigned)KS[(32 * half + pi5(8 * q8 + i)) * PS + pcol];
                    v4u o; o.x = e[0] | (e[1] << 16); o.y = e[2] | (e[3] << 16); o.z = e[4] | (e[5] << 16); o.w = e[6] | (e[7] << 16); kp[q8] = o; } }
        }
        __syncthreads();
#pragma unroll
        for (int jj = 0; jj < 4; ++jj) {
            const int job = 4 * w + jj, type = job >> 4, ct = (job >> 2) & 3, st = job & 3;
            f32x4 acc = (f32x4){0.f, 0.f, 0.f, 0.f};
            if (st <= ct) {
                const LAS bf16* ap = (type ? QS : KS) + (16 * ct + c) * PS + 8 * gq; const LAS bf16* bp = KS + (16 * st + c) * PS + 8 * gq;
#pragma unroll
                for (int ks = 0; ks < 4; ++ks) acc = __builtin_amdgcn_mfma_f32_16x16x32_bf16(*(const LAS bf16x8*)(ap + 32 * ks), *(const LAS bf16x8*)(bp + 32 * ks), acc, 0, 0, 0);
            }
            int cl = c; asm volatile("" : "+v"(cl));
            const int col = 16 * st + cl;
#pragma unroll
            for (int hh = 0; hh < 2; ++hh) {
                const LAS float* GC = (const LAS float*)(L + OVEC + hh * 768); const float gcol = GC[col];
                LAS float* AM = (LAS float*)(L + OAM + hh * 17408); LAS bf16* QKs = (LAS bf16*)(L + OQK + hh * 9216);
#pragma unroll
                for (int r = 0; r < 4; ++r) { const int row = 16 * ct + 4 * gq + r;
                    const float dec = __expf(fminf(GC[row] - gcol, 0.f));
                    if (type == 0) AM[row * 68 + col] = (col < row) ? GC[128 + row] * acc[r] * dec : 0.f;
                    else QKs[row * PQ + (col & 32) + pinv5(col & 31)] = (bf16)(pk2((col <= row) ? acc[r] * dec : 0.f, 0.f) & 0xffffu); }
            }
        }
        __syncthreads();
        {
            const int hh = tid >> 8, j = tid & 255, h = 2 * hq + hh;
            const size_t ubh = ((size_t)(b * 16 + h) * 64 + n);
            const LAS bf16* VS = (const LAS bf16*)(L + OVS + hh * 17408);
            float x[64];
            const LAS float* GCv = (const LAS float*)(L + OVEC + hh * 768); asm volatile("" : "+v"(GCv));
            if (j < 128) {
#pragma unroll
                for (int i = 0; i < 64; ++i) x[i] = GCv[128 + i] * bflo((unsigned)VS[i * PS + j]);
            } else {
#pragma unroll
                for (int i = 0; i < 64; ++i) x[i] = GCv[128 + i] * GCv[64 + i] * bflo((unsigned)KS[i * PS + j - 128]);
            }
            __syncthreads();
            const LAS float* AMv = (const LAS float*)(L + OAM + hh * 17408); asm volatile("" : "+v"(AMv));
#pragma unroll
            for (int i = 1; i < 64; ++i) {
                float s0 = x[i], s1 = 0.f;
#pragma unroll
                for (int m4 = 0; m4 < (i + 3) / 4; ++m4) {
                    const f32x4 a = *(const LAS f32x4*)(AMv + i * 68 + 4 * m4);
                    if (4 * m4 + 0 < i) s0 -= a.x * x[4 * m4 + 0];
                    if (4 * m4 + 1 < i) s1 -= a.y * x[4 * m4 + 1];
                    if (4 * m4 + 2 < i) s0 -= a.z * x[4 * m4 + 2];
                    if (4 * m4 + 3 < i) s1 -= a.w * x[4 * m4 + 3];
                }
                x[i] = s0 + s1;
            }
            if (j < 128) {
                v4u* up = (v4u*)(UTB + ubh * 8192 + (size_t)j * 64);
#pragma unroll
                for (int q8 = 0; q8 < 8; ++q8) { v4u o; o.x = pk2(x[8 * q8], x[8 * q8 + 1]); o.y = pk2(x[8 * q8 + 2], x[8 * q8 + 3]); o.z = pk2(x[8 * q8 + 4], x[8 * q8 + 5]); o.w = pk2(x[8 * q8 + 6], x[8 * q8 + 7]); up[q8] = o; }
            } else {
                LAS bf16* Wt = hh ? KS : QS;
#pragma unroll
                for (int i = 0; i < 64; ++i) Wt[i * PS + j - 128] = (bf16)(pk2(x[i], 0.f) & 0xffffu);
            }
        }
        __syncthreads();
#pragma unroll
        for (int hh = 0; hh < 2; ++hh) { const size_t ubh = ((size_t)(b * 16 + 2 * hq + hh) * 64 + n); const LAS bf16* Wt = hh ? KS : QS; const LAS bf16* QKs = (const LAS bf16*)(L + OQK + hh * 9216);
#pragma unroll
            for (int i = 0; i < 2; ++i) { const int ch = tid + 512 * i, tok = ch >> 4, part = ch & 15; *(v4u*)(WB + ubh * 8192 + (size_t)ch * 8) = *(const LAS v4u*)(Wt + tok * PS + part * 8); }
            { const int tok = tid >> 3, part = tid & 7; *(v4u*)(QKB + ubh * 4096 + (size_t)tid * 8) = *(const LAS v4u*)(QKs + tok * PQ + part * 8); } }
        __syncthreads();
    }
}

__device__ __forceinline__ bf16x8 afrag(const LAS bf16* p) { return *(const LAS bf16x8*)p; }
__device__ __forceinline__ bf16x8 bfrag(const f32x4 t0, const f32x4 t1) {
    v4u a; a.x = pk2(t0[0], t0[1]); a.y = pk2(t0[2], t0[3]); a.z = pk2(t1[0], t1[1]); a.w = pk2(t1[2], t1[3]); return __builtin_bit_cast(bf16x8, a);
}
__device__ __forceinline__ void gdn_scan_phase(const Frame& F, const int unit0, const int ustride, const bf16* QN, const bf16* WB, const bf16* UTB, const bf16* QKB, const bf16* KTB, const float* EG, const float* EK,
                                               const bf16* PROJ, const float* gng, bf16* OA) {
    LAS unsigned char* L = F.lds;
    constexpr int OW = 0, OQ = 16384, OKT = 32768, OQK = 49152, OE = 57344, BUF = 57856, OOT = 2 * BUF, OTS = 136 * 64 * 2;
    const int tid = F.tid, lane = F.lane, w = F.wave, c = lane & 15, gq = lane >> 4, dv0 = 16 * w;
    const int r128 = lane >> 4, p128 = lane & 15, r64 = lane >> 3, p64 = lane & 7;
    for (int unit = unit0; unit < NB * 16; unit += ustride) {
        const int h = unit & 15, b = unit >> 4, hq = h >> 1;
        const size_t tb = (size_t)b * SEQ; const size_t ubh = (size_t)(b * 16 + h) * 64, ubq = (size_t)(b * 8 + hq) * 64;
        f32x4 S[8];
#pragma unroll
        for (int i = 0; i < 8; ++i) S[i] = (f32x4){0.f, 0.f, 0.f, 0.f};
        v2u ucur[4], unext[4];
        const int gtok = tid >> 3, gdv = (tid & 7) * 16;
        LAS float* GN = (LAS float*)(L + OOT + 2 * OTS);
        if (tid < 128) GN[tid] = gng[tid];
        v4u zc[2];
#define GSCAN_ZLOAD(n_) do { const bf16* zp_ = PROJ + (tb + (size_t)(n_) * 64 + gtok) * NPROJ + CZ + h * 128 + gdv; zc[0] = *(const v4u*)zp_; zc[1] = *(const v4u*)(zp_ + 8); } while (0)
#define GSCAN_NORM(n_) do { const LAS bf16* ot_ = (const LAS bf16*)(L + OOT + ((n_) & 1) * OTS) + gtok * 136 + gdv; \
            float o_[16]; { float t8_[8]; unpack8(*(const LAS v4u*)ot_, t8_); _Pragma("unroll") for (int i = 0; i < 8; ++i) o_[i] = t8_[i]; unpack8(*(const LAS v4u*)(ot_ + 8), t8_); _Pragma("unroll") for (int i = 0; i < 8; ++i) o_[8 + i] = t8_[i]; } \
            float ss_ = 0.f; _Pragma("unroll") for (int i = 0; i < 16; ++i) ss_ += o_[i] * o_[i]; \
            ss_ += __shfl_xor(ss_, 1); ss_ += __shfl_xor(ss_, 2); ss_ += __shfl_xor(ss_, 4); \
            const float r_ = __builtin_amdgcn_rsqf(ss_ * (1.f / 128.f) + NORM_EPS); \
            float z_[16]; { float t8_[8]; unpack8(zc[0], t8_); _Pragma("unroll") for (int i = 0; i < 8; ++i) z_[i] = t8_[i]; unpack8(zc[1], t8_); _Pragma("unroll") for (int i = 0; i < 8; ++i) z_[8 + i] = t8_[i]; } \
            f32x4 gg[4]; _Pragma("unroll") for (int i = 0; i < 4; ++i) gg[i] = *(const LAS f32x4*)(GN + gdv + 4 * i); \
            unsigned w_[8]; _Pragma("unroll") for (int i = 0; i < 8; ++i) w_[i] = pk2(o_[2 * i] * r_ * gg[i >> 1][(2 * i) & 3] * fsilu(z_[2 * i]), o_[2 * i + 1] * r_ * gg[i >> 1][(2 * i + 1) & 3] * fsilu(z_[2 * i + 1])); \
            v4u* op_ = (v4u*)(OA + (tb + (size_t)(n_) * 64 + gtok) * 2048 + h * 128 + gdv); op_[0] = (v4u){w_[0], w_[1], w_[2], w_[3]}; op_[1] = (v4u){w_[4], w_[5], w_[6], w_[7]}; } while (0)
        unsigned offW[2], offQ[2], offK[2], offQK;
#pragma unroll
        for (int k = 0; k < 2; ++k) { const int r = 4 * (w + 8 * k) + r128, r2 = 8 * (w + 8 * k) + r64;
            offW[k] = (unsigned)(r * 256 + ((p128 ^ (r & 15)) << 4)); offQ[k] = (unsigned)(r * 2048 + ((p128 ^ (r & 15)) << 4)); offK[k] = (unsigned)(r2 * 128 + ((p64 ^ ((r2 >> 1) & 7)) << 4)); }
        { const int r2 = 8 * w + r64; offQK = (unsigned)(r2 * 128 + ((p64 ^ ((r2 >> 1) & 7)) << 4)); }
#define GSCAN_FILL(n_, buf_) do { const size_t t0_ = tb + (size_t)(n_) * 64; LAS unsigned char* B1 = L + (buf_) * BUF; \
            const char* bw_ = (const char*)(WB + (ubh + (n_)) * 8192); const char* bq_ = (const char*)(QN + t0_ * 1024 + hq * 128); \
            const char* bk_ = (const char*)(KTB + (ubq + (n_)) * 8192); const char* bqk_ = (const char*)(QKB + (ubh + (n_)) * 4096); \
            _Pragma("unroll") for (int k = 0; k < 2; ++k) { \
                __builtin_amdgcn_global_load_lds((const unsigned*)(bw_ + offW[k]), (LAS unsigned*)(B1 + OW + (w + 8 * k) * 1024), 16, 0, 0); \
                __builtin_amdgcn_global_load_lds((const unsigned*)(bq_ + offQ[k]), (LAS unsigned*)(B1 + OQ + (w + 8 * k) * 1024), 16, 0, 0); \
                __builtin_amdgcn_global_load_lds((const unsigned*)(bk_ + offK[k]), (LAS unsigned*)(B1 + OKT + (w + 8 * k) * 1024), 16, 0, 0); } \
            __builtin_amdgcn_global_load_lds((const unsigned*)(bqk_ + offQK), (LAS unsigned*)(B1 + OQK + w * 1024), 16, 0, 0); \
            if (w < 2) __builtin_amdgcn_global_load_lds((const unsigned*)((w ? EK : EG) + (t0_ + lane) * 16 + h), (LAS unsigned*)(B1 + OE + w * 256), 4, 0, 0);     \
            _Pragma("unroll") for (int mt = 0; mt < 4; ++mt) unext[mt] = *(const v2u*)(UTB + (ubh + (n_)) * 8192 + (size_t)(dv0 + c) * 64 + 16 * mt + 4 * gq); } while (0)
        GSCAN_FILL(0, 0);
#pragma unroll
        for (int mt = 0; mt < 4; ++mt) ucur[mt] = unext[mt];
        asm volatile("s_waitcnt vmcnt(0)" ::: "memory");
        __syncthreads();
        for (int n = 0; n < SEQ / 64; ++n) {
            const int buf = n & 1;
            if (n + 1 < SEQ / 64) GSCAN_FILL(n + 1, buf ^ 1);
            if (n > 0) GSCAN_ZLOAD(n - 1);
            const LAS unsigned char* B0 = L + buf * BUF;
            const LAS float* EGs = (const LAS float*)(B0 + OE); const LAS float* EKs = EGs + 64;
#define FR128(base_, mt_, ks_) (*(const LAS bf16x8*)(B0 + (base_) + (16 * (mt_) + c) * 256 + (((4 * (ks_) + gq) ^ c) << 4)))
#define FR64(base_, mt_, ks_)  (*(const LAS bf16x8*)(B0 + (base_) + (16 * (mt_) + c) * 128 + (((4 * (ks_) + gq) ^ ((c >> 1) & 7)) << 4)))
            bf16x8 Sb[4];
#pragma unroll
            for (int ks = 0; ks < 4; ++ks) Sb[ks] = bfrag(S[2 * ks], S[2 * ks + 1]);
            f32x4 P[4], O[4];
            bf16x8 fw[2][4], fq[2][4];
#define GS_LD1(mt_, b_) do { _Pragma("unroll") for (int ks = 0; ks < 4; ++ks) { fw[b_][ks] = FR128(OW, mt_, ks); fq[b_][ks] = FR128(OQ, mt_, ks); } } while (0)
            GS_LD1(0, 0);
#pragma unroll
            for (int mt = 0; mt < 4; ++mt) {
                if (mt < 3) GS_LD1(mt + 1, (mt + 1) & 1);
                else {
#pragma unroll
                    for (int m2 = 0; m2 < 4; ++m2) { fw[0][m2] = FR64(OQK, m2, 0); fq[0][m2] = FR64(OQK, m2, 1); }
                }
                P[mt] = (f32x4){0.f, 0.f, 0.f, 0.f}; O[mt] = (f32x4){0.f, 0.f, 0.f, 0.f};
#pragma unroll
                for (int ks = 0; ks < 4; ++ks) {
                    P[mt] = __builtin_amdgcn_mfma_f32_16x16x32_bf16(fw[mt & 1][ks], Sb[ks], P[mt], 0, 0, 0);
                    O[mt] = __builtin_amdgcn_mfma_f32_16x16x32_bf16(fq[mt & 1][ks], Sb[ks], O[mt], 0, 0, 0); }
            }
#undef GS_LD1
            f32x4 Vn[4], Vs[4];
#pragma unroll
            for (int mt = 0; mt < 4; ++mt) {
                const f32x4 eg = *(const LAS f32x4*)(EGs + 16 * mt + 4 * gq), ek = *(const LAS f32x4*)(EKs + 16 * mt + 4 * gq);
                const v2u uw = ucur[mt];
                Vn[mt][0] = bflo(uw.x) - P[mt][0]; Vn[mt][1] = bfhi(uw.x) - P[mt][1]; Vn[mt][2] = bflo(uw.y) - P[mt][2]; Vn[mt][3] = bfhi(uw.y) - P[mt][3];
                O[mt] = O[mt] * eg; Vs[mt] = Vn[mt] * ek; }
            const bf16x8 Vb0 = bfrag(Vn[0], Vn[1]), Vb1 = bfrag(Vn[2], Vn[3]), Vs0 = bfrag(Vs[0], Vs[1]), Vs1 = bfrag(Vs[2], Vs[3]);
#pragma unroll
            for (int i = 0; i < 4; ++i) { fw[1][i] = FR64(OKT, i, 0); fq[1][i] = FR64(OKT, i, 1); }
#pragma unroll
            for (int mt = 0; mt < 4; ++mt) {
                O[mt] = __builtin_amdgcn_mfma_f32_16x16x32_bf16(fw[0][mt], Vb0, O[mt], 0, 0, 0);
                O[mt] = __builtin_amdgcn_mfma_f32_16x16x32_bf16(fq[0][mt], Vb1, O[mt], 0, 0, 0); }
            const float gl = EGs[63];
#pragma unroll
            for (int i = 0; i < 4; ++i) { fw[0][i] = FR64(OKT, 4 + i, 0); fq[0][i] = FR64(OKT, 4 + i, 1); }
            {
                LAS bf16* ot = (LAS bf16*)(L + OOT + (n & 1) * OTS) + (4 * gq) * 136 + dv0 + c;
#pragma unroll
                for (int mt = 0; mt < 4; ++mt)
#pragma unroll
                    for (int r = 0; r < 4; ++r) ot[(16 * mt + r) * 136] = (bf16)(pk2(O[mt][r], 0.f) & 0xffffu);
            }
#pragma unroll
            for (int i = 0; i < 8; ++i) { S[i] = S[i] * gl;
                S[i] = __builtin_amdgcn_mfma_f32_16x16x32_bf16(fw[1 - (i >> 2)][i & 3], Vs0, S[i], 0, 0, 0);
                S[i] = __builtin_amdgcn_mfma_f32_16x16x32_bf16(fq[1 - (i >> 2)][i & 3], Vs1, S[i], 0, 0, 0); }
#undef FR128
#undef FR64
            if (n + 1 < SEQ / 64) {
#pragma unroll
                for (int mt = 0; mt < 4; ++mt) ucur[mt] = unext[mt]; }
            if (n > 0) GSCAN_NORM(n - 1);
            asm volatile("s_waitcnt vmcnt(2) lgkmcnt(0)" ::: "memory"); __builtin_amdgcn_s_barrier(); asm volatile("" ::: "memory");
        }
        GSCAN_ZLOAD(SEQ / 64 - 1); GSCAN_NORM(SEQ / 64 - 1);
        __syncthreads();
#undef GSCAN_ZLOAD
#undef GSCAN_NORM
#undef GSCAN_FILL
    }
}

constexpr int KS_STRIDE = 72, VT_STRIDE = 264;
__device__ __forceinline__ void swa_phase(const Frame& F, const bf16* PROJ, const float* sinks, const float* rel_bias, bf16* OB) {
    LAS unsigned char* L = F.lds;
    LAS bf16* Ks = (LAS bf16*)L;
    LAS bf16* VT = (LAS bf16*)(L + 256 * KS_STRIDE * 2);
    LAS float* BT = (LAS float*)(L + 256 * KS_STRIDE * 2 + 64 * VT_STRIDE * 2);
    const int tid = F.tid, lane = F.lane, w = F.wave, c = lane & 15, gq = lane >> 4;
#pragma unroll 1
    for (int i = tid; i < 32 * 128; i += 512) {
        const int hd = i >> 7, d = i & 127;
        int bucket = d;
        if (d >= 16) { int lg = 16 + (int)(__logf((float)d * (1.f / 16.f)) * (16.f / 2.0794415416798357f)); bucket = lg < 31 ? lg : 31; }
        BT[i] = rel_bias[bucket * 32 + hd];
    }
    __syncthreads();
    for (int unit = F.vcu; unit < NB * 32 * 4; unit += F.G) {
        const int kvh = unit & 3, n = (unit >> 2) & 31, b = unit >> 7;
        const size_t tok0 = (size_t)b * SEQ + (size_t)n * 128;
#pragma unroll
        for (int i = 0; i < 4; ++i) {
            const int ch = tid + 512 * i, key = ch >> 3, part = ch & 7;
            v4u kw = (v4u){0u, 0u, 0u, 0u}, vw = (v4u){0u, 0u, 0u, 0u};
            if (n > 0 || key >= 128) { const size_t t = tok0 - 128 + key; kw = *(const v4u*)(PROJ + t * NPROJ + CSK + kvh * 64 + part * 8); vw = *(const v4u*)(PROJ + t * NPROJ + CSV + kvh * 64 + part * 8); }
            *(LAS v4u*)(Ks + key * KS_STRIDE + part * 8) = kw;
            LAS bf16* vt = VT + (part * 8) * VT_STRIDE + key;
            vt[0 * VT_STRIDE] = (bf16)(vw.x & 0xffff); vt[1 * VT_STRIDE] = (bf16)(vw.x >> 16); vt[2 * VT_STRIDE] = (bf16)(vw.y & 0xffff); vt[3 * VT_STRIDE] = (bf16)(vw.y >> 16);
            vt[4 * VT_STRIDE] = (bf16)(vw.z & 0xffff); vt[5 * VT_STRIDE] = (bf16)(vw.z >> 16); vt[6 * VT_STRIDE] = (bf16)(vw.w & 0xffff); vt[7 * VT_STRIDE] = (bf16)(vw.w >> 16);
        }
        __syncthreads();
        const int kt0 = w & ~1;
        const int qi = 16 * w + c;
        const bf16* qp0 = PROJ + (tok0 + qi) * NPROJ + CSQ + kvh * 512 + 8 * gq;
        bf16x8 nq0 = *(const bf16x8*)qp0, nq1 = *(const bf16x8*)(qp0 + 32);
        for (int g = 0; g < 8; ++g) {
            const int head = kvh * 8 + g;
            const bf16x8 bq0 = nq0, bq1 = nq1;
            if (g < 7) { nq0 = *(const bf16x8*)(qp0 + (g + 1) * 64); nq1 = *(const bf16x8*)(qp0 + (g + 1) * 64 + 32); }
            f32x4 s[10];
#pragma unroll
            for (int i = 0; i < 10; ++i) {
                const LAS bf16* kp = Ks + (16 * (kt0 + i) + c) * KS_STRIDE + 8 * gq;
                const bf16x8 a0 = *(const LAS bf16x8*)kp, a1 = *(const LAS bf16x8*)(kp + 32);
                f32x4 z = (f32x4){0.f, 0.f, 0.f, 0.f};
                z = __builtin_amdgcn_mfma_f32_16x16x32_bf16(a0, bq0, z, 0, 0, 0);
                s[i] = __builtin_amdgcn_mfma_f32_16x16x32_bf16(a1, bq1, z, 0, 0, 0);
            }
            const float sink = sinks[head];
            const LAS float* bt = BT + head * 128;
            float m = sink;
            int d0 = qi + 128 - (16 * kt0 + 4 * gq); unsigned lim = (n > 0) ? 127u : (unsigned)qi;
            asm volatile("" : "+v"(d0), "+v"(lim));
#pragma unroll
            for (int i = 0; i < 10; ++i)
#pragma unroll
                for (int r = 0; r < 4; ++r) {
                    const int dist = d0 - (16 * i + r);
                    const float x = ((unsigned)dist <= lim) ? (s[i][r] * 0.125f + bt[dist & 127]) : -3.0e38f;
                    s[i][r] = x; m = fmaxf(m, x);
                }
            m = fmaxf(m, __shfl_xor(m, 16)); m = fmaxf(m, __shfl_xor(m, 32));
            float sum = 0.f;
#pragma unroll
            for (int i = 0; i < 10; ++i)
#pragma unroll
                for (int r = 0; r < 4; ++r) { const float p = (s[i][r] > -1.0e38f) ? __expf(s[i][r] - m) : 0.f; s[i][r] = p; sum += p; }
            sum += __shfl_xor(sum, 16); sum += __shfl_xor(sum, 32);
            const float inv = 1.f / (sum + __expf(sink - m));
            f32x4 o[4];
#pragma unroll
            for (int dt = 0; dt < 4; ++dt) o[dt] = (f32x4){0.f, 0.f, 0.f, 0.f};
#pragma unroll
            for (int ks = 0; ks < 5; ++ks) {
                v4u pw; pw.x = pk2(s[2 * ks][0], s[2 * ks][1]); pw.y = pk2(s[2 * ks][2], s[2 * ks][3]); pw.z = pk2(s[2 * ks + 1][0], s[2 * ks + 1][1]); pw.w = pk2(s[2 * ks + 1][2], s[2 * ks + 1][3]);
                const bf16x8 pb = __builtin_bit_cast(bf16x8, pw);
#pragma unroll
                for (int dt = 0; dt < 4; ++dt) {
                    const LAS bf16* vp = VT + (16 * dt + c) * VT_STRIDE + 16 * (kt0 + 2 * ks) + 4 * gq;
                    const v2u lo = *(const LAS v2u*)vp, hi = *(const LAS v2u*)(vp + 16);
                    v4u aw; aw.x = lo.x; aw.y = lo.y; aw.z = hi.x; aw.w = hi.y;
                    o[dt] = __builtin_amdgcn_mfma_f32_16x16x32_bf16(__builtin_bit_cast(bf16x8, aw), pb, o[dt], 0, 0, 0);
                }
            }
            bf16* op = OB + (tok0 + qi) * 2048 + head * 64 + 4 * gq;
#pragma unroll
            for (int dt = 0; dt < 4; ++dt) { v2u wv; wv.x = pk2(o[dt][0] * inv, o[dt][1] * inv); wv.y = pk2(o[dt][2] * inv, o[dt][3] * inv); *(v2u*)(op + 16 * dt) = wv; }
        }
        __syncthreads();
    }
}

__device__ __forceinline__ void gather_phase(const Frame& F, const bf16* H, const int* idx, bf16* XG, float* RSX) {
    const int gw = F.vcu * NWAVES + F.wave, NGW = F.G * NWAVES, lane = F.lane;
    unsigned cnt[8]; int ps[9]; ps[0] = 0;
#pragma unroll
    for (int e = 0; e < 8; ++e) { cnt[e] = F.ctl[CW_CNT + e]; ps[e + 1] = ps[e] + (int)(((cnt[e] + 255u) >> 8) << 8); }
    for (int r = gw; r < ps[8]; r += NGW) {
        int e = 0, p0 = 0; unsigned ce = cnt[0];
#pragma unroll
        for (int k = 1; k < 8; ++k) if (r >= ps[k]) { e = k; p0 = ps[k]; ce = cnt[k]; }
        const int pos = r - p0;
        v2u* dst = (v2u*)((unsigned char*)XG + (size_t)r * D) + lane;
        if ((unsigned)pos < ce) { const int t = idx[(size_t)e * T + pos]; const v4u* src = (const v4u*)(H + (size_t)t * D) + lane;
#pragma unroll
            for (int j = 0; j < 4; ++j) { const v4u x = src[64 * j]; v2u o;
                o.x = pg8::pk4_fp8(bflo(x.x) * X8_SCALE, bfhi(x.x) * X8_SCALE, bflo(x.y) * X8_SCALE, bfhi(x.y) * X8_SCALE); o.y = pg8::pk4_fp8(bflo(x.z) * X8_SCALE, bfhi(x.z) * X8_SCALE, bflo(x.w) * X8_SCALE, bfhi(x.w) * X8_SCALE);
                dst[64 * j] = o; } }
        else {
#pragma unroll
            for (int j = 0; j < 4; ++j) dst[64 * j] = (v2u){0u, 0u}; }
    }
}

__device__ __forceinline__ void final_phase(const Frame& F, const float* X, float* OUT, const bf16* YG, const float* topw, const int* slot, const float* gain) {
    const int gw = F.vcu * NWAVES + F.wave, NGW = F.G * NWAVES, lane = F.lane;
    int ps[9]; ps[0] = 0;
#pragma unroll
    for (int e = 0; e < 8; ++e) ps[e + 1] = ps[e] + (int)(((F.ctl[CW_CNT + e] + 255u) >> 8) << 8);
    for (int t = gw; t < T; t += NGW) {
        const int s0 = slot[2 * t], s1 = slot[2 * t + 1]; const float w0 = topw[2 * t], w1 = topw[2 * t + 1];
        int b0 = 0, b1 = 0;
#pragma unroll
        for (int k = 1; k < 8; ++k) { if ((s0 >> 16) == k) b0 = ps[k]; if ((s1 >> 16) == k) b1 = ps[k]; }
        const int r0 = b0 + (s0 & 0xffff), r1 = b1 + (s1 & 0xffff);
        const f32x4* xr = (const f32x4*)(X + (size_t)t * D) + lane; f32x4* outr = (f32x4*)(OUT + (size_t)t * D) + lane; const f32x4* gr = (const f32x4*)gain + lane;
        const v2u* y0 = (const v2u*)(YG + (size_t)r0 * D) + lane; const v2u* y1 = (const v2u*)(YG + (size_t)r1 * D) + lane;
        f32x4 v[8]; float ss = 0.f;
#pragma unroll
        for (int j = 0; j < 8; ++j) { const v2u a = y0[64 * j], bb = y1[64 * j]; f32x4 x = xr[64 * j];
            x.x += w0 * bflo(a.x) + w1 * bflo(bb.x); x.y += w0 * bfhi(a.x) + w1 * bfhi(bb.x); x.z += w0 * bflo(a.y) + w1 * bflo(bb.y); x.w += w0 * bfhi(a.y) + w1 * bfhi(bb.y);
            v[j] = x; ss += (x.x * x.x + x.y * x.y) + (x.z * x.z + x.w * x.w); }
        const float r = __builtin_amdgcn_rsqf(wave_sum(ss) * (1.f / D) + NORM_EPS);
#pragma unroll
        for (int j = 0; j < 8; ++j) outr[64 * j] = v[j] * r * gr[64 * j];
    }
}

constexpr int N_PHASES = 23;
typedef __attribute__((address_space(4))) const Args CArgs;
__device__ __forceinline__ CArgs* get_args() { CArgs* p = (CArgs*)__builtin_amdgcn_kernarg_segment_ptr(); asm volatile("" : "+s"(p)); return p; }
#define WSP(T_, off) ((T_*)(ws + (off)))
__device__ __forceinline__ Frame refresh(const Frame& F0) { Frame F = F0; int t = threadIdx.x; asm volatile("" : "+v"(t)); F.tid = t; F.lane = t & 63; return F; }

__device__ __forceinline__ void phase_prologue(const Frame& F0) {
    const Frame F = refresh(F0);
    CArgs* A = get_args(); unsigned char* ws = A->ws;
    const int gw = F.vcu * NWAVES + F.wave, NGW = F.G * NWAVES;
    LAS float* scr = (LAS float*)(F.lds + RING_OFF + F.wave * 16384);
    constexpr int I_IN = (D / 64) * (NPROJ / 32), I_SQ = (D / 64) * (D / 32), I_GU = (D / 64) * (FFD2 / 32), I_DN = (FFD / 64) * (D / 32);
    constexpr int NITEMS = 3 * I_SQ + I_DN;
    for (int it = F.vcu; it < NPROJ / 32 + FFD2 / 32; it += F.G) {
        LAS float* mxs = (LAS float*)(F.lds + RING_OFF + 12288);
        if (it < NPROJ / 32) win_i8_item(F, A->in[2], (unsigned char*)(ws + WS_WIN), WSP(float, WS_CS), it, mxs);
        else wgu_i8_item(F, A->in[13], A->in[14], FFD, (unsigned char*)(ws + WS_WGU), WSP(float, WS_CSF), it - NPROJ / 32, mxs); }
    for (int it = gw; it < NITEMS; it += NGW) {
        int r = it;
        if (r < 3 * I_SQ) { const int which = r / I_SQ;
            const float* src = (which == 0 ? A->in[9] : which == 1 ? A->in[10] : A->in[11]); bf16* dst = (bf16*)(ws + (which == 0 ? WS_WPG : which == 1 ? WS_WPS : WS_WO));
            tr_plain(src, D, D, dst, r % I_SQ, scr, F.lane); continue; } r -= 3 * I_SQ;
        tr_plain(A->in[15], FFD, D, (bf16*)(ws + WS_WDN), r, scr, F.lane);
    }
    const float* x_in = A->in[0]; const float* gain = A->in[1]; bf16* Hb = WSP(bf16, WS_H);
    for (int m = gw; m < T; m += NGW) rms_row<false, true>(F, x_in + (size_t)m * D, gain, (bf16*)((unsigned char*)Hb + (size_t)m * D), nullptr, m, nullptr, nullptr, WSP(float, WS_RS), nullptr);
}
__device__ __forceinline__ void moe_convert(const Frame& F, int e_lo, int e_hi, int wk, int nwk) {
    CArgs* A = get_args(); unsigned char* ws = A->ws;
    LAS float* scr = (LAS float*)(F.lds + RING_OFF + F.wave * 16384);
    constexpr int I_MGU = (D / 64) * (FFE2 / 32), I_MDN = (FFE / 64) * (D / 32);
    const int gw = wk * NWAVES + F.wave, NGW = nwk * NWAVES, nit = (e_hi - e_lo) * (I_MGU + I_MDN);
    if (e_lo == 0) {
        LAS float* mxs = (LAS float*)(F.lds + RING_OFF + 12288);
        for (int it = wk; it < NPROJ / 32; it += nwk) win_i8_item(F, A->in[2] + (size_t)D * D_IN, (unsigned char*)(ws + WS_WIN + SZ_WIN), WSP(float, WS_CS) + NPROJ, it, mxs);
        constexpr int I_SQ = (D / 64) * (D / 32);
        for (int it = gw; it < 3 * I_SQ; it += NGW) { const int which = it / I_SQ;
            const float* src = (which == 0 ? A->in[9] : which == 1 ? A->in[10] : A->in[11]) + (size_t)D * D; bf16* dst = (bf16*)(ws + (which == 0 ? WS_WPG : which == 1 ? WS_WPS : WS_WO) + SZ_SQ);
            tr_plain(src, D, D, dst, it % I_SQ, scr, F.lane); }
    }
    for (int it = gw; it < nit; it += NGW) {
        int r = it;
        if (r < (e_hi - e_lo) * I_MGU) { const int e = e_lo + r / I_MGU; tr_gu_f8(A->in[17] + (size_t)e * D * FFE, A->in[18] + (size_t)e * D * FFE, D, FFE, (unsigned char*)(ws + WS_MGU) + (size_t)e * FFE2 * D, r % I_MGU, scr, F.lane); continue; }
        r -= (e_hi - e_lo) * I_MGU;
        { const int e = e_lo + r / I_MDN; tr_plain_f8(A->in[19] + (size_t)e * FFE * D, FFE, D, (unsigned char*)(ws + WS_MDN) + (size_t)e * D * FFE, r % I_MDN, scr, F.lane); }
    }
}
template <int LYR> __device__ __forceinline__ void phase_inproj(const Frame& F0) {
    const Frame F = refresh(F0);
    CArgs* A = get_args(); unsigned char* ws = A->ws;
    pg8::Gemm g{WSP(const bf16, WS_H), WSP(const bf16, WS_WIN + LYR * SZ_WIN), T, NPROJ, D / 2}; pg8::StaticOrder S; S.init(T, NPROJ, F.G, (int)blockIdx.x);
    pg8::EpiStoreBf16I8 E{WSP(bf16, WS_R1), NPROJ, WSP(const float, WS_RS), WSP(const float, WS_CS) + LYR * NPROJ};
    pg8::gemm_phase<pg8::EpiStoreBf16I8, pg8::StaticOrder, PG8_ALIGN, PG8_SP2, 2>(F.lds + RING_OFF, g, S, E);
}
template <int LYR> __device__ __forceinline__ void phase_prep(const Frame& F0) {
    const Frame F = refresh(F0);
    CArgs* A = get_args(); unsigned char* ws = A->ws;
    gdn_prep_phase(F, WSP(const bf16, WS_R1), A->in[3] + (size_t)LYR * 4 * 4096, A->in[4] + LYR * 16, A->in[5] + LYR * 16,
                   WSP(bf16, WS_QN), WSP(bf16, WS_WB), WSP(bf16, WS_UTB), WSP(bf16, WS_QKB), WSP(bf16, WS_KTB), WSP(float, WS_EG), WSP(float, WS_EK));
    { CArgs* A2 = get_args(); unsigned char* ws2 = A2->ws;
      swa_phase(F, (const bf16*)(ws2 + WS_R1), A2->in[7] + LYR * 32, A2->in[8], (bf16*)(ws2 + WS_OB)); }
}
template <int LYR> __device__ __forceinline__ void phase_scan(const Frame& F0) {
    const Frame F = refresh(F0);
    const bool split = F.G >= 128; const int bx = (int)blockIdx.x;
    if (!split || bx < NB * 16) { CArgs* A = get_args(); unsigned char* ws = A->ws;
      gdn_scan_phase(F, split ? bx : F.vcu, split ? NB * 16 : F.G, WSP(const bf16, WS_QN), WSP(const bf16, WS_WB), WSP(const bf16, WS_UTB), WSP(const bf16, WS_QKB), WSP(const bf16, WS_KTB), WSP(const float, WS_EG), WSP(const float, WS_EK),
                     WSP(const bf16, WS_R1), A->in[6] + LYR * 128, WSP(bf16, WS_OA)); }
    if (!split || bx >= NB * 16) { const int nwk = split ? F.G - NB * 16 : F.G, wk = split ? bx - NB * 16 : bx;
      moe_convert(F, LYR * (NE / 2), (LYR + 1) * (NE / 2), wk, nwk); }
}
template <int LYR> __device__ __forceinline__ void phase_proj(const Frame& F0) {
    const Frame F = refresh(F0);
    { CArgs* A = get_args(); unsigned char* ws = A->ws;
      pg8::Gemm g{WSP(const bf16, WS_OA), WSP(const bf16, WS_WPG + LYR * SZ_SQ), T, D, D}; pg8::StaticOrder S; S.init(T, D, F.G, (int)blockIdx.x);
      pg8::EpiGateA E{WSP(bf16, WS_Y), D, WSP(const bf16, WS_R1) + CGA, NPROJ};
      pg8::gemm_phase<pg8::EpiGateA, pg8::StaticOrder, PG8_ALIGN, PG8_SP2>(F.lds + RING_OFF, g, S, E); }
    { CArgs* A = get_args(); unsigned char* ws = A->ws;
      pg8::Gemm g{WSP(const bf16, WS_OB), WSP(const bf16, WS_WPS + LYR * SZ_SQ), T, D, D}; pg8::StaticOrder S; S.init(T, D, F.G, (int)blockIdx.x);
      pg8::EpiGateB E{WSP(bf16, WS_Y), D, WSP(const bf16, WS_R1) + CGB, NPROJ};
      pg8::gemm_phase<pg8::EpiGateB, pg8::StaticOrder, PG8_ALIGN, PG8_SP2>(F.lds + RING_OFF, g, S, E); }
}
template <int LYR> __device__ __forceinline__ void phase_out(const Frame& F0) {
    const Frame F = refresh(F0);
    CArgs* A = get_args(); unsigned char* ws = A->ws;
    pg8::Gemm g{WSP(const bf16, WS_Y), WSP(const bf16, WS_WO + LYR * SZ_SQ), T, D, D}; pg8::StaticOrder S; S.init(T, D, F.G, (int)blockIdx.x);
    pg8::EpiResF32 E{LYR == 0 ? A->in[0] : (const float*)A->out, A->pad == 3 ? WSP(float, WS_YP) : A->out, D};
    pg8::gemm_phase<pg8::EpiResF32, pg8::StaticOrder, PG8_ALIGN, PG8_SP2>(F.lds + RING_OFF, g, S, E);
}
template <int LYR> __device__ __forceinline__ void phase_norm2(const Frame& F0) {
    const Frame F = refresh(F0);
    CArgs* A = get_args(); unsigned char* ws = A->ws;
    const int gw = F.vcu * NWAVES + F.wave, NGW = F.G * NWAVES;
    const float* gain = A->in[12] + (size_t)LYR * D; const float* X = A->out; bf16* Hb = WSP(bf16, WS_H);
    if constexpr (LYR == 0) { for (int m = gw; m < T; m += NGW) rms_row<false, true>(F, X + (size_t)m * D, gain, (bf16*)((unsigned char*)Hb + (size_t)m * D), nullptr, m, nullptr, nullptr, WSP(float, WS_RSF), nullptr); }
    else {
        LAS float* rwT = (LAS float*)(F.lds + RING_OFF); const float* rw = A->in[16];
        for (int i = F.tid; i < D * NE; i += NWAVES * 64) { const int cc = i >> 3, e = i & 7; rwT[e * D + cc] = rw[i]; }
        __syncthreads();
        unsigned* CNT = F.ctl + CW_CNT; int* IDX = WSP(int, WS_IDX); float* TOPW = WSP(float, WS_TOPW); int* SLOT = WSP(int, WS_SLOT);
        LAS unsigned* lcnt = (LAS unsigned*)(F.lds + RING_OFF + 65536);
        LAS int* lrec = (LAS int*)lcnt + 16;
        if (F.tid < 16) lcnt[F.tid] = 0u;
        __syncthreads();
        int nrow = 0;
        for (int m = gw; m < T; m += NGW, ++nrow) rms_row<true>(F, X + (size_t)m * D, gain, Hb + (size_t)m * D, rwT, m, CNT, IDX, TOPW, SLOT, (LAS void*)lcnt, nrow * NWAVES + F.wave);
        __syncthreads();
        const bool dry = (A->pad == 3);
        if (F.tid < 8) lcnt[8 + F.tid] = dry ? 0u : atomicAdd(CNT + F.tid, lcnt[F.tid]);
        __syncthreads();
        const int maxrows = (T + NGW - 1) / NGW;
        for (int r = F.tid; r < maxrows * NWAVES; r += NWAVES * 64) { const int i = r / NWAVES, wv = r % NWAVES, m = F.vcu * NWAVES + wv + i * NGW;
            if (m < T && !dry) {
#pragma unroll
                for (int k = 0; k < 2; ++k) { const int rc = lrec[2 * r + k], e = rc >> 16, pos = (int)lcnt[8 + e] + (rc & 0xffff); IDX[(size_t)e * T + pos] = m; SLOT[2 * m + k] = (e << 16) | pos; } } }
        __syncthreads();
    }
}
__device__ __forceinline__ void phase_gather(const Frame& F0) {
    const Frame F = refresh(F0);
    CArgs* A = get_args(); unsigned char* ws = A->ws;
    gather_phase(F, WSP(const bf16, WS_H), WSP(const int, WS_IDX), WSP(bf16, WS_XG), WSP(float, WS_RSX));
}
template <int LYR> __device__ __forceinline__ void phase_up(const Frame& F0) {
    const Frame F = refresh(F0);
    CArgs* A = get_args(); unsigned char* ws = A->ws;
    if constexpr (LYR == 0) {
        pg8::Gemm g{WSP(const bf16, WS_H), WSP(const bf16, WS_WGU), T, FFD2, D / 2}; pg8::StaticOrder S; S.init(T, FFD2, F.G, (int)blockIdx.x);
        pg8::EpiSwiGLUI8<false> E{WSP(void, WS_R1), FFD, WSP(const float, WS_RSF), WSP(const float, WS_CSF), 1.f};
        pg8::gemm_phase<pg8::EpiSwiGLUI8<false>, pg8::StaticOrder, PG8_ALIGN, PG8_SP2, 2>(F.lds + RING_OFF, g, S, E);
    } else {
        pg8::Gemm g{WSP(const bf16, WS_XG), WSP(const bf16, WS_MGU), MOE_ROWS, FFE2, D / 2}; pg8::MoeOrder S; S.init(F.ctl + CW_CNT, FFE2 / 256, F.G, F.vcu, (LAS int*)(F.lds + LDSCTL_OFF + 1024));
        pg8::EpiSwiGLUF8 E{WSP(unsigned char, WS_R1), FFE, H8_SCALE};
        pg8::gemm_phase<pg8::EpiSwiGLUF8, pg8::MoeOrder, PG8_ALIGN, PG8_SP2, 1>(F.lds + RING_OFF, g, S, E, W8_E8M0, X8_E8M0);
    }
}
template <int LYR> __device__ __forceinline__ void phase_down(const Frame& F0) {
    const Frame F = refresh(F0);
    CArgs* A = get_args(); unsigned char* ws = A->ws;
    if constexpr (LYR == 0) {
        pg8::Gemm g{WSP(const bf16, WS_R1), WSP(const bf16, WS_WDN), T, D, FFD}; pg8::StaticOrder S; S.init(T, D, F.G, (int)blockIdx.x);
        pg8::EpiResF32 E{A->out, A->pad == 3 ? WSP(float, WS_YP) : A->out, D};
        pg8::gemm_phase<pg8::EpiResF32, pg8::StaticOrder, PG8_ALIGN, PG8_SP2>(F.lds + RING_OFF, g, S, E);
    } else {
        pg8::Gemm g{WSP(const bf16, WS_R1), WSP(const bf16, WS_MDN), MOE_ROWS, D, FFE / 2}; pg8::MoeOrder S; S.init(F.ctl + CW_CNT, D / 256, F.G, F.vcu, (LAS int*)(F.lds + LDSCTL_OFF + 1024));
        pg8::EpiStoreBf16 E{WSP(bf16, WS_YG), D};
        pg8::gemm_phase<pg8::EpiStoreBf16, pg8::MoeOrder, PG8_ALIGN, PG8_SP2, 1>(F.lds + RING_OFF, g, S, E, W8_E8M0, H8_E8M0);
    }
}
template <int LYR> __device__ __forceinline__ void phase_tail(const Frame& F0) {
    const Frame F = refresh(F0);
    CArgs* A = get_args(); unsigned char* ws = A->ws;
    if constexpr (LYR == 0) {
        const int gw = F.vcu * NWAVES + F.wave, NGW = F.G * NWAVES; const float* X = A->out; const float* gain = A->in[1] + D; bf16* Hb = WSP(bf16, WS_H);
        for (int m = gw; m < T; m += NGW) rms_row<false, true>(F, X + (size_t)m * D, gain, (bf16*)((unsigned char*)Hb + (size_t)m * D), nullptr, m, nullptr, nullptr, WSP(float, WS_RS), nullptr);
    } else final_phase(F, A->out, A->pad == 3 ? WSP(float, WS_YP) : A->out, WSP(const bf16, WS_YG), WSP(const float, WS_TOPW), WSP(const int, WS_SLOT), A->in[20]);
}

#define IN(k) (lo <= (k) && (k) < hi)
#define SEAM(k) do { if (IN(k) && IN((k) + 1)) xcd_barrier(bar); } while (0)
template <int LYR> __device__ __forceinline__ void layer_body(const Frame& F, const XcdBarrier& bar, const int lo, const int hi) {
    constexpr int pb = 1 + 11 * LYR;
    if (IN(pb + 0)) DUP(1, phase_inproj<LYR>(F));
    SEAM(pb + 0);
    if (IN(pb + 1)) DUP(2, phase_prep<LYR>(F));
    SEAM(pb + 1);
    if (IN(pb + 2)) DUP(3, phase_scan<LYR>(F));
    SEAM(pb + 2);
    if (IN(pb + 4)) DUP(5, phase_proj<LYR>(F));
    SEAM(pb + 4);
    if (IN(pb + 5)) phase_out<LYR>(F);
    SEAM(pb + 5);
    if (IN(pb + 6)) { phase_norm2<LYR>(F); if constexpr (LYR == 0) { if ((DUPMASK >> 6) & 1) phase_norm2<LYR>(F); } }
    SEAM(pb + 6);
    if constexpr (LYR == 1) { if (IN(pb + 7)) DUP(7, phase_gather(F)); SEAM(pb + 7); }
    if (IN(pb + 8)) DUP(9 + LYR, phase_up<LYR>(F));
    SEAM(pb + 8);
    if (IN(pb + 9)) { phase_down<LYR>(F); if constexpr (LYR == 1) { if ((DUPMASK >> 11) & 1) phase_down<LYR>(F); } }
    SEAM(pb + 9);
    if (IN(pb + 10)) { phase_tail<LYR>(F); if constexpr (LYR == 0) { if ((DUPMASK >> 14) & 1) phase_tail<LYR>(F); } }
    if constexpr (LYR == 0) SEAM(pb + 10);
}

__global__ void __launch_bounds__(NWAVES * 64, 2) hybrid_fwd(Args args) {
    extern __shared__ __attribute__((aligned(16))) unsigned char lds[];
    Frame F;
    F.lds = (LAS unsigned char*)lds;
    F.MISC = (volatile LAS unsigned*)(F.lds + MISC_OFF);
    F.tid = threadIdx.x; F.lane = F.tid & 63; F.wave = __builtin_amdgcn_readfirstlane(F.tid >> 6);
    F.G = gridDim.x; { const int bx = blockIdx.x; F.vcu = (F.G % 8 == 0) ? (bx % 8) * (F.G / 8) + bx / 8 : bx; }
    F.ctl = (unsigned*)(args.ws + WS_CTL);
    for (int u = F.tid; u < (LDS_BYTES - LDSCTL_OFF) / 4; u += NWAVES * 64) ((LAS unsigned*)(F.lds + LDSCTL_OFF))[u] = 0u;
    __syncthreads();
    const int lo = args.ph_lo, hi = args.ph_hi;
    XcdBarrier bar; bar.bar = F.ctl + CW_BAR; bar.x = 0; bar.st = nullptr;
    if (hi - lo > 1) bar = xcd_barrier_post(F.ctl + CW_BAR, F.MISC + 8);
    if (IN(0)) DUP(0, phase_prologue(F));
    SEAM(0);
    layer_body<0>(F, bar, lo, hi);
    layer_body<1>(F, bar, lo, hi);
}
#undef IN
#undef SEAM

extern "C" void kernel_launch(void* const* d_in, const int* in_sizes, int n_in, void* d_out, int out_size, void* d_ws, size_t ws_size, hipStream_t stream) {
    static int grid = 0;
    if (grid == 0) {
        if (n_in != 21 || out_size != T * D || ws_size < WS_END) { fprintf(stderr, "kernel_launch: unexpected shapes (n_in %d out %d ws %zu need %zu)\n", n_in, out_size, ws_size, (size_t)WS_END); grid = -1; return; }
        int dev = 0, cus = 0, per_cu = 0;
        if (hipGetDevice(&dev) != hipSuccess || hipDeviceGetAttribute(&cus, hipDeviceAttributeMultiprocessorCount, dev) != hipSuccess) { grid = -1; return; }
        if (hipFuncSetAttribute((const void*)hybrid_fwd, hipFuncAttributeMaxDynamicSharedMemorySize, LDS_BYTES) != hipSuccess) { fprintf(stderr, "kernel_launch: hipFuncSetAttribute failed\n"); grid = -1; return; }
        if (hipOccupancyMaxActiveBlocksPerMultiprocessor(&per_cu, (const void*)hybrid_fwd, NWAVES * 64, LDS_BYTES) != hipSuccess || per_cu < 1) { fprintf(stderr, "kernel_launch: occupancy query says %d\n", per_cu); }
        (void)hipGetLastError();
        grid = cus;
    }
    if (grid < 0) return;
    if (hipMemsetAsync((char*)d_ws + WS_CTL, 0, CTL_ZERO_BYTES, stream) != hipSuccess) return;
    Args a{};
    for (int i = 0; i < 21; ++i) a.in[i] = (const float*)d_in[i];
    a.out = (float*)d_out; a.ws = (unsigned char*)d_ws; a.pad = 0;
#if MK_ONE_LAUNCH
    a.ph_lo = 0; a.ph_hi = N_PHASES; a.li = 0;
    hipLaunchKernelGGL(hybrid_fwd, dim3(grid), dim3(NWAVES * 64), LDS_BYTES, stream, a);
#else
    for (int p = 0; p < N_PHASES; ++p) {
        if (p == 8 || p == 4 || p == 15) continue;
        a.ph_lo = p; a.ph_hi = p + 1; a.li = 0; a.pad = 0;
        if (p == PROBE_PHASE) { if (p == 10 || p == 17 || p == 18 || p == 22) { a.pad = 3; hipLaunchKernelGGL(hybrid_fwd, dim3(grid), dim3(NWAVES * 64), LDS_BYTES, stream, a); a.pad = 0; }
                                else hipLaunchKernelGGL(hybrid_fwd, dim3(grid), dim3(NWAVES * 64), LDS_BYTES, stream, a); }
        hipLaunchKernelGGL(hybrid_fwd, dim3(grid), dim3(NWAVES * 64), LDS_BYTES, stream, a);
    }
#endif
}
```

```cpp
#include <hip/hip_runtime.h>
#include <cstdio>
#include <cstdint>

#ifndef MK_ONE_LAUNCH
#define MK_ONE_LAUNCH 1
#endif
#ifndef PROBE_PHASE
#define PROBE_PHASE -1
#endif
#ifndef PROF_PHASE
#define PROF_PHASE -1
#endif
#define PROF_MARK(k) do { if (PROF_PHASE >= 0 && blockIdx.x == 0 && threadIdx.x == 0) { const unsigned long long now_ = __builtin_amdgcn_s_memrealtime(); \
        volatile LAS unsigned* pm_ = F.MISC + 16; const unsigned long long prev_ = ((unsigned long long)pm_[1] << 32) | pm_[0]; \
        if ((k) == PROF_PHASE) { const unsigned long long d_ = now_ - prev_; pm_[2] = (unsigned)d_; pm_[3] = (unsigned)(d_ >> 32); } \
        pm_[0] = (unsigned)now_; pm_[1] = (unsigned)(now_ >> 32); } } while (0)
#ifndef CONV_WGS
#define CONV_WGS 128
#endif
#ifndef DUPMASK
#define DUPMASK 0
#endif
#define DUP(k, call) do { call; if ((DUPMASK >> (k)) & 1) { call; } } while (0)

namespace pg8 {
#define PG8_LAS __attribute__((address_space(3)))
typedef unsigned short bf16_t;
typedef short bf16x8 __attribute__((ext_vector_type(8)));
typedef float f32x4 __attribute__((ext_vector_type(4)));
typedef float f32x2 __attribute__((ext_vector_type(2)));
typedef unsigned u32x4 __attribute__((ext_vector_type(4)));
typedef unsigned u32x2 __attribute__((ext_vector_type(2)));
typedef __bf16 bfx2_t __attribute__((ext_vector_type(2)));
typedef int i32x8 __attribute__((ext_vector_type(8)));
typedef int i32x4v __attribute__((ext_vector_type(4)));
constexpr int BM = 256, BK = 64, HALF = 128, HTB = HALF * BK * 2, STAGE_BYTES = 8 * HTB, NXCD = 8, WGM = 8;

__host__ __device__ __forceinline__ int lds_byte(int r, int c) { const int st = (r >> 4) * 2 + (c >> 5), rr = r & 15, cc = c & 31, ob = rr * 64 + cc * 2; return st * 1024 + (ob ^ (((ob >> 9) & 1) << 5)); }
__host__ __device__ __forceinline__ void stage_rc(int b, int& R, int& C) { const int st = b / 1024, sb = b % 1024, swz = sb ^ (((sb >> 9) & 1) << 5); R = (st >> 1) * 16 + swz / 64; C = (st & 1) * 32 + (swz % 64) / 2; }
__host__ __device__ __forceinline__ int perm32(int rho) { const int n = rho >> 4, i = rho & 15; return 8 * (i >> 2) + 4 * n + (i & 3); }

__device__ __forceinline__ unsigned pk2(float lo, float hi) { f32x2 v = {lo, hi}; return __builtin_bit_cast(unsigned, __builtin_convertvector(v, bfx2_t)); }
__device__ __forceinline__ float bflo(unsigned w) { return __builtin_bit_cast(float, w << 16); }
__device__ __forceinline__ float bfhi(unsigned w) { return __builtin_bit_cast(float, w & 0xffff0000u); }
__device__ __forceinline__ float fsigmoid(float x) { return __builtin_amdgcn_rcpf(1.0f + __expf(-x)); }

__device__ __forceinline__ unsigned pk4_fp8(float a, float b, float c, float d) { unsigned w = 0; w = __builtin_amdgcn_cvt_pk_fp8_f32(a, b, w, false); w = __builtin_amdgcn_cvt_pk_fp8_f32(c, d, w, true); return w; }
struct Unit { int pm, pn, pnb; };
struct Gemm { const bf16_t* A; const bf16_t* Bt; int M, N, K; };

struct StaticOrder {
    int nM, nN, nwg, G, c;
    __host__ __device__ void init(int M, int N, int G_, int c_) { nM = M / BM; nN = N / BM; nwg = nM * nN; G = G_; c = c_; }
    __host__ __device__ bool next(int i, Unit& u) const {
        const long L = (long)i * G + c; if (L >= nwg) return false;
        int wgid = (int)L; { const int q = nwg / NXCD, r = nwg % NXCD, xcd = wgid % NXCD, off = wgid / NXCD; wgid = (xcd < r ? xcd * (q + 1) : r * (q + 1) + (xcd - r) * q) + off; }
        const int nig = WGM * nN, gid = wgid / nig, fm = gid * WGM, gsz = (nM - fm) < WGM ? (nM - fm) : WGM;
        u.pm = fm + ((wgid % nig) % gsz); u.pn = (wgid % nig) / gsz; u.pnb = u.pn; return true;
    }
    __device__ __forceinline__ void a_ready(const Unit&) const {}
    __device__ __forceinline__ void done(const Unit&) const {}
};
struct MoeOrder {
    int G, c, nN; const PG8_LAS int* tab;
    __device__ __forceinline__ void init(const unsigned* cnt, int nN_, int G_, int c_, PG8_LAS int* tab_) {
        G = G_; c = c_; nN = nN_; tab = tab_;
        if (threadIdx.x == 0) { int us = 0, bs = 0; tab_[0] = 0; tab_[16] = 0;
            for (int e = 0; e < 8; ++e) { const int nb = (int)((cnt[e] + 255u) >> 8); bs += nb; us += nb * nN_; tab_[e + 1] = us; tab_[17 + e] = bs; } }
        __syncthreads();
    }
    __device__ __forceinline__ bool next(int i, Unit& u) const {
        const int L = i * G + c; if (L >= tab[8]) return false;
        int e = 0;
#pragma unroll
        for (int k = 1; k < 8; ++k) e += (L >= tab[k]) ? 1 : 0;
        const int us = tab[e], bs = tab[16 + e], nbe = tab[17 + e] - bs;
        const int r = L - us, pn = r / nbe, blk = r - pn * nbe;
        u.pm = __builtin_amdgcn_readfirstlane(bs + blk); u.pn = __builtin_amdgcn_readfirstlane(pn); u.pnb = __builtin_amdgcn_readfirstlane(e * nN + pn); return true;
    }
    __device__ __forceinline__ void a_ready(const Unit&) const {}
    __device__ __forceinline__ void done(const Unit&) const {}
};

struct EpiStoreBf16 {
    static constexpr bool PERM = true, AFTER_DRAIN = false;
    bf16_t* O; int ldc;
    __device__ __forceinline__ void operator()(const f32x4 (&acc)[2][2][4][2], const Unit& u, int wr, int wc, int fr, int fq) const {
        const int row0 = u.pm * BM + wr * 64 + fr, col0 = u.pn * BM + wc * 32 + 8 * fq;
#pragma unroll
        for (int ai = 0; ai < 2; ++ai)
#pragma unroll
            for (int m = 0; m < 4; ++m) { bf16_t* rowp = O + (size_t)(row0 + ai * HALF + m * 16) * ldc + col0;
#pragma unroll
                for (int bj = 0; bj < 2; ++bj) { const f32x4 v0 = acc[ai][bj][m][0], v1 = acc[ai][bj][m][1];
                    u32x4 w; w.x = pk2(v0[0], v0[1]); w.y = pk2(v0[2], v0[3]); w.z = pk2(v1[0], v1[1]); w.w = pk2(v1[2], v1[3]);
                    *(u32x4*)(rowp + bj * HALF) = w; } }
    }
};
struct EpiStoreBf16I8 {
    static constexpr bool PERM = true, AFTER_DRAIN = false;
    bf16_t* O; int ldc; const float* rs; const float* cs;
    __device__ __forceinline__ void operator()(const f32x4 (&acc)[2][2][4][2], const Unit& u, int wr, int wc, int fr, int fq) const {
        const int row0 = u.pm * BM + wr * 64 + fr, col0 = u.pn * BM + wc * 32 + 8 * fq;
        f32x4 cv[2][2];
#pragma unroll
        for (int bj = 0; bj < 2; ++bj)
#pragma unroll
            for (int n = 0; n < 2; ++n) cv[bj][n] = *(const f32x4*)(cs + col0 + bj * HALF + 4 * n);
        float rsv[2][4];
#pragma unroll
        for (int ai = 0; ai < 2; ++ai)
#pragma unroll
            for (int m = 0; m < 4; ++m) rsv[ai][m] = rs[row0 + ai * HALF + m * 16];
#pragma unroll
        for (int ai = 0; ai < 2; ++ai)
#pragma unroll
            for (int m = 0; m < 4; ++m) { const int row = row0 + ai * HALF + m * 16; const float r = rsv[ai][m]; bf16_t* rowp = O + (size_t)row * ldc + col0;
#pragma unroll
                for (int bj = 0; bj < 2; ++bj) { const i32x4v a0 = __builtin_bit_cast(i32x4v, acc[ai][bj][m][0]), a1 = __builtin_bit_cast(i32x4v, acc[ai][bj][m][1]);
                    const f32x4 v0 = __builtin_convertvector(a0, f32x4) * cv[bj][0] * r, v1 = __builtin_convertvector(a1, f32x4) * cv[bj][1] * r;
                    u32x4 w; w.x = pk2(v0[0], v0[1]); w.y = pk2(v0[2], v0[3]); w.z = pk2(v1[0], v1[1]); w.w = pk2(v1[2], v1[3]);
                    *(u32x4*)(rowp + bj * HALF) = w; } }
    }
};
struct EpiSwiGLUF8 {
    static constexpr bool PERM = true, AFTER_DRAIN = false;
    unsigned char* Hd; int ldc; float osc;
    __device__ __forceinline__ void operator()(const f32x4 (&acc)[2][2][4][2], const Unit& u, int wr, int wc, int fr, int fq) const {
        const int row0 = u.pm * BM + wr * 64 + fr, col0 = u.pn * HALF + wc * 32 + 8 * fq;
#pragma unroll
        for (int ai = 0; ai < 2; ++ai)
#pragma unroll
            for (int m = 0; m < 4; ++m) { unsigned char* rowp = Hd + (size_t)(row0 + ai * HALF + m * 16) * ldc + col0;
                float o[8];
#pragma unroll
                for (int n = 0; n < 2; ++n)
#pragma unroll
                    for (int i = 0; i < 4; ++i) { const float g = acc[ai][0][m][n][i], up = acc[ai][1][m][n][i]; o[4 * n + i] = g * up * fsigmoid(g) * osc; }
                u32x2 w; w.x = pk4_fp8(o[0], o[1], o[2], o[3]); w.y = pk4_fp8(o[4], o[5], o[6], o[7]);
                *(u32x2*)rowp = w; }
    }
};
template <bool OUTF8> struct EpiSwiGLUI8 {
    static constexpr bool PERM = true, AFTER_DRAIN = false;
    void* Hd; int ldc; const float* rs; const float* cs; float osc;
    __device__ __forceinline__ void operator()(const f32x4 (&acc)[2][2][4][2], const Unit& u, int wr, int wc, int fr, int fq) const {
        const int row0 = u.pm * BM + wr * 64 + fr, col0 = u.pn * HALF + wc * 32 + 8 * fq, ccol = u.pnb * BM + wc * 32 + 8 * fq;
        f32x4 cv[2][2]; float rsv[2][4];
#pragma unroll
        for (int bj = 0; bj < 2; ++bj)
#pragma unroll
            for (int n = 0; n < 2; ++n) cv[bj][n] = *(const f32x4*)(cs + ccol + bj * HALF + 4 * n);
#pragma unroll
        for (int ai = 0; ai < 2; ++ai)
#pragma unroll
            for (int m = 0; m < 4; ++m) rsv[ai][m] = rs[row0 + ai * HALF + m * 16];
#pragma unroll
        for (int ai = 0; ai < 2; ++ai)
#pragma unroll
            for (int m = 0; m < 4; ++m) { const int row = row0 + ai * HALF + m * 16; const float r = rsv[ai][m];
                float o[8];
#pragma unroll
                for (int n = 0; n < 2; ++n) { const f32x4 gv = __builtin_convertvector(__builtin_bit_cast(i32x4v, acc[ai][0][m][n]), f32x4) * cv[0][n] * r, uv = __builtin_convertvector(__builtin_bit_cast(i32x4v, acc[ai][1][m][n]), f32x4) * cv[1][n] * r;
#pragma unroll
                    for (int i = 0; i < 4; ++i) o[4 * n + i] = gv[i] * uv[i] * fsigmoid(gv[i]); }
                if constexpr (OUTF8) { u32x2 w; w.x = pk4_fp8(o[0] * osc, o[1] * osc, o[2] * osc, o[3] * osc); w.y = pk4_fp8(o[4] * osc, o[5] * osc, o[6] * osc, o[7] * osc);
                    *(u32x2*)((unsigned char*)Hd + (size_t)row * ldc + col0) = w; }
                else { u32x4 w; w.x = pk2(o[0], o[1]); w.y = pk2(o[2], o[3]); w.z = pk2(o[4], o[5]); w.w = pk2(o[6], o[7]); *(u32x4*)((bf16_t*)Hd + (size_t)row * ldc + col0) = w; } }
    }
};
struct EpiResF32 {
    static constexpr bool PERM = false, AFTER_DRAIN = false;
    const float* base; float* out; int ldc;
    __device__ __forceinline__ void operator()(const f32x4 (&acc)[2][2][4][2], const Unit& u, int wr, int wc, int fr, int fq) const {
        const int row0 = u.pm * BM + wr * 64 + fr, col0 = u.pn * BM + wc * 32 + 4 * fq;
#pragma unroll
        for (int ai = 0; ai < 2; ++ai) {
            f32x4 b[4][2][2];
#pragma unroll
            for (int m = 0; m < 4; ++m) { const size_t off = (size_t)(row0 + ai * HALF + m * 16) * ldc + col0;
#pragma unroll
                for (int bj = 0; bj < 2; ++bj)
#pragma unroll
                    for (int n = 0; n < 2; ++n) b[m][bj][n] = *(const f32x4*)(base + off + bj * HALF + n * 16); }
            asm volatile("" ::: "memory");
#pragma unroll
            for (int m = 0; m < 4; ++m) { const size_t off = (size_t)(row0 + ai * HALF + m * 16) * ldc + col0;
#pragma unroll
                for (int bj = 0; bj < 2; ++bj)
#pragma unroll
                    for (int n = 0; n < 2; ++n) *(f32x4*)(out + off + bj * HALF + n * 16) = b[m][bj][n] + acc[ai][bj][m][n]; }
            asm volatile("" ::: "memory");
        }
    }
};
struct EpiGateA {
    static constexpr bool PERM = true, AFTER_DRAIN = false;
    bf16_t* Y; int ldc; const bf16_t* gate; int ldg;
    __device__ __forceinline__ void operator()(const f32x4 (&acc)[2][2][4][2], const Unit& u, int wr, int wc, int fr, int fq) const {
        const int row0 = u.pm * BM + wr * 64 + fr, col0 = u.pn * BM + wc * 32 + 8 * fq;
        u32x4 gws[2][4][2];
#pragma unroll
        for (int ai = 0; ai < 2; ++ai)
#pragma unroll
            for (int m = 0; m < 4; ++m)
#pragma unroll
                for (int bj = 0; bj < 2; ++bj) gws[ai][m][bj] = *(const u32x4*)(gate + (size_t)(row0 + ai * HALF + m * 16) * ldg + col0 + bj * HALF);
        asm volatile("" ::: "memory");
#pragma unroll
        for (int ai = 0; ai < 2; ++ai)
#pragma unroll
            for (int m = 0; m < 4; ++m) { const int row = row0 + ai * HALF + m * 16;
#pragma unroll
                for (int bj = 0; bj < 2; ++bj) { const u32x4 gw = gws[ai][m][bj];
                    const f32x4 v0 = acc[ai][bj][m][0], v1 = acc[ai][bj][m][1];
                    u32x4 w;
                    w.x = pk2(v0[0] * fsigmoid(bflo(gw.x)), v0[1] * fsigmoid(bfhi(gw.x))); w.y = pk2(v0[2] * fsigmoid(bflo(gw.y)), v0[3] * fsigmoid(bfhi(gw.y)));
                    w.z = pk2(v1[0] * fsigmoid(bflo(gw.z)), v1[1] * fsigmoid(bfhi(gw.z))); w.w = pk2(v1[2] * fsigmoid(bflo(gw.w)), v1[3] * fsigmoid(bfhi(gw.w)));
                    *(u32x4*)(Y + (size_t)row * ldc + col0 + bj * HALF) = w; } }
    }
};
struct EpiGateB {
    static constexpr bool PERM = true, AFTER_DRAIN = false;
    bf16_t* Y; int ldc; const bf16_t* gate; int ldg;
    __device__ __forceinline__ void operator()(const f32x4 (&acc)[2][2][4][2], const Unit& u, int wr, int wc, int fr, int fq) const {
        const int row0 = u.pm * BM + wr * 64 + fr, col0 = u.pn * BM + wc * 32 + 8 * fq;
#pragma unroll
        for (int ai = 0; ai < 2; ++ai) {
            u32x4 gws[4][2], pp[4][2];
#pragma unroll
            for (int m = 0; m < 4; ++m)
#pragma unroll
                for (int bj = 0; bj < 2; ++bj) { const int row = row0 + ai * HALF + m * 16; gws[m][bj] = *(const u32x4*)(gate + (size_t)row * ldg + col0 + bj * HALF); pp[m][bj] = *(const u32x4*)(Y + (size_t)row * ldc + col0 + bj * HALF); }
            asm volatile("" ::: "memory");
#pragma unroll
            for (int m = 0; m < 4; ++m) { const int row = row0 + ai * HALF + m * 16;
#pragma unroll
                for (int bj = 0; bj < 2; ++bj) { const u32x4 gw = gws[m][bj], p = pp[m][bj];
                    const f32x4 v0 = acc[ai][bj][m][0], v1 = acc[ai][bj][m][1];
                    u32x4 w;
                    w.x = pk2(bflo(p.x) + v0[0] * fsigmoid(bflo(gw.x)), bfhi(p.x) + v0[1] * fsigmoid(bfhi(gw.x))); w.y = pk2(bflo(p.y) + v0[2] * fsigmoid(bflo(gw.y)), bfhi(p.y) + v0[3] * fsigmoid(bfhi(gw.y)));
                    w.z = pk2(bflo(p.z) + v1[0] * fsigmoid(bflo(gw.z)), bfhi(p.z) + v1[1] * fsigmoid(bfhi(gw.z))); w.w = pk2(bflo(p.w) + v1[2] * fsigmoid(bflo(gw.w)), bfhi(p.w) + v1[3] * fsigmoid(bfhi(gw.w)));
                    *(u32x4*)(Y + (size_t)row * ldc + col0 + bj * HALF) = w; } }
            asm volatile("" ::: "memory");
        }
    }
};

template <class Epi, class Sched, bool ALIGN_EPI = false, bool SP2 = false, int MODE = 0  >
__device__ __forceinline__ void gemm_phase(PG8_LAS unsigned char* lds, const Gemm g, const Sched& S, const Epi& E, const int sw = 0x7f7f7f7f, const int sa = 0x7f7f7f7f) {
    constexpr bool F8 = (MODE == 1);
    const int tid = threadIdx.x, wid = __builtin_amdgcn_readfirstlane(tid >> 6), lane = tid & 63, wr = wid >> 2, wc = wid & 3, fr = lane & 15, fq = lane >> 4;
    const int K = g.K, nt = K / BK;
    unsigned voffA, voffB;
    { int R, C; stage_rc(tid * 16, R, C); const int Rb = Epi::PERM ? ((R & ~31) + perm32(R & 31)) : R;
      voffA = (unsigned)(R * K + C) * 2u; voffB = (unsigned)(Rb * K + C) * 2u; }
    const unsigned rstep = 64u * (unsigned)K * 2u;
    const unsigned kstep = (unsigned)(BK * 2);
    const unsigned hstep = (unsigned)HALF * (unsigned)K * 2u;
    const unsigned tstep = 2u * hstep;
    const __amdgpu_buffer_rsrc_t rsA = __builtin_amdgcn_make_buffer_rsrc((void*)g.A, 0, 0xFFFFFFFF, 0x00020000), rsB = __builtin_amdgcn_make_buffer_rsrc((void*)g.Bt, 0, 0xFFFFFFFF, 0x00020000);
    const unsigned ldsw = (unsigned)wid * 1024u;
    const int aoff = lds_byte(wr * 64 + fr, fq * 8), boff = lds_byte(wc * 32 + fr, fq * 8);
#define PG8_SA(b, h) (((b) * 2 + (h)) * HTB)
#define PG8_SB(b, h) ((4 + (b) * 2 + (h)) * HTB)
#define PG8_STAGE(bufoff, rs, soff, voff) do { _Pragma("unroll") for (int _i = 0; _i < 2; ++_i) \
        __builtin_amdgcn_raw_ptr_buffer_load_lds(rs, (PG8_LAS void*)(lds + (bufoff) + ldsw + _i * 8192), 16, (int)(voff), (int)((soff) + _i * rstep), 0, 0); } while (0)
#define PG8_LD8(p_) __builtin_shufflevector(*(const PG8_LAS i32x4v*)(p_), *(const PG8_LAS i32x4v*)((p_) + 1024), 0, 1, 2, 3, 4, 5, 6, 7)
#define PG8_LDA(dst, b, h) do { _Pragma("unroll") for (int m = 0; m < 4; ++m) { if constexpr (F8) dst##8[m] = PG8_LD8(lds + PG8_SA(b, h) + aoff + m * 2048); \
        else { _Pragma("unroll") for (int k = 0; k < 2; ++k) dst[m][k] = *(const PG8_LAS bf16x8*)(lds + PG8_SA(b, h) + aoff + m * 2048 + k * 1024); } } } while (0)
#define PG8_LDB(dst, b, h) do { _Pragma("unroll") for (int n = 0; n < 2; ++n) { if constexpr (F8) dst##8[n] = PG8_LD8(lds + PG8_SB(b, h) + boff + n * 2048); \
        else { _Pragma("unroll") for (int k = 0; k < 2; ++k) dst[n][k] = *(const PG8_LAS bf16x8*)(lds + PG8_SB(b, h) + boff + n * 2048 + k * 1024); } } } while (0)
#define PG8_CAT(x0, x1) __builtin_shufflevector(__builtin_bit_cast(i32x4v, x0), __builtin_bit_cast(i32x4v, x1), 0, 1, 2, 3, 4, 5, 6, 7)
#define PG8_MMA(ai, bj, At, Bt) do { __builtin_amdgcn_s_setprio(1); _Pragma("unroll") for (int m = 0; m < 4; ++m) _Pragma("unroll") for (int n = 0; n < 2; ++n) { \
        if constexpr (F8) acc[ai][bj][m][n] = __builtin_amdgcn_mfma_scale_f32_16x16x128_f8f6f4(Bt##8[n], At##8[m], acc[ai][bj][m][n], 0, 0, 0, sw, 0, sa); \
        else if constexpr (MODE == 2) { _Pragma("unroll") for (int k = 0; k < 2; ++k) acc[ai][bj][m][n] = __builtin_bit_cast(f32x4, __builtin_amdgcn_mfma_i32_16x16x64_i8(__builtin_bit_cast(i32x4v, Bt[n][k]), __builtin_bit_cast(i32x4v, At[m][k]), __builtin_bit_cast(i32x4v, acc[ai][bj][m][n]), 0, 0, 0)); } \
        else { _Pragma("unroll") for (int k = 0; k < 2; ++k) acc[ai][bj][m][n] = __builtin_amdgcn_mfma_f32_16x16x32_bf16(Bt[n][k], At[m][k], acc[ai][bj][m][n], 0, 0, 0); } } \
        __builtin_amdgcn_s_setprio(0); } while (0)
#define PG8_WAIT_V(n) asm volatile("s_waitcnt vmcnt(" #n ")" ::: "memory")
#define PG8_WAIT_L(n) asm volatile("s_waitcnt lgkmcnt(" #n ")" ::: "memory")
#define PG8_BAR __builtin_amdgcn_s_barrier()
#define PG8_SCHED __builtin_amdgcn_sched_barrier(0)
    Unit cur, nxt; int ui = 0;
    if (!S.next(0, cur)) return;
    f32x4 acc[2][2][4][2];
#pragma unroll
    for (int a = 0; a < 2; ++a)
#pragma unroll
        for (int b = 0; b < 2; ++b)
#pragma unroll
            for (int m = 0; m < 4; ++m)
#pragma unroll
                for (int n = 0; n < 2; ++n) acc[a][b][m][n] = (f32x4){0.f, 0.f, 0.f, 0.f};
    bf16x8 At[4][2], B0[2][2], B1[2][2]; i32x8 At8[4], B08[2], B18[2];
    unsigned cA = (unsigned)cur.pm * tstep, cB = (unsigned)cur.pnb * tstep;
    S.a_ready(cur);
    if constexpr (SP2) {
        PG8_STAGE(PG8_SB(0, 0), rsB, cB, voffB); PG8_STAGE(PG8_SB(0, 1), rsB, cB + hstep, voffB); PG8_STAGE(PG8_SA(0, 0), rsA, cA, voffA); PG8_STAGE(PG8_SA(0, 1), rsA, cA + hstep, voffA);
        if (wr == 1) PG8_BAR;
        PG8_WAIT_V(2); PG8_BAR;
        PG8_STAGE(PG8_SB(1, 0), rsB, cB + kstep, voffB); PG8_STAGE(PG8_SA(1, 0), rsA, cA + kstep, voffA); PG8_STAGE(PG8_SB(1, 1), rsB, cB + hstep + kstep, voffB);
        PG8_WAIT_V(6); PG8_BAR;
    } else {
        PG8_STAGE(PG8_SB(0, 0), rsB, cB, voffB); PG8_STAGE(PG8_SA(0, 0), rsA, cA, voffA); PG8_STAGE(PG8_SB(0, 1), rsB, cB + hstep, voffB); PG8_STAGE(PG8_SA(0, 1), rsA, cA + hstep, voffA);
        if (wr == 1) PG8_BAR;
        PG8_WAIT_V(4); PG8_BAR;
        PG8_STAGE(PG8_SB(1, 0), rsB, cB + kstep, voffB); PG8_STAGE(PG8_SA(1, 0), rsA, cA + kstep, voffA); PG8_STAGE(PG8_SB(1, 1), rsB, cB + hstep + kstep, voffB);
        PG8_WAIT_V(6); PG8_BAR;
    }
    for (;;) {
        const bool has_next = S.next(ui + 1, nxt);
        const unsigned nA = has_next ? (unsigned)nxt.pm * tstep : cA, nB = has_next ? (unsigned)nxt.pnb * tstep : cB;
        for (int t = 0; t < nt; t += 2) {
            const bool last = (t == nt - 2);
            const unsigned a1 = cA + (unsigned)(t + 1) * kstep;
            const unsigned a2 = last ? nA : cA + (unsigned)(t + 2) * kstep, b2 = last ? nB : cB + (unsigned)(t + 2) * kstep;
            const unsigned a3 = a2 + kstep, b3 = b2 + kstep;
            if (last && has_next) S.a_ready(nxt);
            if constexpr (SP2) {
            PG8_LDB(B0, 0, 0); PG8_LDB(B1, 0, 1); PG8_SCHED; PG8_LDA(At, 0, 0); PG8_STAGE(PG8_SA(1, 1), rsA, a1 + hstep, voffA);
            PG8_WAIT_V(8); PG8_WAIT_L(0); PG8_BAR; PG8_MMA(0, 0, At, B0); PG8_MMA(0, 1, At, B1); PG8_BAR; PG8_SCHED;
            PG8_LDA(At, 0, 1); PG8_STAGE(PG8_SB(0, 0), rsB, b2, voffB); PG8_STAGE(PG8_SB(0, 1), rsB, b2 + hstep, voffB); PG8_STAGE(PG8_SA(0, 0), rsA, a2, voffA);
            PG8_WAIT_V(8); PG8_WAIT_L(0); PG8_BAR; PG8_MMA(1, 0, At, B0); PG8_MMA(1, 1, At, B1); PG8_BAR; PG8_SCHED;
            PG8_LDB(B0, 1, 0); PG8_LDB(B1, 1, 1); PG8_SCHED; PG8_LDA(At, 1, 0); PG8_STAGE(PG8_SA(0, 1), rsA, a2 + hstep, voffA);
            PG8_WAIT_V(8); PG8_WAIT_L(0); PG8_BAR; PG8_MMA(0, 0, At, B0); PG8_MMA(0, 1, At, B1); PG8_BAR; PG8_SCHED;
            PG8_LDA(At, 1, 1); PG8_STAGE(PG8_SB(1, 0), rsB, b3, voffB); PG8_STAGE(PG8_SB(1, 1), rsB, b3 + hstep, voffB); PG8_STAGE(PG8_SA(1, 0), rsA, a3, voffA);
            PG8_WAIT_V(8); PG8_WAIT_L(0); PG8_BAR; PG8_MMA(1, 0, At, B0); PG8_MMA(1, 1, At, B1); PG8_BAR; PG8_SCHED;
            } else {
            PG8_LDB(B0, 0, 0); PG8_SCHED; PG8_LDA(At, 0, 0); PG8_STAGE(PG8_SA(1, 1), rsA, a1 + hstep, voffA);
            PG8_WAIT_L(8); PG8_BAR; PG8_WAIT_L(0); PG8_MMA(0, 0, At, B0); PG8_BAR; PG8_SCHED;
            PG8_LDB(B1, 0, 1); PG8_STAGE(PG8_SB(0, 0), rsB, b2, voffB);
            PG8_BAR; PG8_WAIT_L(0); PG8_MMA(0, 1, At, B1); PG8_BAR;
            PG8_LDA(At, 0, 1); PG8_STAGE(PG8_SA(0, 0), rsA, a2, voffA);
            PG8_BAR; PG8_WAIT_L(0); PG8_MMA(1, 0, At, B0); PG8_BAR; PG8_SCHED;
            PG8_STAGE(PG8_SB(0, 1), rsB, b2 + hstep, voffB);
            PG8_WAIT_V(6); PG8_BAR; PG8_MMA(1, 1, At, B1); PG8_BAR;
            PG8_LDB(B0, 1, 0); PG8_SCHED; PG8_LDA(At, 1, 0); PG8_STAGE(PG8_SA(0, 1), rsA, a2 + hstep, voffA);
            PG8_WAIT_L(8); PG8_BAR; PG8_WAIT_L(0); PG8_MMA(0, 0, At, B0); PG8_BAR; PG8_SCHED;
            PG8_LDB(B1, 1, 1); PG8_STAGE(PG8_SB(1, 0), rsB, b3, voffB);
            PG8_BAR; PG8_WAIT_L(0); PG8_MMA(0, 1, At, B1); PG8_BAR;
            PG8_LDA(At, 1, 1); PG8_STAGE(PG8_SA(1, 0), rsA, a3, voffA);
            PG8_BAR; PG8_WAIT_L(0); PG8_MMA(1, 0, At, B0); PG8_BAR; PG8_SCHED;
            PG8_STAGE(PG8_SB(1, 1), rsB, b3 + hstep, voffB);
            PG8_WAIT_V(6); PG8_BAR; PG8_MMA(1, 1, At, B1); PG8_BAR;
            }
        }
        if constexpr (ALIGN_EPI) { if (wr == 0) PG8_BAR; }
        if constexpr (!Epi::AFTER_DRAIN) { E(acc, cur, wr, wc, fr, fq); S.done(cur); }
        if (!has_next) break;
#pragma unroll
        for (int a = 0; a < 2; ++a)
#pragma unroll
            for (int b = 0; b < 2; ++b)
#pragma unroll
                for (int m = 0; m < 4; ++m)
#pragma unroll
                    for (int n = 0; n < 2; ++n) acc[a][b][m][n] = (f32x4){0.f, 0.f, 0.f, 0.f};
        cur = nxt; cA = nA; cB = nB; ++ui;
        if constexpr (ALIGN_EPI) { if (wr == 1) PG8_BAR; }
    }
    PG8_WAIT_V(0);
    if constexpr (!ALIGN_EPI) { if (wr == 0) PG8_BAR; }
    PG8_BAR;
#undef PG8_SA
#undef PG8_SB
#undef PG8_STAGE
#undef PG8_LDA
#undef PG8_LDB
#undef PG8_MMA
#undef PG8_CAT
#undef PG8_WAIT_V
#undef PG8_WAIT_L
#undef PG8_BAR
#undef PG8_SCHED
}
}

#define PG8_SP2 true
#define PG8_ALIGN true

constexpr int NWAVES = 8;
constexpr int NB = 4, SEQ = 4096, T = NB * SEQ, D = 2048;
constexpr int NPROJ = 13056;
constexpr int CQ = 0, CK = 1024, CV = 2048, CZ = 4096, CSQ = 6144, CSK = 8192, CSV = 8448, CGA = 8704, CGB = 10752, CBETA = 12800, CALPHA = 12816;
constexpr int D_IN = 12832;
constexpr int FFD = 5504, FFD2 = 11008, FFE = 7168, FFE2 = 14336, NE = 8;
constexpr int MOE_ROWS = 2 * T + NE * 256;
constexpr float NORM_EPS = 1e-6f;

constexpr size_t WS_CTL = 0, CTL_ZERO_BYTES = 1u << 20;
constexpr size_t SZ_WIN = (size_t)NPROJ * D * 2, SZ_SQ = (size_t)D * D * 2;
constexpr size_t WS_WIN = CTL_ZERO_BYTES;
constexpr size_t WS_WPG = WS_WIN + 2 * SZ_WIN;
constexpr size_t WS_WPS = WS_WPG + 2 * SZ_SQ;
constexpr size_t WS_WO = WS_WPS + 2 * SZ_SQ;
constexpr size_t WS_WGU = WS_WO + 2 * SZ_SQ;
constexpr size_t WS_WDN = WS_WGU + (size_t)FFD2 * D * 2;
constexpr size_t WS_MGU = WS_WDN + (size_t)D * FFD * 2;
constexpr size_t WS_MDN = WS_MGU + (size_t)NE * FFE2 * D * 2;
constexpr size_t WS_H = WS_MDN + (size_t)NE * D * FFE * 2;
constexpr size_t WS_R1 = WS_H + (size_t)T * D * 2;
constexpr size_t SZ_R1 = (size_t)MOE_ROWS * FFE * 2;
constexpr size_t WS_MIX = WS_R1 + SZ_R1;
constexpr size_t WS_QN = WS_MIX;
constexpr size_t WS_KN = WS_QN + (size_t)T * 1024 * 2;
constexpr size_t WS_V = WS_KN + (size_t)T * 1024 * 2;
constexpr size_t WS_ORAW = WS_V + (size_t)T * 2048 * 2;
constexpr size_t WS_OA = WS_ORAW + (size_t)T * 2048 * 4;
constexpr size_t WS_OB = WS_OA + (size_t)T * 2048 * 2;
constexpr size_t WS_G = WS_OB + (size_t)T * 2048 * 2;
constexpr size_t WS_BETA = WS_G + (size_t)T * 16 * 4;
constexpr size_t WS_MIX_END = WS_BETA + (size_t)T * 16 * 4;
constexpr size_t WS_Y = WS_QN;
constexpr size_t WS_YP = WS_ORAW;
constexpr size_t WS_XG = WS_MIX;
constexpr size_t WS_YG = WS_MIX + ((size_t)160 << 20);
constexpr size_t WS_IDX = WS_MIX_END;
constexpr size_t WS_TOPW = WS_IDX + (size_t)NE * T * 4;
constexpr size_t WS_SLOT = WS_TOPW + (size_t)T * 2 * 4;
constexpr size_t WS_QKB = WS_SLOT + (size_t)T * 2 * 4;
constexpr size_t WS_KTB = WS_QKB + (size_t)4096 * 4096 * 2;
constexpr size_t WS_EG = WS_KTB + (size_t)2048 * 8192 * 2;
constexpr size_t WS_EK = WS_EG + (size_t)T * 16 * 4;
constexpr size_t WS_RS = WS_EK + (size_t)T * 16 * 4;
constexpr size_t WS_CS = WS_RS + (size_t)T * 4;
constexpr size_t WS_CSF = WS_CS + (size_t)2 * NPROJ * 4;
constexpr size_t WS_CSM = WS_CSF + (size_t)FFD2 * 4;
constexpr size_t WS_RSF = WS_CSM + (size_t)NE * FFE2 * 4;
constexpr size_t WS_RSX = WS_RSF + (size_t)T * 4;
constexpr size_t WS_END = WS_RSX + (size_t)MOE_ROWS * 4;
constexpr size_t WS_WB = WS_R1 + (size_t)T * NPROJ * 2;
constexpr size_t WS_UTB = WS_ORAW;
static_assert(WS_WB + (size_t)4096 * 8192 * 2 <= WS_R1 + SZ_R1, "W tiles fit behind proj");
static_assert(WS_XG + (size_t)MOE_ROWS * D * 2 <= WS_YG && WS_YG + (size_t)MOE_ROWS * D * 2 <= WS_MIX_END, "moe overlays");
static_assert((size_t)T * NPROJ * 2 <= SZ_R1, "proj fits R1");
constexpr int CW_CNT = 64;
constexpr int CW_BAR = 4096;

constexpr int RING_OFF = 0, RING_BYTES = 155648;
constexpr int LDSCTL_OFF = RING_BYTES, MISC_OFF = LDSCTL_OFF + 320;
constexpr int LDS_BYTES = 163840;

#define GAS __attribute__((address_space(1)))
#define LAS __attribute__((address_space(3)))
typedef unsigned short bf16;
typedef unsigned v4u __attribute__((ext_vector_type(4)));
typedef unsigned v2u __attribute__((ext_vector_type(2)));
typedef float f32x4 __attribute__((ext_vector_type(4)));
typedef short bf16x8 __attribute__((ext_vector_type(8)));
using pg8::pk2; using pg8::bflo; using pg8::bfhi; using pg8::fsigmoid;
#define LDS_WAIT() asm volatile("s_waitcnt lgkmcnt(0)" ::: "memory")
#define VM_WAIT() asm volatile("s_waitcnt vmcnt(0)" ::: "memory")

#define XB_TMO      128
#define XB_XCNT(j)  (256  + 64 * (j))
#define XB_XSUB(j)  (1280 + 64 * (j))
#define XB_XGEN(j)  (2304 + 64 * (j))
#define XB_TOP      3328
#define XB_TOPGEN   3392
#define XCD_BAR_WORDS 3456
#define XB_SPIN_CAP (1u << 21)

__device__ __forceinline__ unsigned xb_ld(unsigned* p)              { return __hip_atomic_load(p, __ATOMIC_RELAXED, __HIP_MEMORY_SCOPE_AGENT); }
__device__ __forceinline__ unsigned xb_add(unsigned* p, unsigned v) { return __hip_atomic_fetch_add(p, v, __ATOMIC_RELAXED, __HIP_MEMORY_SCOPE_AGENT); }
__device__ __forceinline__ unsigned xb_xcc_id() { return (unsigned)__builtin_amdgcn_s_getreg((3 << 11) | 20) & 0xFu; }
#define XB_SPIN(cond, bar) do { unsigned _sp = 0; while (cond) { __builtin_amdgcn_s_sleep(1); \
    if ((++_sp & 255u) == 0u) { if (xb_ld(&(bar)[XB_TMO])) break; if (_sp > XB_SPIN_CAP) { atomicAdd(&(bar)[XB_TMO], 1u); break; } } } } while (0)

struct XcdBarrier { unsigned* bar; unsigned x; volatile LAS unsigned* st; };

__device__ __forceinline__ XcdBarrier xcd_barrier_post(unsigned* bar, volatile LAS unsigned* st) {
    XcdBarrier b; b.bar = bar; b.x = xb_xcc_id(); b.st = st;
    if (threadIdx.x == 0) (void)xb_add(&bar[XB_XCNT(b.x)], 1u);
    return b;
}
__device__ __forceinline__ void xcd_barrier_complete(unsigned* bar, unsigned x, unsigned& nloc, unsigned& nx) {
    const unsigned G = gridDim.x * gridDim.y * gridDim.z;
    unsigned sum, cnt, mine, sp = 0u;
    for (;;) {
        sum = 0u; cnt = 0u; mine = 0u;
#pragma unroll
        for (unsigned j = 0; j < 16; ++j) { const unsigned c = xb_ld(&bar[XB_XCNT(j)]); sum += c; cnt += (c > 0u) ? 1u : 0u; mine = (j == x) ? c : mine; }
        if (sum == G) break;
        __builtin_amdgcn_s_sleep(1);
        if ((++sp & 255u) == 0u) { if (xb_ld(&bar[XB_TMO])) break; if (sp > XB_SPIN_CAP) { atomicAdd(&bar[XB_TMO], 1u); break; } }
    }
    nloc = mine > 0u ? mine : 1u; nx = cnt > 0u ? cnt : 1u;
}
__device__ __forceinline__ void xcd_barrier(const XcdBarrier& b) {
    asm volatile("s_waitcnt vmcnt(0)" ::: "memory");
    __syncthreads();
    if (threadIdx.x == 0) {
        unsigned* bar = b.bar;
        __builtin_amdgcn_s_waitcnt(0);
        unsigned nloc = b.st[0], nx = b.st[1];
        if (nloc == 0u) { xcd_barrier_complete(bar, b.x, nloc, nx); b.st[0] = nloc; b.st[1] = nx; }
        const unsigned old = xb_add(&bar[XB_XSUB(b.x)], 1u);
        const unsigned gen = old / nloc;
        if (old + 1u == (gen + 1u) * nloc) {
            __builtin_amdgcn_fence(__ATOMIC_RELEASE, "agent");
            asm volatile("s_waitcnt vmcnt(0)" ::: "memory");
            const unsigned og = xb_add(&bar[XB_TOP], 1u);
            const unsigned tg = og / nx;
            if (og + 1u == (tg + 1u) * nx) xb_add(&bar[XB_TOPGEN], 1u);
            else XB_SPIN(xb_ld(&bar[XB_TOPGEN]) == tg, bar);
            __builtin_amdgcn_fence(__ATOMIC_ACQUIRE, "agent");
            xb_add(&bar[XB_XGEN(b.x)], 1u);
            asm volatile("s_waitcnt vmcnt(0)" ::: "memory");
        } else {
            XB_SPIN(xb_ld(&bar[XB_XGEN(b.x)]) == gen, bar);
            __builtin_amdgcn_fence(__ATOMIC_ACQUIRE, "agent");
            asm volatile("s_waitcnt vmcnt(0)" ::: "memory");
        }
    }
    __syncthreads();
}

struct Args {
    const float* in[21]; float* out; unsigned char* ws; int ph_lo, ph_hi, li, pad;
};
struct Frame {
    LAS unsigned char* lds;
    volatile LAS unsigned* MISC;
    unsigned* ctl;
    int tid, lane, wave, vcu, G;
};

__device__ __forceinline__ float wave_sum(float v) {
#pragma unroll
    for (int o = 1; o < 64; o <<= 1) v += __shfl_xor(v, o);
    return v;
}
template <int CTRL> __device__ __forceinline__ float dpp_f(float x) { return __builtin_bit_cast(float, __builtin_amdgcn_update_dpp(0, __builtin_bit_cast(int, x), CTRL, 0xF, 0xF, false)); }
__device__ __forceinline__ float reduce16(float x) {
    x += dpp_f<0x128>(x); x += dpp_f<0x124>(x); x += dpp_f<0x122>(x); x += dpp_f<0x121>(x); return x;
}
__device__ __forceinline__ float fsilu(float x) { return x * fsigmoid(x); }

__device__ __forceinline__ void transpose_item(const float* W, int ldw, int k0, int ns0, bf16* WT, int K, int nd0, bool zero, LAS float* scr, int lane) {
    if (!zero) {
#pragma unroll 8
        for (int i = 0; i < 32; ++i) { const int kk = 2 * i + (lane >> 5); scr[kk * 33 + (lane & 31)] = W[(size_t)(k0 + kk) * ldw + ns0 + (lane & 31)]; }
    }
    LDS_WAIT(); asm volatile("" ::: "memory");
    const int c = lane & 7;
#pragma unroll
    for (int j = 0; j < 4; ++j) { const int n = (lane >> 3) + 8 * j; const LAS float* s = scr + (8 * c) * 33 + n;
        v4u o;
        if (zero) { o = (v4u){0u, 0u, 0u, 0u}; }
        else { o.x = pk2(s[0 * 33], s[1 * 33]); o.y = pk2(s[2 * 33], s[3 * 33]); o.z = pk2(s[4 * 33], s[5 * 33]); o.w = pk2(s[6 * 33], s[7 * 33]); }
        *(GAS v4u*)(WT + (size_t)(nd0 + n) * K + k0 + 8 * c) = o; }
    LDS_WAIT(); asm volatile("" ::: "memory");
}
__device__ __forceinline__ void transpose_item_f8(const float* W, int ldw, int k0, int ns0, unsigned char* WT, int K, int nd0, float wsc, LAS float* scr, int lane) {
#pragma unroll 8
    for (int i = 0; i < 32; ++i) { const int kk = 2 * i + (lane >> 5); scr[kk * 33 + (lane & 31)] = __builtin_nontemporal_load(W + (size_t)(k0 + kk) * ldw + ns0 + (lane & 31)); }
    LDS_WAIT(); asm volatile("" ::: "memory");
    const int c = lane & 7;
#pragma unroll
    for (int j = 0; j < 4; ++j) { const int n = (lane >> 3) + 8 * j; const LAS float* s = scr + (8 * c) * 33 + n;
        v2u o; o.x = pg8::pk4_fp8(s[0 * 33] * wsc, s[1 * 33] * wsc, s[2 * 33] * wsc, s[3 * 33] * wsc); o.y = pg8::pk4_fp8(s[4 * 33] * wsc, s[5 * 33] * wsc, s[6 * 33] * wsc, s[7 * 33] * wsc);
        __builtin_nontemporal_store(o, (v2u*)(WT + (size_t)(nd0 + n) * K + k0 + 8 * c)); }
    LDS_WAIT(); asm volatile("" ::: "memory");
}
constexpr float W8_SCALE = 64.f; constexpr int W8_E8M0 = 0x79797979;
constexpr float X8_SCALE = 4.f, H8_SCALE = 4.f; constexpr int X8_E8M0 = 0x7d7d7d7d, H8_E8M0 = 0x7d7d7d7d;
__device__ __forceinline__ void tr_plain_f8(const float* W, int K, int N, unsigned char* WT, int item, LAS float* scr, int lane) {
    const int nblk = N / 32, kb = item / nblk, nb = item % nblk;
    transpose_item_f8(W, N, 64 * kb, 32 * nb, WT, K, 32 * nb, W8_SCALE, scr, lane);
}
__device__ __forceinline__ void tr_gu_f8(const float* Wg, const float* Wu, int K, int F, unsigned char* WT, int item, LAS float* scr, int lane) {
    const int nblk = (2 * F) / 32, kb = item / nblk, nb = item % nblk, nd0 = 32 * nb, pn = nd0 >> 8, j = nd0 & 255;
    const float* W = (j < 128) ? Wg : Wu; const int ns0 = 128 * pn + (j & 127);
    transpose_item_f8(W, F, 64 * kb, ns0, WT, K, nd0, W8_SCALE, scr, lane);
}
__device__ __forceinline__ void tr_plain(const float* W, int K, int N, bf16* WT, int item, LAS float* scr, int lane) {
    const int nblk = N / 32, kb = item / nblk, nb = item % nblk;
    transpose_item(W, N, 64 * kb, 32 * nb, WT, K, 32 * nb, false, scr, lane);
}
__device__ __forceinline__ void w_i8_core(const Frame& F, const float* Wblk  , int ldw, bool zero, unsigned char* WTrow0  , float* CSblk, LAS float* mxs  ) {
    const int lane = F.lane, n = lane & 31, kq = lane >> 5;
    const int k0 = 256 * F.wave + 128 * kq;
    const float* Wc = Wblk + (size_t)k0 * ldw + n;
    float v[128]; float mx = 0.f;
#pragma unroll
    for (int i = 0; i < 128; ++i) { v[i] = zero ? 0.f : Wc[(size_t)i * ldw]; mx = fmaxf(mx, fabsf(v[i])); }
    mxs[(2 * F.wave + kq) * 32 + n] = mx;
    __syncthreads();
    float cm = 0.f;
#pragma unroll
    for (int j = 0; j < 16; ++j) cm = fmaxf(cm, mxs[j * 32 + n]);
    const float iv = cm > 0.f ? 127.f / cm : 0.f;
    if (F.wave == 0 && lane < 32) CSblk[n] = cm * (1.f / 127.f);
    v4u* op = (v4u*)(WTrow0 + (size_t)n * D + k0);
#pragma unroll
    for (int q = 0; q < 8; ++q) { unsigned wd[4];
#pragma unroll
        for (int d = 0; d < 4; ++d) { const int q0 = (int)__builtin_rintf(v[16 * q + 4 * d] * iv) & 255, q1 = (int)__builtin_rintf(v[16 * q + 4 * d + 1] * iv) & 255, q2 = (int)__builtin_rintf(v[16 * q + 4 * d + 2] * iv) & 255, q3 = (int)__builtin_rintf(v[16 * q + 4 * d + 3] * iv) & 255;
            wd[d] = (unsigned)(q0 | (q1 << 8) | (q2 << 16) | (q3 << 24)); }
        op[q] = (v4u){wd[0], wd[1], wd[2], wd[3]}; }
    __syncthreads();
}
__device__ __forceinline__ void win_i8_item(const Frame& F, const float* W, unsigned char* WT, float* CS, int nb, LAS float* mxs) {
    const int nd0 = 32 * nb; const bool zero = nd0 >= 12832; const int ns0 = nd0 < 6144 ? nd0 : (nd0 < 12800 ? nd0 + 32 : (zero ? 0 : nd0 - 12800 + 6144));
    w_i8_core(F, W + ns0, D_IN, zero, WT + (size_t)nd0 * D, CS + nd0, mxs);
}
__device__ __forceinline__ void wgu_i8_item(const Frame& F, const float* Wg, const float* Wu, int Fh, unsigned char* WT, float* CS, int nb, LAS float* mxs) {
    const int nd0 = 32 * nb, pn = nd0 >> 8, j = nd0 & 255;
    w_i8_core(F, ((j < 128) ? Wg : Wu) + 128 * pn + (j & 127), Fh, false, WT + (size_t)nd0 * D, CS + nd0, mxs);
}
template <bool ROUTER, bool OUT8 = false>
__device__ __forceinline__ void rms_row(const Frame& F, const float* xrow, const float* gain, bf16* orow, const LAS float* rwT, int t, unsigned* cnt, int* idx, float* topw, int* slot, LAS void* cnt_lds = nullptr, int rec = 0) {
    const f32x4* xr = (const f32x4*)xrow + F.lane; const f32x4* gr = (const f32x4*)gain + F.lane;
    f32x4 v[8]; float ss = 0.f;
#pragma unroll
    for (int j = 0; j < 8; ++j) { v[j] = xr[64 * j]; ss += (v[j].x * v[j].x + v[j].y * v[j].y) + (v[j].z * v[j].z + v[j].w * v[j].w); }
    const float r = __builtin_amdgcn_rsqf(wave_sum(ss) * (1.f / D) + NORM_EPS);
    if constexpr (OUT8) {
        float am = 0.f;
#pragma unroll
        for (int j = 0; j < 8; ++j) { v[j] = v[j] * r * gr[64 * j]; am = fmaxf(am, fmaxf(fmaxf(fabsf(v[j].x), fabsf(v[j].y)), fmaxf(fabsf(v[j].z), fabsf(v[j].w)))); }
#pragma unroll
        for (int o = 1; o < 64; o <<= 1) am = fmaxf(am, __shfl_xor(am, o));
        const float iv = am > 0.f ? 127.f / am : 0.f;
        unsigned* o4 = (unsigned*)orow + F.lane;
#pragma unroll
        for (int j = 0; j < 8; ++j) { const int q0 = (int)__builtin_rintf(v[j].x * iv) & 255, q1 = (int)__builtin_rintf(v[j].y * iv) & 255, q2 = (int)__builtin_rintf(v[j].z * iv) & 255, q3 = (int)__builtin_rintf(v[j].w * iv) & 255;
            o4[64 * j] = (unsigned)(q0 | (q1 << 8) | (q2 << 16) | (q3 << 24)); }
        if (F.lane == 0) topw[t] = am * (1.f / 127.f);
    } else {
        v2u* o8 = (v2u*)orow + F.lane;
#pragma unroll
        for (int j = 0; j < 8; ++j) { v[j] = v[j] * r * gr[64 * j]; v2u w; w.x = pk2(v[j].x, v[j].y); w.y = pk2(v[j].z, v[j].w); o8[64 * j] = w; }
    }
    if constexpr (ROUTER) {
        float lg[8];
#pragma unroll
        for (int e = 0; e < 8; ++e) { float s = 0.f;
#pragma unroll
            for (int j = 0; j < 8; ++j) { const f32x4 w = *(const LAS f32x4*)(rwT + e * D + 4 * F.lane + 256 * j); s += (v[j].x * w.x + v[j].y * w.y) + (v[j].z * w.z + v[j].w * w.w); }
            lg[e] = wave_sum(s); asm volatile("" ::: "memory"); }
        int e1 = 0; float l1 = lg[0];
#pragma unroll
        for (int e = 1; e < 8; ++e) if (lg[e] > l1) { l1 = lg[e]; e1 = e; }
        int e2 = -1; float l2 = -3.0e38f;
#pragma unroll
        for (int e = 0; e < 8; ++e) if (e != e1 && lg[e] > l2) { l2 = lg[e]; e2 = e; }
        if (F.lane == 0) {
            const float w1 = 1.f / (1.f + __expf(l2 - l1)), w2 = 1.f - w1;
            LAS unsigned* lcnt = (LAS unsigned*)cnt_lds; LAS int* lrec = (LAS int*)cnt_lds + 16;
            const unsigned p1 = __hip_atomic_fetch_add(lcnt + e1, 1u, __ATOMIC_RELAXED, __HIP_MEMORY_SCOPE_WORKGROUP), p2 = __hip_atomic_fetch_add(lcnt + e2, 1u, __ATOMIC_RELAXED, __HIP_MEMORY_SCOPE_WORKGROUP);
            lrec[2 * rec] = (e1 << 16) | (int)p1; lrec[2 * rec + 1] = (e2 << 16) | (int)p2;
            topw[2 * t] = w1; topw[2 * t + 1] = w2;
        }
    }
}

__device__ __forceinline__ void unpack8(const v4u w, float (&f)[8]) { f[0] = bflo(w.x); f[1] = bfhi(w.x); f[2] = bflo(w.y); f[3] = bfhi(w.y); f[4] = bflo(w.z); f[5] = bfhi(w.z); f[6] = bflo(w.w); f[7] = bfhi(w.w); }

__host__ __device__ constexpr int pi5(int p) { return 4 * (p >> 3) + (p & 3) + 16 * ((p >> 2) & 1); }
__host__ __device__ constexpr int pinv5(int a) { return 8 * ((a & 15) >> 2) + (a & 3) + 4 * (a >> 4); }
constexpr int PS = 136, PQ = 72;
#define FMIX_LO(s_, aw_, x_) asm("v_fma_mix_f32 %0, -%1, %2, %0 op_sel_hi:[1,0,0]" : "+v"(s_) : "v"(aw_), "v"(x_))
#define FMIX_HI(s_, aw_, x_) asm("v_fma_mix_f32 %0, -%1, %2, %0 op_sel:[1,0,0] op_sel_hi:[1,0,0]" : "+v"(s_) : "v"(aw_), "v"(x_))
template <int I, int M8> __device__ __forceinline__ void solve_oct(const float (&x)[64], const LAS _Float16* AMv, float& s0, float& s1) {
    if constexpr (8 * M8 < I) {
        const v4u a = *(const LAS v4u*)(AMv + I * 72 + 8 * M8);
        if constexpr (8 * M8 + 0 < I) FMIX_LO(s0, a.x, x[8 * M8 + 0]);
        if constexpr (8 * M8 + 1 < I) FMIX_HI(s1, a.x, x[8 * M8 + 1]);
        if constexpr (8 * M8 + 2 < I) FMIX_LO(s0, a.y, x[8 * M8 + 2]);
        if constexpr (8 * M8 + 3 < I) FMIX_HI(s1, a.y, x[8 * M8 + 3]);
        if constexpr (8 * M8 + 4 < I) FMIX_LO(s0, a.z, x[8 * M8 + 4]);
        if constexpr (8 * M8 + 5 < I) FMIX_HI(s1, a.z, x[8 * M8 + 5]);
        if constexpr (8 * M8 + 6 < I) FMIX_LO(s0, a.w, x[8 * M8 + 6]);
        if constexpr (8 * M8 + 7 < I) FMIX_HI(s1, a.w, x[8 * M8 + 7]);
        solve_oct<I, M8 + 1>(x, AMv, s0, s1);
    }
}
template <int I> __device__ __forceinline__ void solve_rows(float (&x)[64], const LAS _Float16* AMv) {
    if constexpr (I < 64) { float s0 = x[I], s1 = 0.f; solve_oct<I, 0>(x, AMv, s0, s1); x[I] = s0 + s1; solve_rows<I + 1>(x, AMv); }
}
#undef FMIX_LO
#undef FMIX_HI
__device__ __forceinline__ void gdn_prep_phase(const Frame& F, const bf16* PROJ, const float* convw, const float* a_log, const float* dt_bias,
                                               bf16* QN, bf16* WB, bf16* UTB, bf16* QKB, bf16* KTB, float* EG, float* EK) {
    LAS unsigned char* L = F.lds;
    LAS bf16* KS = (LAS bf16*)L; LAS bf16* QS = (LAS bf16*)(L + 17408);
    constexpr int OVS = 34816, OAM = 69632, OQK = 104448, OVEC = 122880;
    const int tid = F.tid, lane = F.lane, w = F.wave, c = lane & 15, gq = lane >> 4;
    const int cm = tid >> 7, cr = (tid >> 4) & 7, cg16 = tid & 15;
    v4u xr[11]; unsigned gbraw = 0u, garaw = 0u;
#define PREP_FETCH(unit_) do { const int hq_ = (unit_) & 7, n_ = ((unit_) >> 3) & 63, b_ = (unit_) >> 9; const size_t t0_ = (size_t)b_ * SEQ + (size_t)n_ * 64; \
        const int col_ = (cm == 0 ? CQ + hq_ * 128 : cm == 1 ? CK + hq_ * 128 : CV + (2 * hq_ + (cm - 2)) * 128) + 8 * cg16; \
        const bf16* pr_ = PROJ + (t0_ + 8 * cr) * NPROJ + col_; const bool head_ = (cr == 0 && (t0_ & (SEQ - 1)) == 0); \
        _Pragma("unroll") for (int j = 0; j < 11; ++j) xr[j] = (head_ && j < 3) ? (v4u){0u, 0u, 0u, 0u} : *(const v4u*)(pr_ + (ptrdiff_t)(j - 3) * NPROJ); \
        if (w < 2) { gbraw = (unsigned)PROJ[(t0_ + lane) * NPROJ + CBETA + 2 * hq_ + w]; garaw = (unsigned)PROJ[(t0_ + lane) * NPROJ + CALPHA + 2 * hq_ + w]; } } while (0)
    if (F.vcu < NB * 64 * 8) PREP_FETCH(F.vcu);
    for (int unit = F.vcu; unit < NB * 64 * 8; unit += F.G) {
        const int hq = unit & 7, n = (unit >> 3) & 63, b = unit >> 9;
        const size_t t0 = (size_t)b * SEQ + (size_t)n * 64;
        const float braw_c = bflo(gbraw), araw_c = bflo(garaw);
        {
            const int m = cm, r = cr, g16 = cg16;
            const int col = (m == 0 ? CQ + hq * 128 : m == 1 ? CK + hq * 128 : CV + (2 * hq + (m - 2)) * 128) + 8 * g16;
            float wt[4][8];
#pragma unroll
            for (int tap = 0; tap < 4; ++tap) { const f32x4 a = *(const f32x4*)(convw + tap * 4096 + col), bb = *(const f32x4*)(convw + tap * 4096 + col + 4);
                wt[tap][0] = a.x; wt[tap][1] = a.y; wt[tap][2] = a.z; wt[tap][3] = a.w; wt[tap][4] = bb.x; wt[tap][5] = bb.y; wt[tap][6] = bb.z; wt[tap][7] = bb.w; }
            float x0[8], x1[8], x2[8];
            unpack8(xr[0], x0); unpack8(xr[1], x1); unpack8(xr[2], x2);
            const float qs = (m == 0) ? 0.08838834764831845f : 1.0f;
            const int pm_ = g16 & 3, ppos = 32 * (g16 >> 2) + 16 * (pm_ & 1) + 4 * (pm_ >> 1);
            LAS bf16* dst = (m == 0) ? QS : (m == 1) ? KS : (LAS bf16*)(L + OVS + (m - 2) * 17408);
#pragma unroll
            for (int j = 0; j < 8; ++j) {
                float x3[8]; unpack8(xr[3 + j], x3);
                float y[8]; float ss = 0.f;
#pragma unroll
                for (int i = 0; i < 8; ++i) { float a = wt[0][i] * x0[i] + wt[1][i] * x1[i] + wt[2][i] * x2[i] + wt[3][i] * x3[i]; a = fsilu(a); y[i] = a; ss += a * a; }
                if (m < 2) { const float sc = __builtin_amdgcn_rsqf(reduce16(ss) + 1e-6f) * qs;
#pragma unroll
                    for (int i = 0; i < 8; ++i) y[i] *= sc; }
                v4u o; o.x = pk2(y[0], y[1]); o.y = pk2(y[2], y[3]); o.z = pk2(y[4], y[5]); o.w = pk2(y[6], y[7]);
                const int tok = 8 * r + j;
                if (m < 2) { v2u lo, hi2; lo.x = o.x; lo.y = o.y; hi2.x = o.z; hi2.y = o.w; *(LAS v2u*)(dst + tok * PS + ppos) = lo; *(LAS v2u*)(dst + tok * PS + ppos + 8) = hi2; }
                else *(LAS v4u*)(dst + tok * PS + 8 * g16) = o;
#pragma unroll
                for (int i = 0; i < 8; ++i) { x0[i] = x1[i]; x1[i] = x2[i]; x2[i] = x3[i]; }
            }
        }
        __syncthreads();
        if (w < 2) {
            const int h = 2 * hq + w; LAS float* GC = (LAS float*)(L + OVEC + w * 768);
            const float braw = braw_c, araw = araw_c;
            const float xx = araw + dt_bias[h]; const float sp = xx > 20.f ? xx : log1pf(__expf(xx));
            float g = -__expf(a_log[h]) * sp;
#pragma unroll
            for (int o = 1; o < 64; o <<= 1) { const float y = __shfl_up(g, o); if (lane >= o) g += y; }
            const float last = __shfl(g, 63), eg = __expf(g), ek = __expf(last - g);
            GC[lane] = g; GC[64 + lane] = eg; GC[128 + lane] = fsigmoid(braw);
            EG[(t0 + lane) * 16 + h] = eg; EK[(t0 + lane) * 16 + h] = ek;
        }
        {
#pragma unroll
            for (int i = 0; i < 2; ++i) { const int ch = tid + 512 * i, tok = ch >> 4, part = ch & 15; *(v4u*)(QN + (t0 + tok) * 1024 + hq * 128 + part * 8) = *(const LAS v4u*)(QS + tok * PS + part * 8); }
            if (tid < 256) { const int pcol = tid >> 1, half = tid & 1, dk = (pcol & 96) + pi5(pcol & 31);
                v4u* kp = (v4u*)(KTB + ((size_t)(b * 8 + hq) * 64 + n) * 8192 + (size_t)dk * 64 + 32 * half);
#pragma unroll
                for (int q8 = 0; q8 < 4; ++q8) { unsigned e[8];
#pragma unroll
                    for (int i = 0; i < 8; ++i) e[i] = (unsigned)KS[(32 * half + pi5(8 * q8 + i)) * PS + pcol];
                    v4u o; o.x = e[0] | (e[1] << 16); o.y = e[2] | (e[3] << 16); o.z = e[4] | (e[5] << 16); o.w = e[6] | (e[7] << 16); kp[q8] = o; } }
        }
        __syncthreads();
#pragma unroll
        for (int jj = 0; jj < 4; ++jj) {
            const int job = 4 * w + jj, type = job >> 4, ct = (job >> 2) & 3, st = job & 3;
            f32x4 acc = (f32x4){0.f, 0.f, 0.f, 0.f};
            if (st <= ct) {
                const LAS bf16* ap = (type ? QS : KS) + (16 * ct + c) * PS + 8 * gq; const LAS bf16* bp = KS + (16 * st + c) * PS + 8 * gq;
#pragma unroll
                for (int ks = 0; ks < 4; ++ks) acc = __builtin_amdgcn_mfma_f32_16x16x32_bf16(*(const LAS bf16x8*)(ap + 32 * ks), *(const LAS bf16x8*)(bp + 32 * ks), acc, 0, 0, 0);
            }
            int cl = c; asm volatile("" : "+v"(cl));
            const int col = 16 * st + cl;
#pragma unroll
            for (int hh = 0; hh < 2; ++hh) {
                const LAS float* GC = (const LAS float*)(L + OVEC + hh * 768); const float gcol = GC[col];
                LAS _Float16* AM = (LAS _Float16*)(L + OAM + hh * 17408); LAS bf16* QKs = (LAS bf16*)(L + OQK + hh * 9216);
#pragma unroll
                for (int r = 0; r < 4; ++r) { const int row = 16 * ct + 4 * gq + r;
                    const float dec = __expf(fminf(GC[row] - gcol, 0.f));
                    if (type == 0) AM[row * 72 + col] = (_Float16)((col < row) ? GC[128 + row] * acc[r] * dec : 0.f);
                    else QKs[row * PQ + (col & 32) + pinv5(col & 31)] = (bf16)(pk2((col <= row) ? acc[r] * dec : 0.f, 0.f) & 0xffffu); }
            }
        }
        if (unit + F.G < NB * 64 * 8) PREP_FETCH(unit + F.G);
        __syncthreads();
        {
            const int hh = tid >> 8, j = tid & 255, h = 2 * hq + hh;
            const size_t ubh = ((size_t)(b * 16 + h) * 64 + n);
            const LAS bf16* VS = (const LAS bf16*)(L + OVS + hh * 17408);
            float x[64];
            const LAS float* GCv = (const LAS float*)(L + OVEC + hh * 768); asm volatile("" : "+v"(GCv));
            if (j < 128) {
#pragma unroll
                for (int i = 0; i < 64; ++i) x[i] = GCv[128 + i] * bflo((unsigned)VS[i * PS + j]);
            } else {
#pragma unroll
                for (int i = 0; i < 64; ++i) x[i] = GCv[128 + i] * GCv[64 + i] * bflo((unsigned)KS[i * PS + j - 128]);
            }
            __syncthreads();
            const LAS _Float16* AMv = (const LAS _Float16*)(L + OAM + hh * 17408); asm volatile("" : "+v"(AMv));
solve_rows<1>(x, AMv);
            if (j < 128) {
                v4u* up = (v4u*)(UTB + ubh * 8192 + (size_t)j * 64);
#pragma unroll
                for (int q8 = 0; q8 < 8; ++q8) { v4u o; o.x = pk2(x[8 * q8], x[8 * q8 + 1]); o.y = pk2(x[8 * q8 + 2], x[8 * q8 + 3]); o.z = pk2(x[8 * q8 + 4], x[8 * q8 + 5]); o.w = pk2(x[8 * q8 + 6], x[8 * q8 + 7]); up[q8] = o; }
            } else {
                LAS bf16* Wt = hh ? KS : QS;
#pragma unroll
                for (int i = 0; i < 64; ++i) Wt[i * PS + j - 128] = (bf16)(pk2(x[i], 0.f) & 0xffffu);
            }
        }
        __syncthreads();
#pragma unroll
        for (int hh = 0; hh < 2; ++hh) { const size_t ubh = ((size_t)(b * 16 + 2 * hq + hh) * 64 + n); const LAS bf16* Wt = hh ? KS : QS; const LAS bf16* QKs = (const LAS bf16*)(L + OQK + hh * 9216);
#pragma unroll
            for (int i = 0; i < 2; ++i) { const int ch = tid + 512 * i, tok = ch >> 4, part = ch & 15; *(v4u*)(WB + ubh * 8192 + (size_t)ch * 8) = *(const LAS v4u*)(Wt + tok * PS + part * 8); }
            { const int tok = tid >> 3, part = tid & 7; *(v4u*)(QKB + ubh * 4096 + (size_t)tid * 8) = *(const LAS v4u*)(QKs + tok * PQ + part * 8); } }
        __syncthreads();
    }
}

__device__ __forceinline__ bf16x8 afrag(const LAS bf16* p) { return *(const LAS bf16x8*)p; }
__device__ __forceinline__ bf16x8 bfrag(const f32x4 t0, const f32x4 t1) {
    v4u a; a.x = pk2(t0[0], t0[1]); a.y = pk2(t0[2], t0[3]); a.z = pk2(t1[0], t1[1]); a.w = pk2(t1[2], t1[3]); return __builtin_bit_cast(bf16x8, a);
}
__device__ __forceinline__ void gdn_scan_phase(const Frame& F, const int unit0, const int ustride, const bf16* QN, const bf16* WB, const bf16* UTB, const bf16* QKB, const bf16* KTB, const float* EG, const float* EK,
                                               const bf16* PROJ, const float* gng, bf16* OA) {
    LAS unsigned char* L = F.lds;
    constexpr int OW = 0, OQ = 16384, OKT = 32768, OQK = 49152, OE = 57344, BUF = 57856, OOT = 2 * BUF, OTS = 136 * 64 * 2;
    const int tid = F.tid, lane = F.lane, w = F.wave, c = lane & 15, gq = lane >> 4, dv0 = 16 * w;
    const int r128 = lane >> 4, p128 = lane & 15, r64 = lane >> 3, p64 = lane & 7;
    for (int unit = unit0; unit < NB * 16; unit += ustride) {
        const int h = unit & 15, b = unit >> 4, hq = h >> 1;
        const size_t tb = (size_t)b * SEQ; const size_t ubh = (size_t)(b * 16 + h) * 64, ubq = (size_t)(b * 8 + hq) * 64;
        f32x4 S[8];
#pragma unroll
        for (int i = 0; i < 8; ++i) S[i] = (f32x4){0.f, 0.f, 0.f, 0.f};
        v2u ucur[4], unext[4];
        const int gtok = tid >> 3, gdv = (tid & 7) * 16;
        LAS float* GN = (LAS float*)(L + OOT + 2 * OTS);
        if (tid < 128) GN[tid] = gng[tid];
        v4u zc[2];
#define GSCAN_ZLOAD(n_) do { const bf16* zp_ = PROJ + (tb + (size_t)(n_) * 64 + gtok) * NPROJ + CZ + h * 128 + gdv; zc[0] = *(const v4u*)zp_; zc[1] = *(const v4u*)(zp_ + 8); } while (0)
#define GSCAN_NORM(n_) do { const LAS bf16* ot_ = (const LAS bf16*)(L + OOT + ((n_) & 1) * OTS) + gtok * 136 + gdv; \
            float o_[16]; { float t8_[8]; unpack8(*(const LAS v4u*)ot_, t8_); _Pragma("unroll") for (int i = 0; i < 8; ++i) o_[i] = t8_[i]; unpack8(*(const LAS v4u*)(ot_ + 8), t8_); _Pragma("unroll") for (int i = 0; i < 8; ++i) o_[8 + i] = t8_[i]; } \
            float ss_ = 0.f; _Pragma("unroll") for (int i = 0; i < 16; ++i) ss_ += o_[i] * o_[i]; \
            ss_ += __shfl_xor(ss_, 1); ss_ += __shfl_xor(ss_, 2); ss_ += __shfl_xor(ss_, 4); \
            const float r_ = __builtin_amdgcn_rsqf(ss_ * (1.f / 128.f) + NORM_EPS); \
            float z_[16]; { float t8_[8]; unpack8(zc[0], t8_); _Pragma("unroll") for (int i = 0; i < 8; ++i) z_[i] = t8_[i]; unpack8(zc[1], t8_); _Pragma("unroll") for (int i = 0; i < 8; ++i) z_[8 + i] = t8_[i]; } \
            f32x4 gg[4]; _Pragma("unroll") for (int i = 0; i < 4; ++i) gg[i] = *(const LAS f32x4*)(GN + gdv + 4 * i); \
            unsigned w_[8]; _Pragma("unroll") for (int i = 0; i < 8; ++i) w_[i] = pk2(o_[2 * i] * r_ * gg[i >> 1][(2 * i) & 3] * fsilu(z_[2 * i]), o_[2 * i + 1] * r_ * gg[i >> 1][(2 * i + 1) & 3] * fsilu(z_[2 * i + 1])); \
            v4u* op_ = (v4u*)(OA + (tb + (size_t)(n_) * 64 + gtok) * 2048 + h * 128 + gdv); op_[0] = (v4u){w_[0], w_[1], w_[2], w_[3]}; op_[1] = (v4u){w_[4], w_[5], w_[6], w_[7]}; } while (0)
        unsigned offW[2], offQ[2], offK[2], offQK;
#pragma unroll
        for (int k = 0; k < 2; ++k) { const int r = 4 * (w + 8 * k) + r128, r2 = 8 * (w + 8 * k) + r64;
            offW[k] = (unsigned)(r * 256 + ((p128 ^ (r & 15)) << 4)); offQ[k] = (unsigned)(r * 2048 + ((p128 ^ (r & 15)) << 4)); offK[k] = (unsigned)(r2 * 128 + ((p64 ^ ((r2 >> 1) & 7)) << 4)); }
        { const int r2 = 8 * w + r64; offQK = (unsigned)(r2 * 128 + ((p64 ^ ((r2 >> 1) & 7)) << 4)); }
#define GSCAN_FILL(n_, buf_) do { const size_t t0_ = tb + (size_t)(n_) * 64; LAS unsigned char* B1 = L + (buf_) * BUF; \
            const char* bw_ = (const char*)(WB + (ubh + (n_)) * 8192); const char* bq_ = (const char*)(QN + t0_ * 1024 + hq * 128); \
            const char* bk_ = (const char*)(KTB + (ubq + (n_)) * 8192); const char* bqk_ = (const char*)(QKB + (ubh + (n_)) * 4096); \
            _Pragma("unroll") for (int k = 0; k < 2; ++k) { \
                __builtin_amdgcn_global_load_lds((const unsigned*)(bw_ + offW[k]), (LAS unsigned*)(B1 + OW + (w + 8 * k) * 1024), 16, 0, 0); \
                __builtin_amdgcn_global_load_lds((const unsigned*)(bq_ + offQ[k]), (LAS unsigned*)(B1 + OQ + (w + 8 * k) * 1024), 16, 0, 0); \
                __builtin_amdgcn_global_load_lds((const unsigned*)(bk_ + offK[k]), (LAS unsigned*)(B1 + OKT + (w + 8 * k) * 1024), 16, 0, 0); } \
            __builtin_amdgcn_global_load_lds((const unsigned*)(bqk_ + offQK), (LAS unsigned*)(B1 + OQK + w * 1024), 16, 0, 0); \
            if (w < 2) __builtin_amdgcn_global_load_lds((const unsigned*)((w ? EK : EG) + (t0_ + lane) * 16 + h), (LAS unsigned*)(B1 + OE + w * 256), 4, 0, 0);     \
            _Pragma("unroll") for (int mt = 0; mt < 4; ++mt) unext[mt] = *(const v2u*)(UTB + (ubh + (n_)) * 8192 + (size_t)(dv0 + c) * 64 + 16 * mt + 4 * gq); } while (0)
        GSCAN_FILL(0, 0);
#pragma unroll
        for (int mt = 0; mt < 4; ++mt) ucur[mt] = unext[mt];
        asm volatile("s_waitcnt vmcnt(0)" ::: "memory");
        __syncthreads();
        for (int n = 0; n < SEQ / 64; ++n) {
            const int buf = n & 1;
            if (n + 1 < SEQ / 64) GSCAN_FILL(n + 1, buf ^ 1);
            if (n > 0) GSCAN_ZLOAD(n - 1);
            const LAS unsigned char* B0 = L + buf * BUF;
            const LAS float* EGs = (const LAS float*)(B0 + OE); const LAS float* EKs = EGs + 64;
#define FR128(base_, mt_, ks_) (*(const LAS bf16x8*)(B0 + (base_) + (16 * (mt_) + c) * 256 + (((4 * (ks_) + gq) ^ c) << 4)))
#define FR64(base_, mt_, ks_)  (*(const LAS bf16x8*)(B0 + (base_) + (16 * (mt_) + c) * 128 + (((4 * (ks_) + gq) ^ ((c >> 1) & 7)) << 4)))
            bf16x8 Sb[4];
#pragma unroll
            for (int ks = 0; ks < 4; ++ks) Sb[ks] = bfrag(S[2 * ks], S[2 * ks + 1]);
            f32x4 P[4], O[4];
            bf16x8 fw[2][4], fq[2][4];
#define GS_LD1(mt_, b_) do { _Pragma("unroll") for (int ks = 0; ks < 4; ++ks) { fw[b_][ks] = FR128(OW, mt_, ks); fq[b_][ks] = FR128(OQ, mt_, ks); } } while (0)
            GS_LD1(0, 0);
#pragma unroll
            for (int mt = 0; mt < 4; ++mt) {
                if (mt < 3) GS_LD1(mt + 1, (mt + 1) & 1);
                else {
#pragma unroll
                    for (int m2 = 0; m2 < 4; ++m2) { fw[0][m2] = FR64(OQK, m2, 0); fq[0][m2] = FR64(OQK, m2, 1); }
                }
                P[mt] = (f32x4){0.f, 0.f, 0.f, 0.f}; O[mt] = (f32x4){0.f, 0.f, 0.f, 0.f};
#pragma unroll
                for (int ks = 0; ks < 4; ++ks) {
                    P[mt] = __builtin_amdgcn_mfma_f32_16x16x32_bf16(fw[mt & 1][ks], Sb[ks], P[mt], 0, 0, 0);
                    O[mt] = __builtin_amdgcn_mfma_f32_16x16x32_bf16(fq[mt & 1][ks], Sb[ks], O[mt], 0, 0, 0); }
            }
#undef GS_LD1
            f32x4 Vn[4], Vs[4];
#pragma unroll
            for (int mt = 0; mt < 4; ++mt) {
                const f32x4 eg = *(const LAS f32x4*)(EGs + 16 * mt + 4 * gq), ek = *(const LAS f32x4*)(EKs + 16 * mt + 4 * gq);
                const v2u uw = ucur[mt];
                Vn[mt][0] = bflo(uw.x) - P[mt][0]; Vn[mt][1] = bfhi(uw.x) - P[mt][1]; Vn[mt][2] = bflo(uw.y) - P[mt][2]; Vn[mt][3] = bfhi(uw.y) - P[mt][3];
                O[mt] = O[mt] * eg; Vs[mt] = Vn[mt] * ek; }
            const bf16x8 Vb0 = bfrag(Vn[0], Vn[1]), Vb1 = bfrag(Vn[2], Vn[3]), Vs0 = bfrag(Vs[0], Vs[1]), Vs1 = bfrag(Vs[2], Vs[3]);
#pragma unroll
            for (int i = 0; i < 4; ++i) { fw[1][i] = FR64(OKT, i, 0); fq[1][i] = FR64(OKT, i, 1); }
#pragma unroll
            for (int mt = 0; mt < 4; ++mt) {
                O[mt] = __builtin_amdgcn_mfma_f32_16x16x32_bf16(fw[0][mt], Vb0, O[mt], 0, 0, 0);
                O[mt] = __builtin_amdgcn_mfma_f32_16x16x32_bf16(fq[0][mt], Vb1, O[mt], 0, 0, 0); }
            const float gl = EGs[63];
#pragma unroll
            for (int i = 0; i < 4; ++i) { fw[0][i] = FR64(OKT, 4 + i, 0); fq[0][i] = FR64(OKT, 4 + i, 1); }
            {
                LAS bf16* ot = (LAS bf16*)(L + OOT + (n & 1) * OTS) + (4 * gq) * 136 + dv0 + c;
#pragma unroll
                for (int mt = 0; mt < 4; ++mt)
#pragma unroll
                    for (int r = 0; r < 4; ++r) ot[(16 * mt + r) * 136] = (bf16)(pk2(O[mt][r], 0.f) & 0xffffu);
            }
#pragma unroll
            for (int i = 0; i < 8; ++i) { S[i] = S[i] * gl;
                S[i] = __builtin_amdgcn_mfma_f32_16x16x32_bf16(fw[1 - (i >> 2)][i & 3], Vs0, S[i], 0, 0, 0);
                S[i] = __builtin_amdgcn_mfma_f32_16x16x32_bf16(fq[1 - (i >> 2)][i & 3], Vs1, S[i], 0, 0, 0); }
#undef FR128
#undef FR64
            if (n + 1 < SEQ / 64) {
#pragma unroll
                for (int mt = 0; mt < 4; ++mt) ucur[mt] = unext[mt]; }
            if (n > 0) GSCAN_NORM(n - 1);
            asm volatile("s_waitcnt vmcnt(2) lgkmcnt(0)" ::: "memory"); __builtin_amdgcn_s_barrier(); asm volatile("" ::: "memory");
        }
        GSCAN_ZLOAD(SEQ / 64 - 1); GSCAN_NORM(SEQ / 64 - 1);
        __syncthreads();
#undef GSCAN_ZLOAD
#undef GSCAN_NORM
#undef GSCAN_FILL
    }
}

constexpr int KS_STRIDE = 72, VT_STRIDE = 264;
__device__ __forceinline__ void swa_phase(const Frame& F, const bf16* PROJ, const float* sinks, const float* rel_bias, bf16* OB) {
    LAS unsigned char* L = F.lds;
    LAS bf16* Ks = (LAS bf16*)L;
    LAS bf16* VT = (LAS bf16*)(L + 256 * KS_STRIDE * 2);
    LAS float* BT = (LAS float*)(L + 256 * KS_STRIDE * 2 + 64 * VT_STRIDE * 2);
    const int tid = F.tid, lane = F.lane, w = F.wave, c = lane & 15, gq = lane >> 4;
#pragma unroll 1
    for (int i = tid; i < 32 * 128; i += 512) {
        const int hd = i >> 7, d = i & 127;
        int bucket = d;
        if (d >= 16) { int lg = 16 + (int)(__logf((float)d * (1.f / 16.f)) * (16.f / 2.0794415416798357f)); bucket = lg < 31 ? lg : 31; }
        BT[i] = rel_bias[bucket * 32 + hd];
    }
    __syncthreads();
    for (int unit = F.vcu; unit < NB * 32 * 4; unit += F.G) {
        const int kvh = unit & 3, n = (unit >> 2) & 31, b = unit >> 7;
        const size_t tok0 = (size_t)b * SEQ + (size_t)n * 128;
#pragma unroll
        for (int i = 0; i < 4; ++i) {
            const int ch = tid + 512 * i, key = ch >> 3, part = ch & 7;
            v4u kw = (v4u){0u, 0u, 0u, 0u}, vw = (v4u){0u, 0u, 0u, 0u};
            if (n > 0 || key >= 128) { const size_t t = tok0 - 128 + key; kw = *(const v4u*)(PROJ + t * NPROJ + CSK + kvh * 64 + part * 8); vw = *(const v4u*)(PROJ + t * NPROJ + CSV + kvh * 64 + part * 8); }
            *(LAS v4u*)(Ks + key * KS_STRIDE + part * 8) = kw;
            LAS bf16* vt = VT + (part * 8) * VT_STRIDE + key;
            vt[0 * VT_STRIDE] = (bf16)(vw.x & 0xffff); vt[1 * VT_STRIDE] = (bf16)(vw.x >> 16); vt[2 * VT_STRIDE] = (bf16)(vw.y & 0xffff); vt[3 * VT_STRIDE] = (bf16)(vw.y >> 16);
            vt[4 * VT_STRIDE] = (bf16)(vw.z & 0xffff); vt[5 * VT_STRIDE] = (bf16)(vw.z >> 16); vt[6 * VT_STRIDE] = (bf16)(vw.w & 0xffff); vt[7 * VT_STRIDE] = (bf16)(vw.w >> 16);
        }
        __syncthreads();
        const int kt0 = w & ~1;
        const int qi = 16 * w + c;
        const bf16* qp0 = PROJ + (tok0 + qi) * NPROJ + CSQ + kvh * 512 + 8 * gq;
        bf16x8 nq0 = *(const bf16x8*)qp0, nq1 = *(const bf16x8*)(qp0 + 32);
        for (int g = 0; g < 8; ++g) {
            const int head = kvh * 8 + g;
            const bf16x8 bq0 = nq0, bq1 = nq1;
            if (g < 7) { nq0 = *(const bf16x8*)(qp0 + (g + 1) * 64); nq1 = *(const bf16x8*)(qp0 + (g + 1) * 64 + 32); }
            f32x4 s[10];
#pragma unroll
            for (int i = 0; i < 10; ++i) {
                const LAS bf16* kp = Ks + (16 * (kt0 + i) + c) * KS_STRIDE + 8 * gq;
                const bf16x8 a0 = *(const LAS bf16x8*)kp, a1 = *(const LAS bf16x8*)(kp + 32);
                f32x4 z = (f32x4){0.f, 0.f, 0.f, 0.f};
                z = __builtin_amdgcn_mfma_f32_16x16x32_bf16(a0, bq0, z, 0, 0, 0);
                s[i] = __builtin_amdgcn_mfma_f32_16x16x32_bf16(a1, bq1, z, 0, 0, 0);
            }
            const float sink = sinks[head];
            const LAS float* bt = BT + head * 128;
            float m = sink;
            int d0 = qi + 128 - (16 * kt0 + 4 * gq); unsigned lim = (n > 0) ? 127u : (unsigned)qi;
            asm volatile("" : "+v"(d0), "+v"(lim));
#pragma unroll
            for (int i = 0; i < 10; ++i)
#pragma unroll
                for (int r = 0; r < 4; ++r) {
                    const int dist = d0 - (16 * i + r);
                    const float x = ((unsigned)dist <= lim) ? (s[i][r] * 0.125f + bt[dist & 127]) : -3.0e38f;
                    s[i][r] = x; m = fmaxf(m, x);
                }
            m = fmaxf(m, __shfl_xor(m, 16)); m = fmaxf(m, __shfl_xor(m, 32));
            float sum = 0.f;
#pragma unroll
            for (int i = 0; i < 10; ++i)
#pragma unroll
                for (int r = 0; r < 4; ++r) { const float p = (s[i][r] > -1.0e38f) ? __expf(s[i][r] - m) : 0.f; s[i][r] = p; sum += p; }
            sum += __shfl_xor(sum, 16); sum += __shfl_xor(sum, 32);
            const float inv = 1.f / (sum + __expf(sink - m));
            f32x4 o[4];
#pragma unroll
            for (int dt = 0; dt < 4; ++dt) o[dt] = (f32x4){0.f, 0.f, 0.f, 0.f};
#pragma unroll
            for (int ks = 0; ks < 5; ++ks) {
                v4u pw; pw.x = pk2(s[2 * ks][0], s[2 * ks][1]); pw.y = pk2(s[2 * ks][2], s[2 * ks][3]); pw.z = pk2(s[2 * ks + 1][0], s[2 * ks + 1][1]); pw.w = pk2(s[2 * ks + 1][2], s[2 * ks + 1][3]);
                const bf16x8 pb = __builtin_bit_cast(bf16x8, pw);
#pragma unroll
                for (int dt = 0; dt < 4; ++dt) {
                    const LAS bf16* vp = VT + (16 * dt + c) * VT_STRIDE + 16 * (kt0 + 2 * ks) + 4 * gq;
                    const v2u lo = *(const LAS v2u*)vp, hi = *(const LAS v2u*)(vp + 16);
                    v4u aw; aw.x = lo.x; aw.y = lo.y; aw.z = hi.x; aw.w = hi.y;
                    o[dt] = __builtin_amdgcn_mfma_f32_16x16x32_bf16(__builtin_bit_cast(bf16x8, aw), pb, o[dt], 0, 0, 0);
                }
            }
            bf16* op = OB + (tok0 + qi) * 2048 + head * 64 + 4 * gq;
#pragma unroll
            for (int dt = 0; dt < 4; ++dt) { v2u wv; wv.x = pk2(o[dt][0] * inv, o[dt][1] * inv); wv.y = pk2(o[dt][2] * inv, o[dt][3] * inv); *(v2u*)(op + 16 * dt) = wv; }
        }
        __syncthreads();
    }
}

__device__ __forceinline__ void gather_phase(const Frame& F, const bf16* H, const int* idx, bf16* XG, float* RSX) {
    const int gw = F.vcu * NWAVES + F.wave, NGW = F.G * NWAVES, lane = F.lane;
    unsigned cnt[8]; int ps[9]; ps[0] = 0;
#pragma unroll
    for (int e = 0; e < 8; ++e) { cnt[e] = F.ctl[CW_CNT + e]; ps[e + 1] = ps[e] + (int)(((cnt[e] + 255u) >> 8) << 8); }
    for (int r = gw; r < ps[8]; r += NGW) {
        int e = 0, p0 = 0; unsigned ce = cnt[0];
#pragma unroll
        for (int k = 1; k < 8; ++k) if (r >= ps[k]) { e = k; p0 = ps[k]; ce = cnt[k]; }
        const int pos = r - p0;
        v2u* dst = (v2u*)((unsigned char*)XG + (size_t)r * D) + lane;
        if ((unsigned)pos < ce) { const int t = idx[(size_t)e * T + pos]; const v4u* src = (const v4u*)(H + (size_t)t * D) + lane;
#pragma unroll
            for (int j = 0; j < 4; ++j) { const v4u x = src[64 * j]; v2u o;
                o.x = pg8::pk4_fp8(bflo(x.x) * X8_SCALE, bfhi(x.x) * X8_SCALE, bflo(x.y) * X8_SCALE, bfhi(x.y) * X8_SCALE); o.y = pg8::pk4_fp8(bflo(x.z) * X8_SCALE, bfhi(x.z) * X8_SCALE, bflo(x.w) * X8_SCALE, bfhi(x.w) * X8_SCALE);
                dst[64 * j] = o; } }
        else {
#pragma unroll
            for (int j = 0; j < 4; ++j) dst[64 * j] = (v2u){0u, 0u}; }
    }
}

__device__ __forceinline__ void final_phase(const Frame& F, const float* X, float* OUT, const bf16* YG, const float* topw, const int* slot, const float* gain) {
    const int gw = F.vcu * NWAVES + F.wave, NGW = F.G * NWAVES, lane = F.lane;
    int ps[9]; ps[0] = 0;
#pragma unroll
    for (int e = 0; e < 8; ++e) ps[e + 1] = ps[e] + (int)(((F.ctl[CW_CNT + e] + 255u) >> 8) << 8);
    for (int t = gw; t < T; t += NGW) {
        const int s0 = slot[2 * t], s1 = slot[2 * t + 1]; const float w0 = topw[2 * t], w1 = topw[2 * t + 1];
        int b0 = 0, b1 = 0;
#pragma unroll
        for (int k = 1; k < 8; ++k) { if ((s0 >> 16) == k) b0 = ps[k]; if ((s1 >> 16) == k) b1 = ps[k]; }
        const int r0 = b0 + (s0 & 0xffff), r1 = b1 + (s1 & 0xffff);
        const f32x4* xr = (const f32x4*)(X + (size_t)t * D) + lane; f32x4* outr = (f32x4*)(OUT + (size_t)t * D) + lane; const f32x4* gr = (const f32x4*)gain + lane;
        const v2u* y0 = (const v2u*)(YG + (size_t)r0 * D) + lane; const v2u* y1 = (const v2u*)(YG + (size_t)r1 * D) + lane;
        f32x4 v[8]; float ss = 0.f;
#pragma unroll
        for (int j = 0; j < 8; ++j) { const v2u a = y0[64 * j], bb = y1[64 * j]; f32x4 x = xr[64 * j];
            x.x += w0 * bflo(a.x) + w1 * bflo(bb.x); x.y += w0 * bfhi(a.x) + w1 * bfhi(bb.x); x.z += w0 * bflo(a.y) + w1 * bflo(bb.y); x.w += w0 * bfhi(a.y) + w1 * bfhi(bb.y);
            v[j] = x; ss += (x.x * x.x + x.y * x.y) + (x.z * x.z + x.w * x.w); }
        const float r = __builtin_amdgcn_rsqf(wave_sum(ss) * (1.f / D) + NORM_EPS);
#pragma unroll
        for (int j = 0; j < 8; ++j) outr[64 * j] = v[j] * r * gr[64 * j];
    }
}

constexpr int N_PHASES = 23;
typedef __attribute__((address_space(4))) const Args CArgs;
__device__ __forceinline__ CArgs* get_args() { CArgs* p = (CArgs*)__builtin_amdgcn_kernarg_segment_ptr(); asm volatile("" : "+s"(p)); return p; }
#define WSP(T_, off) ((T_*)(ws + (off)))
__device__ __forceinline__ Frame refresh(const Frame& F0) { Frame F = F0; int t = threadIdx.x; asm volatile("" : "+v"(t)); F.tid = t; F.lane = t & 63; return F; }

__device__ __forceinline__ void phase_prologue(const Frame& F0) {
    const Frame F = refresh(F0);
    CArgs* A = get_args(); unsigned char* ws = A->ws;
    const int gw = F.vcu * NWAVES + F.wave, NGW = F.G * NWAVES;
    LAS float* scr = (LAS float*)(F.lds + RING_OFF + F.wave * 16384);
    constexpr int I_IN = (D / 64) * (NPROJ / 32), I_SQ = (D / 64) * (D / 32), I_GU = (D / 64) * (FFD2 / 32), I_DN = (FFD / 64) * (D / 32);
    constexpr int NITEMS = 3 * I_SQ + I_DN;
    for (int it = F.vcu; it < NPROJ / 32 + FFD2 / 32; it += F.G) {
        LAS float* mxs = (LAS float*)(F.lds + RING_OFF + 12288);
        if (it < NPROJ / 32) win_i8_item(F, A->in[2], (unsigned char*)(ws + WS_WIN), WSP(float, WS_CS), it, mxs);
        else wgu_i8_item(F, A->in[13], A->in[14], FFD, (unsigned char*)(ws + WS_WGU), WSP(float, WS_CSF), it - NPROJ / 32, mxs); }
    for (int it = gw; it < NITEMS; it += NGW) {
        int r = it;
        if (r < 3 * I_SQ) { const int which = r / I_SQ;
            const float* src = (which == 0 ? A->in[9] : which == 1 ? A->in[10] : A->in[11]); bf16* dst = (bf16*)(ws + (which == 0 ? WS_WPG : which == 1 ? WS_WPS : WS_WO));
            tr_plain(src, D, D, dst, r % I_SQ, scr, F.lane); continue; } r -= 3 * I_SQ;
        tr_plain(A->in[15], FFD, D, (bf16*)(ws + WS_WDN), r, scr, F.lane);
    }
    const float* x_in = A->in[0]; const float* gain = A->in[1]; bf16* Hb = WSP(bf16, WS_H);
    for (int m = gw; m < T; m += NGW) rms_row<false, true>(F, x_in + (size_t)m * D, gain, (bf16*)((unsigned char*)Hb + (size_t)m * D), nullptr, m, nullptr, nullptr, WSP(float, WS_RS), nullptr);
}
__device__ __forceinline__ void moe_convert(const Frame& F, int e_lo, int e_hi, int wk, int nwk) {
    CArgs* A = get_args(); unsigned char* ws = A->ws;
    LAS float* scr = (LAS float*)(F.lds + RING_OFF + F.wave * 16384);
    constexpr int I_MGU = (D / 64) * (FFE2 / 32), I_MDN = (FFE / 64) * (D / 32);
    const int gw = wk * NWAVES + F.wave, NGW = nwk * NWAVES, nit = (e_hi - e_lo) * (I_MGU + I_MDN);
    if (e_lo == 0) {
        LAS float* mxs = (LAS float*)(F.lds + RING_OFF + 12288);
        for (int it = wk; it < NPROJ / 32; it += nwk) win_i8_item(F, A->in[2] + (size_t)D * D_IN, (unsigned char*)(ws + WS_WIN + SZ_WIN), WSP(float, WS_CS) + NPROJ, it, mxs);
        constexpr int I_SQ = (D / 64) * (D / 32);
        for (int it = gw; it < 3 * I_SQ; it += NGW) { const int which = it / I_SQ;
            const float* src = (which == 0 ? A->in[9] : which == 1 ? A->in[10] : A->in[11]) + (size_t)D * D; bf16* dst = (bf16*)(ws + (which == 0 ? WS_WPG : which == 1 ? WS_WPS : WS_WO) + SZ_SQ);
            tr_plain(src, D, D, dst, it % I_SQ, scr, F.lane); }
    }
    for (int it = gw; it < nit; it += NGW) {
        int r = it;
        if (r < (e_hi - e_lo) * I_MGU) { const int e = e_lo + r / I_MGU; tr_gu_f8(A->in[17] + (size_t)e * D * FFE, A->in[18] + (size_t)e * D * FFE, D, FFE, (unsigned char*)(ws + WS_MGU) + (size_t)e * FFE2 * D, r % I_MGU, scr, F.lane); continue; }
        r -= (e_hi - e_lo) * I_MGU;
        { const int e = e_lo + r / I_MDN; tr_plain_f8(A->in[19] + (size_t)e * FFE * D, FFE, D, (unsigned char*)(ws + WS_MDN) + (size_t)e * D * FFE, r % I_MDN, scr, F.lane); }
    }
}
template <int LYR> __device__ __forceinline__ void phase_inproj(const Frame& F0) {
    const Frame F = refresh(F0);
    CArgs* A = get_args(); unsigned char* ws = A->ws;
    pg8::Gemm g{WSP(const bf16, WS_H), WSP(const bf16, WS_WIN + LYR * SZ_WIN), T, NPROJ, D / 2}; pg8::StaticOrder S; S.init(T, NPROJ, F.G, (int)blockIdx.x);
    pg8::EpiStoreBf16I8 E{WSP(bf16, WS_R1), NPROJ, WSP(const float, WS_RS), WSP(const float, WS_CS) + LYR * NPROJ};
    pg8::gemm_phase<pg8::EpiStoreBf16I8, pg8::StaticOrder, PG8_ALIGN, PG8_SP2, 2>(F.lds + RING_OFF, g, S, E);
}
template <int LYR> __device__ __forceinline__ void phase_prep(const Frame& F0) {
    const Frame F = refresh(F0);
    CArgs* A = get_args(); unsigned char* ws = A->ws;
    gdn_prep_phase(F, WSP(const bf16, WS_R1), A->in[3] + (size_t)LYR * 4 * 4096, A->in[4] + LYR * 16, A->in[5] + LYR * 16,
                   WSP(bf16, WS_QN), WSP(bf16, WS_WB), WSP(bf16, WS_UTB), WSP(bf16, WS_QKB), WSP(bf16, WS_KTB), WSP(float, WS_EG), WSP(float, WS_EK));
    PROF_MARK(30 + 10 * LYR);
    { CArgs* A2 = get_args(); unsigned char* ws2 = A2->ws;
      swa_phase(F, (const bf16*)(ws2 + WS_R1), A2->in[7] + LYR * 32, A2->in[8], (bf16*)(ws2 + WS_OB)); }
}
template <int LYR> __device__ __forceinline__ void phase_scan(const Frame& F0) {
    const Frame F = refresh(F0);
    const bool split = F.G >= 128; const int bx = (int)blockIdx.x;
    if (!split || bx < NB * 16) { CArgs* A = get_args(); unsigned char* ws = A->ws;
      gdn_scan_phase(F, split ? bx : F.vcu, split ? NB * 16 : F.G, WSP(const bf16, WS_QN), WSP(const bf16, WS_WB), WSP(const bf16, WS_UTB), WSP(const bf16, WS_QKB), WSP(const bf16, WS_KTB), WSP(const float, WS_EG), WSP(const float, WS_EK),
                     WSP(const bf16, WS_R1), A->in[6] + LYR * 128, WSP(bf16, WS_OA)); }
    if (!split || (bx >= NB * 16 && bx < NB * 16 + CONV_WGS)) { const int nwk = split ? CONV_WGS : F.G, wk = split ? bx - NB * 16 : bx;
      moe_convert(F, LYR * (NE / 2), (LYR + 1) * (NE / 2), wk, nwk); }
    PROF_MARK(31 + 10 * LYR);
}
template <int LYR> __device__ __forceinline__ void phase_proj(const Frame& F0) {
    const Frame F = refresh(F0);
    { CArgs* A = get_args(); unsigned char* ws = A->ws;
      pg8::Gemm g{WSP(const bf16, WS_OA), WSP(const bf16, WS_WPG + LYR * SZ_SQ), T, D, D}; pg8::StaticOrder S; S.init(T, D, F.G, (int)blockIdx.x);
      pg8::EpiGateA E{WSP(bf16, WS_Y), D, WSP(const bf16, WS_R1) + CGA, NPROJ};
      pg8::gemm_phase<pg8::EpiGateA, pg8::StaticOrder, PG8_ALIGN, PG8_SP2>(F.lds + RING_OFF, g, S, E); }
    { CArgs* A = get_args(); unsigned char* ws = A->ws;
      pg8::Gemm g{WSP(const bf16, WS_OB), WSP(const bf16, WS_WPS + LYR * SZ_SQ), T, D, D}; pg8::StaticOrder S; S.init(T, D, F.G, (int)blockIdx.x);
      pg8::EpiGateB E{WSP(bf16, WS_Y), D, WSP(const bf16, WS_R1) + CGB, NPROJ};
      pg8::gemm_phase<pg8::EpiGateB, pg8::StaticOrder, PG8_ALIGN, PG8_SP2>(F.lds + RING_OFF, g, S, E); }
}
template <int LYR> __device__ __forceinline__ void phase_out(const Frame& F0) {
    const Frame F = refresh(F0);
    CArgs* A = get_args(); unsigned char* ws = A->ws;
    pg8::Gemm g{WSP(const bf16, WS_Y), WSP(const bf16, WS_WO + LYR * SZ_SQ), T, D, D}; pg8::StaticOrder S; S.init(T, D, F.G, (int)blockIdx.x);
    pg8::EpiResF32 E{LYR == 0 ? A->in[0] : (const float*)A->out, A->pad == 3 ? WSP(float, WS_YP) : A->out, D};
    pg8::gemm_phase<pg8::EpiResF32, pg8::StaticOrder, PG8_ALIGN, PG8_SP2>(F.lds + RING_OFF, g, S, E);
}
template <int LYR> __device__ __forceinline__ void phase_norm2(const Frame& F0) {
    const Frame F = refresh(F0);
    CArgs* A = get_args(); unsigned char* ws = A->ws;
    const int gw = F.vcu * NWAVES + F.wave, NGW = F.G * NWAVES;
    const float* gain = A->in[12] + (size_t)LYR * D; const float* X = A->out; bf16* Hb = WSP(bf16, WS_H);
    if constexpr (LYR == 0) { for (int m = gw; m < T; m += NGW) rms_row<false, true>(F, X + (size_t)m * D, gain, (bf16*)((unsigned char*)Hb + (size_t)m * D), nullptr, m, nullptr, nullptr, WSP(float, WS_RSF), nullptr); }
    else {
        LAS float* rwT = (LAS float*)(F.lds + RING_OFF); const float* rw = A->in[16];
        for (int i = F.tid; i < D * NE; i += NWAVES * 64) { const int cc = i >> 3, e = i & 7; rwT[e * D + cc] = rw[i]; }
        __syncthreads();
        unsigned* CNT = F.ctl + CW_CNT; int* IDX = WSP(int, WS_IDX); float* TOPW = WSP(float, WS_TOPW); int* SLOT = WSP(int, WS_SLOT);
        LAS unsigned* lcnt = (LAS unsigned*)(F.lds + RING_OFF + 65536);
        LAS int* lrec = (LAS int*)lcnt + 16;
        if (F.tid < 16) lcnt[F.tid] = 0u;
        __syncthreads();
        int nrow = 0;
        for (int m = gw; m < T; m += NGW, ++nrow) rms_row<true>(F, X + (size_t)m * D, gain, Hb + (size_t)m * D, rwT, m, CNT, IDX, TOPW, SLOT, (LAS void*)lcnt, nrow * NWAVES + F.wave);
        __syncthreads();
        const bool dry = (A->pad == 3);
        if (F.tid < 8) lcnt[8 + F.tid] = dry ? 0u : atomicAdd(CNT + F.tid, lcnt[F.tid]);
        __syncthreads();
        const int maxrows = (T + NGW - 1) / NGW;
        for (int r = F.tid; r < maxrows * NWAVES; r += NWAVES * 64) { const int i = r / NWAVES, wv = r % NWAVES, m = F.vcu * NWAVES + wv + i * NGW;
            if (m < T && !dry) {
#pragma unroll
                for (int k = 0; k < 2; ++k) { const int rc = lrec[2 * r + k], e = rc >> 16, pos = (int)lcnt[8 + e] + (rc & 0xffff); IDX[(size_t)e * T + pos] = m; SLOT[2 * m + k] = (e << 16) | pos; } } }
        __syncthreads();
    }
}
__device__ __forceinline__ void phase_gather(const Frame& F0) {
    const Frame F = refresh(F0);
    CArgs* A = get_args(); unsigned char* ws = A->ws;
    gather_phase(F, WSP(const bf16, WS_H), WSP(const int, WS_IDX), WSP(bf16, WS_XG), WSP(float, WS_RSX));
}
template <int LYR> __device__ __forceinline__ void phase_up(const Frame& F0) {
    const Frame F = refresh(F0);
    CArgs* A = get_args(); unsigned char* ws = A->ws;
    if constexpr (LYR == 0) {
        pg8::Gemm g{WSP(const bf16, WS_H), WSP(const bf16, WS_WGU), T, FFD2, D / 2}; pg8::StaticOrder S; S.init(T, FFD2, F.G, (int)blockIdx.x);
        pg8::EpiSwiGLUI8<false> E{WSP(void, WS_R1), FFD, WSP(const float, WS_RSF), WSP(const float, WS_CSF), 1.f};
        pg8::gemm_phase<pg8::EpiSwiGLUI8<false>, pg8::StaticOrder, PG8_ALIGN, PG8_SP2, 2>(F.lds + RING_OFF, g, S, E);
    } else {
        pg8::Gemm g{WSP(const bf16, WS_XG), WSP(const bf16, WS_MGU), MOE_ROWS, FFE2, D / 2}; pg8::MoeOrder S; S.init(F.ctl + CW_CNT, FFE2 / 256, F.G, F.vcu, (LAS int*)(F.lds + LDSCTL_OFF + 1024));
        pg8::EpiSwiGLUF8 E{WSP(unsigned char, WS_R1), FFE, H8_SCALE};
        pg8::gemm_phase<pg8::EpiSwiGLUF8, pg8::MoeOrder, PG8_ALIGN, PG8_SP2, 1>(F.lds + RING_OFF, g, S, E, W8_E8M0, X8_E8M0);
    }
}
template <int LYR> __device__ __forceinline__ void phase_down(const Frame& F0) {
    const Frame F = refresh(F0);
    CArgs* A = get_args(); unsigned char* ws = A->ws;
    if constexpr (LYR == 0) {
        pg8::Gemm g{WSP(const bf16, WS_R1), WSP(const bf16, WS_WDN), T, D, FFD}; pg8::StaticOrder S; S.init(T, D, F.G, (int)blockIdx.x);
        pg8::EpiResF32 E{A->out, A->pad == 3 ? WSP(float, WS_YP) : A->out, D};
        pg8::gemm_phase<pg8::EpiResF32, pg8::StaticOrder, PG8_ALIGN, PG8_SP2>(F.lds + RING_OFF, g, S, E);
    } else {
        pg8::Gemm g{WSP(const bf16, WS_R1), WSP(const bf16, WS_MDN), MOE_ROWS, D, FFE / 2}; pg8::MoeOrder S; S.init(F.ctl + CW_CNT, D / 256, F.G, F.vcu, (LAS int*)(F.lds + LDSCTL_OFF + 1024));
        pg8::EpiStoreBf16 E{WSP(bf16, WS_YG), D};
        pg8::gemm_phase<pg8::EpiStoreBf16, pg8::MoeOrder, PG8_ALIGN, PG8_SP2, 1>(F.lds + RING_OFF, g, S, E, W8_E8M0, H8_E8M0);
    }
}
template <int LYR> __device__ __forceinline__ void phase_tail(const Frame& F0) {
    const Frame F = refresh(F0);
    CArgs* A = get_args(); unsigned char* ws = A->ws;
    if constexpr (LYR == 0) {
        const int gw = F.vcu * NWAVES + F.wave, NGW = F.G * NWAVES; const float* X = A->out; const float* gain = A->in[1] + D; bf16* Hb = WSP(bf16, WS_H);
        for (int m = gw; m < T; m += NGW) rms_row<false, true>(F, X + (size_t)m * D, gain, (bf16*)((unsigned char*)Hb + (size_t)m * D), nullptr, m, nullptr, nullptr, WSP(float, WS_RS), nullptr);
    } else final_phase(F, A->out, A->pad == 3 ? WSP(float, WS_YP) : A->out, WSP(const bf16, WS_YG), WSP(const float, WS_TOPW), WSP(const int, WS_SLOT), A->in[20]);
}

#define IN(k) (lo <= (k) && (k) < hi)
#define SEAM(k) do { if (IN(k) && IN((k) + 1)) xcd_barrier(bar); PROF_MARK(k); } while (0)
template <int LYR> __device__ __forceinline__ void layer_body(const Frame& F, const XcdBarrier& bar, const int lo, const int hi) {
    constexpr int pb = 1 + 11 * LYR;
    if (IN(pb + 0)) DUP(1, phase_inproj<LYR>(F));
    SEAM(pb + 0);
    if (IN(pb + 1)) DUP(2, phase_prep<LYR>(F));
    SEAM(pb + 1);
    if (IN(pb + 2)) DUP(3, phase_scan<LYR>(F));
    SEAM(pb + 2);
    if (IN(pb + 4)) DUP(5, phase_proj<LYR>(F));
    SEAM(pb + 4);
    if (IN(pb + 5)) phase_out<LYR>(F);
    SEAM(pb + 5);
    if (IN(pb + 6)) { phase_norm2<LYR>(F); if constexpr (LYR == 0) { if ((DUPMASK >> 6) & 1) phase_norm2<LYR>(F); } }
    SEAM(pb + 6);
    if constexpr (LYR == 1) { if (IN(pb + 7)) DUP(7, phase_gather(F)); SEAM(pb + 7); }
    if (IN(pb + 8)) DUP(9 + LYR, phase_up<LYR>(F));
    SEAM(pb + 8);
    if (IN(pb + 9)) { phase_down<LYR>(F); if constexpr (LYR == 1) { if ((DUPMASK >> 11) & 1) phase_down<LYR>(F); } }
    SEAM(pb + 9);
    if (IN(pb + 10)) { phase_tail<LYR>(F); if constexpr (LYR == 0) { if ((DUPMASK >> 14) & 1) phase_tail<LYR>(F); } }
    if constexpr (LYR == 0) SEAM(pb + 10);
}

__global__ void __launch_bounds__(NWAVES * 64, 2) hybrid_fwd(Args args) {
    extern __shared__ __attribute__((aligned(16))) unsigned char lds[];
    Frame F;
    F.lds = (LAS unsigned char*)lds;
    F.MISC = (volatile LAS unsigned*)(F.lds + MISC_OFF);
    F.tid = threadIdx.x; F.lane = F.tid & 63; F.wave = __builtin_amdgcn_readfirstlane(F.tid >> 6);
    F.G = gridDim.x; { const int bx = blockIdx.x; F.vcu = (F.G % 8 == 0) ? (bx % 8) * (F.G / 8) + bx / 8 : bx; }
    F.ctl = (unsigned*)(args.ws + WS_CTL);
    for (int u = F.tid; u < (LDS_BYTES - LDSCTL_OFF) / 4; u += NWAVES * 64) ((LAS unsigned*)(F.lds + LDSCTL_OFF))[u] = 0u;
    __syncthreads();
    const int lo = args.ph_lo, hi = args.ph_hi;
    XcdBarrier bar; bar.bar = F.ctl + CW_BAR; bar.x = 0; bar.st = nullptr;
    if (hi - lo > 1) bar = xcd_barrier_post(F.ctl + CW_BAR, F.MISC + 8);
    PROF_MARK(-2);
    if (IN(0)) DUP(0, phase_prologue(F));
    SEAM(0);
    layer_body<0>(F, bar, lo, hi);
    layer_body<1>(F, bar, lo, hi);
    PROF_MARK(22);
    if (PROF_PHASE >= 0 && blockIdx.x == 0 && threadIdx.x == 0) { volatile LAS unsigned* pm_ = F.MISC + 16; const unsigned long long d_ = (((unsigned long long)pm_[3] << 32) | pm_[2]) * 32ull;
        const unsigned long long t0_ = __builtin_amdgcn_s_memrealtime(); while (__builtin_amdgcn_s_memrealtime() - t0_ < d_) __builtin_amdgcn_s_sleep(64); }
}
#undef IN
#undef SEAM

extern "C" void kernel_launch(void* const* d_in, const int* in_sizes, int n_in, void* d_out, int out_size, void* d_ws, size_t ws_size, hipStream_t stream) {
    static int grid = 0;
    if (grid == 0) {
        if (n_in != 21 || out_size != T * D || ws_size < WS_END) { fprintf(stderr, "kernel_launch: unexpected shapes (n_in %d out %d ws %zu need %zu)\n", n_in, out_size, ws_size, (size_t)WS_END); grid = -1; return; }
        int dev = 0, cus = 0, per_cu = 0;
        if (hipGetDevice(&dev) != hipSuccess || hipDeviceGetAttribute(&cus, hipDeviceAttributeMultiprocessorCount, dev) != hipSuccess) { grid = -1; return; }
        if (hipFuncSetAttribute((const void*)hybrid_fwd, hipFuncAttributeMaxDynamicSharedMemorySize, LDS_BYTES) != hipSuccess) { fprintf(stderr, "kernel_launch: hipFuncSetAttribute failed\n"); grid = -1; return; }
        if (hipOccupancyMaxActiveBlocksPerMultiprocessor(&per_cu, (const void*)hybrid_fwd, NWAVES * 64, LDS_BYTES) != hipSuccess || per_cu < 1) { fprintf(stderr, "kernel_launch: occupancy query says %d\n", per_cu); }
        (void)hipGetLastError();
        grid = cus;
    }
    if (grid < 0) return;
    if (hipMemsetAsync((char*)d_ws + WS_CTL, 0, CTL_ZERO_BYTES, stream) != hipSuccess) return;
    Args a{};
    for (int i = 0; i < 21; ++i) a.in[i] = (const float*)d_in[i];
    a.out = (float*)d_out; a.ws = (unsigned char*)d_ws; a.pad = 0;
#if MK_ONE_LAUNCH
    a.ph_lo = 0; a.ph_hi = N_PHASES; a.li = 0;
    hipLaunchKernelGGL(hybrid_fwd, dim3(grid), dim3(NWAVES * 64), LDS_BYTES, stream, a);
#else
    for (int p = 0; p < N_PHASES; ++p) {
        if (p == 8 || p == 4 || p == 15) continue;
        a.ph_lo = p; a.ph_hi = p + 1; a.li = 0; a.pad = 0;
        if (p == PROBE_PHASE) { if (p == 10 || p == 17 || p == 18 || p == 22) { a.pad = 3; hipLaunchKernelGGL(hybrid_fwd, dim3(grid), dim3(NWAVES * 64), LDS_BYTES, stream, a); a.pad = 0; }
                                else hipLaunchKernelGGL(hybrid_fwd, dim3(grid), dim3(NWAVES * 64), LDS_BYTES, stream, a); }
        hipLaunchKernelGGL(hybrid_fwd, dim3(grid), dim3(NWAVES * 64), LDS_BYTES, stream, a);
    }
#endif
}
```

```cpp
#include <hip/hip_runtime.h>
#include <cstdio>
#include <cstdint>

#ifndef MK_ONE_LAUNCH
#define MK_ONE_LAUNCH 1
#endif
#ifndef PROBE_PHASE
#define PROBE_PHASE -1
#endif
#ifndef PROF_PHASE
#define PROF_PHASE -1
#endif
#define PROF_MARK(k) do { if (PROF_PHASE >= 0 && blockIdx.x == 0 && threadIdx.x == 0) { const unsigned long long now_ = __builtin_amdgcn_s_memrealtime(); \
        volatile LAS unsigned* pm_ = F.MISC + 16; const unsigned long long prev_ = ((unsigned long long)pm_[1] << 32) | pm_[0]; \
        if ((k) == PROF_PHASE) { const unsigned long long d_ = now_ - prev_; pm_[2] = (unsigned)d_; pm_[3] = (unsigned)(d_ >> 32); } \
        pm_[0] = (unsigned)now_; pm_[1] = (unsigned)(now_ >> 32); } } while (0)
#ifndef CONV_WGS
#define CONV_WGS 128
#endif
#ifndef DUPMASK
#define DUPMASK 0
#endif
#define DUP(k, call) do { call; if ((DUPMASK >> (k)) & 1) { call; } } while (0)

namespace pg8 {
#define PG8_LAS __attribute__((address_space(3)))
typedef unsigned short bf16_t;
typedef short bf16x8 __attribute__((ext_vector_type(8)));
typedef float f32x4 __attribute__((ext_vector_type(4)));
typedef float f32x2 __attribute__((ext_vector_type(2)));
typedef unsigned u32x4 __attribute__((ext_vector_type(4)));
typedef unsigned u32x2 __attribute__((ext_vector_type(2)));
typedef __bf16 bfx2_t __attribute__((ext_vector_type(2)));
typedef int i32x8 __attribute__((ext_vector_type(8)));
typedef int i32x4v __attribute__((ext_vector_type(4)));
constexpr int BM = 256, BK = 64, HALF = 128, HTB = HALF * BK * 2, STAGE_BYTES = 8 * HTB, NXCD = 8, WGM = 8;

__host__ __device__ __forceinline__ int lds_byte(int r, int c) { const int st = (r >> 4) * 2 + (c >> 5), rr = r & 15, cc = c & 31, ob = rr * 64 + cc * 2; return st * 1024 + (ob ^ (((ob >> 9) & 1) << 5)); }
__host__ __device__ __forceinline__ void stage_rc(int b, int& R, int& C) { const int st = b / 1024, sb = b % 1024, swz = sb ^ (((sb >> 9) & 1) << 5); R = (st >> 1) * 16 + swz / 64; C = (st & 1) * 32 + (swz % 64) / 2; }
__host__ __device__ __forceinline__ int perm32(int rho) { const int n = rho >> 4, i = rho & 15; return 8 * (i >> 2) + 4 * n + (i & 3); }

__device__ __forceinline__ unsigned pk2(float lo, float hi) { f32x2 v = {lo, hi}; return __builtin_bit_cast(unsigned, __builtin_convertvector(v, bfx2_t)); }
__device__ __forceinline__ float bflo(unsigned w) { return __builtin_bit_cast(float, w << 16); }
__device__ __forceinline__ float bfhi(unsigned w) { return __builtin_bit_cast(float, w & 0xffff0000u); }
__device__ __forceinline__ float fsigmoid(float x) { return __builtin_amdgcn_rcpf(1.0f + __expf(-x)); }

__device__ __forceinline__ unsigned pk4_fp8(float a, float b, float c, float d) { unsigned w = 0; w = __builtin_amdgcn_cvt_pk_fp8_f32(a, b, w, false); w = __builtin_amdgcn_cvt_pk_fp8_f32(c, d, w, true); return w; }
struct Unit { int pm, pn, pnb; };
struct Gemm { const bf16_t* A; const bf16_t* Bt; int M, N, K; };

struct StaticOrder {
    int nM, nN, nwg, G, c;
    __host__ __device__ void init(int M, int N, int G_, int c_) { nM = M / BM; nN = N / BM; nwg = nM * nN; G = G_; c = c_; }
    __host__ __device__ bool next(int i, Unit& u) const {
        const long L = (long)i * G + c; if (L >= nwg) return false;
        int wgid = (int)L; { const int q = nwg / NXCD, r = nwg % NXCD, xcd = wgid % NXCD, off = wgid / NXCD; wgid = (xcd < r ? xcd * (q + 1) : r * (q + 1) + (xcd - r) * q) + off; }
        const int nig = WGM * nN, gid = wgid / nig, fm = gid * WGM, gsz = (nM - fm) < WGM ? (nM - fm) : WGM;
        u.pm = fm + ((wgid % nig) % gsz); u.pn = (wgid % nig) / gsz; u.pnb = u.pn; return true;
    }
    __device__ __forceinline__ void a_ready(const Unit&) const {}
    __device__ __forceinline__ void done(const Unit&) const {}
};
struct MoeOrder {
    int G, c, nN; const PG8_LAS int* tab;
    __device__ __forceinline__ void init(const unsigned* cnt, int nN_, int G_, int c_, PG8_LAS int* tab_) {
        G = G_; c = c_; nN = nN_; tab = tab_;
        if (threadIdx.x == 0) { int us = 0, bs = 0; tab_[0] = 0; tab_[16] = 0;
            for (int e = 0; e < 8; ++e) { const int nb = (int)((cnt[e] + 255u) >> 8); bs += nb; us += nb * nN_; tab_[e + 1] = us; tab_[17 + e] = bs; } }
        __syncthreads();
    }
    __device__ __forceinline__ bool next(int i, Unit& u) const {
        const int L = i * G + c; if (L >= tab[8]) return false;
        int e = 0;
#pragma unroll
        for (int k = 1; k < 8; ++k) e += (L >= tab[k]) ? 1 : 0;
        const int us = tab[e], bs = tab[16 + e], nbe = tab[17 + e] - bs;
        const int r = L - us, pn = r / nbe, blk = r - pn * nbe;
        u.pm = __builtin_amdgcn_readfirstlane(bs + blk); u.pn = __builtin_amdgcn_readfirstlane(pn); u.pnb = __builtin_amdgcn_readfirstlane(e * nN + pn); return true;
    }
    __device__ __forceinline__ void a_ready(const Unit&) const {}
    __device__ __forceinline__ void done(const Unit&) const {}
};

struct EpiStoreBf16 {
    static constexpr bool PERM = true, AFTER_DRAIN = false;
    bf16_t* O; int ldc;
    __device__ __forceinline__ void operator()(const f32x4 (&acc)[2][2][4][2], const Unit& u, int wr, int wc, int fr, int fq) const {
        const int row0 = u.pm * BM + wr * 64 + fr, col0 = u.pn * BM + wc * 32 + 8 * fq;
#pragma unroll
        for (int ai = 0; ai < 2; ++ai)
#pragma unroll
            for (int m = 0; m < 4; ++m) { bf16_t* rowp = O + (size_t)(row0 + ai * HALF + m * 16) * ldc + col0;
#pragma unroll
                for (int bj = 0; bj < 2; ++bj) { const f32x4 v0 = acc[ai][bj][m][0], v1 = acc[ai][bj][m][1];
                    u32x4 w; w.x = pk2(v0[0], v0[1]); w.y = pk2(v0[2], v0[3]); w.z = pk2(v1[0], v1[1]); w.w = pk2(v1[2], v1[3]);
                    *(u32x4*)(rowp + bj * HALF) = w; } }
    }
};
struct EpiStoreBf16I8 {
    static constexpr bool PERM = true, AFTER_DRAIN = false;
    bf16_t* O; int ldc; const float* rs; const float* cs;
    __device__ __forceinline__ void operator()(const f32x4 (&acc)[2][2][4][2], const Unit& u, int wr, int wc, int fr, int fq) const {
        const int row0 = u.pm * BM + wr * 64 + fr, col0 = u.pn * BM + wc * 32 + 8 * fq;
        f32x4 cv[2][2];
#pragma unroll
        for (int bj = 0; bj < 2; ++bj)
#pragma unroll
            for (int n = 0; n < 2; ++n) cv[bj][n] = *(const f32x4*)(cs + col0 + bj * HALF + 4 * n);
        float rsv[2][4];
#pragma unroll
        for (int ai = 0; ai < 2; ++ai)
#pragma unroll
            for (int m = 0; m < 4; ++m) rsv[ai][m] = rs[row0 + ai * HALF + m * 16];
#pragma unroll
        for (int ai = 0; ai < 2; ++ai)
#pragma unroll
            for (int m = 0; m < 4; ++m) { const int row = row0 + ai * HALF + m * 16; const float r = rsv[ai][m]; bf16_t* rowp = O + (size_t)row * ldc + col0;
#pragma unroll
                for (int bj = 0; bj < 2; ++bj) { const i32x4v a0 = __builtin_bit_cast(i32x4v, acc[ai][bj][m][0]), a1 = __builtin_bit_cast(i32x4v, acc[ai][bj][m][1]);
                    const f32x4 v0 = __builtin_convertvector(a0, f32x4) * cv[bj][0] * r, v1 = __builtin_convertvector(a1, f32x4) * cv[bj][1] * r;
                    u32x4 w; w.x = pk2(v0[0], v0[1]); w.y = pk2(v0[2], v0[3]); w.z = pk2(v1[0], v1[1]); w.w = pk2(v1[2], v1[3]);
                    *(u32x4*)(rowp + bj * HALF) = w; } }
    }
};
struct EpiSwiGLUF8 {
    static constexpr bool PERM = true, AFTER_DRAIN = false;
    unsigned char* Hd; int ldc; float osc;
    __device__ __forceinline__ void operator()(const f32x4 (&acc)[2][2][4][2], const Unit& u, int wr, int wc, int fr, int fq) const {
        const int row0 = u.pm * BM + wr * 64 + fr, col0 = u.pn * HALF + wc * 32 + 8 * fq;
#pragma unroll
        for (int ai = 0; ai < 2; ++ai)
#pragma unroll
            for (int m = 0; m < 4; ++m) { unsigned char* rowp = Hd + (size_t)(row0 + ai * HALF + m * 16) * ldc + col0;
                float o[8];
#pragma unroll
                for (int n = 0; n < 2; ++n)
#pragma unroll
                    for (int i = 0; i < 4; ++i) { const float g = acc[ai][0][m][n][i], up = acc[ai][1][m][n][i]; o[4 * n + i] = g * up * fsigmoid(g) * osc; }
                u32x2 w; w.x = pk4_fp8(o[0], o[1], o[2], o[3]); w.y = pk4_fp8(o[4], o[5], o[6], o[7]);
                *(u32x2*)rowp = w; }
    }
};
template <bool OUTF8> struct EpiSwiGLUI8 {
    static constexpr bool PERM = true, AFTER_DRAIN = false;
    void* Hd; int ldc; const float* rs; const float* cs; float osc;
    __device__ __forceinline__ void operator()(const f32x4 (&acc)[2][2][4][2], const Unit& u, int wr, int wc, int fr, int fq) const {
        const int row0 = u.pm * BM + wr * 64 + fr, col0 = u.pn * HALF + wc * 32 + 8 * fq, ccol = u.pnb * BM + wc * 32 + 8 * fq;
        f32x4 cv[2][2]; float rsv[2][4];
#pragma unroll
        for (int bj = 0; bj < 2; ++bj)
#pragma unroll
            for (int n = 0; n < 2; ++n) cv[bj][n] = *(const f32x4*)(cs + ccol + bj * HALF + 4 * n);
#pragma unroll
        for (int ai = 0; ai < 2; ++ai)
#pragma unroll
            for (int m = 0; m < 4; ++m) rsv[ai][m] = rs[row0 + ai * HALF + m * 16];
#pragma unroll
        for (int ai = 0; ai < 2; ++ai)
#pragma unroll
            for (int m = 0; m < 4; ++m) { const int row = row0 + ai * HALF + m * 16; const float r = rsv[ai][m];
                float o[8];
#pragma unroll
                for (int n = 0; n < 2; ++n) { const f32x4 gv = __builtin_convertvector(__builtin_bit_cast(i32x4v, acc[ai][0][m][n]), f32x4) * cv[0][n] * r, uv = __builtin_convertvector(__builtin_bit_cast(i32x4v, acc[ai][1][m][n]), f32x4) * cv[1][n] * r;
#pragma unroll
                    for (int i = 0; i < 4; ++i) o[4 * n + i] = gv[i] * uv[i] * fsigmoid(gv[i]); }
                if constexpr (OUTF8) { u32x2 w; w.x = pk4_fp8(o[0] * osc, o[1] * osc, o[2] * osc, o[3] * osc); w.y = pk4_fp8(o[4] * osc, o[5] * osc, o[6] * osc, o[7] * osc);
                    *(u32x2*)((unsigned char*)Hd + (size_t)row * ldc + col0) = w; }
                else { u32x4 w; w.x = pk2(o[0], o[1]); w.y = pk2(o[2], o[3]); w.z = pk2(o[4], o[5]); w.w = pk2(o[6], o[7]); *(u32x4*)((bf16_t*)Hd + (size_t)row * ldc + col0) = w; } }
    }
};
struct EpiResF32 {
    static constexpr bool PERM = false, AFTER_DRAIN = false;
    const float* base; float* out; int ldc;
    __device__ __forceinline__ void operator()(const f32x4 (&acc)[2][2][4][2], const Unit& u, int wr, int wc, int fr, int fq) const {
        const int row0 = u.pm * BM + wr * 64 + fr, col0 = u.pn * BM + wc * 32 + 4 * fq;
#pragma unroll
        for (int ai = 0; ai < 2; ++ai) {
            f32x4 b[4][2][2];
#pragma unroll
            for (int m = 0; m < 4; ++m) { const size_t off = (size_t)(row0 + ai * HALF + m * 16) * ldc + col0;
#pragma unroll
                for (int bj = 0; bj < 2; ++bj)
#pragma unroll
                    for (int n = 0; n < 2; ++n) b[m][bj][n] = *(const f32x4*)(base + off + bj * HALF + n * 16); }
            asm volatile("" ::: "memory");
#pragma unroll
            for (int m = 0; m < 4; ++m) { const size_t off = (size_t)(row0 + ai * HALF + m * 16) * ldc + col0;
#pragma unroll
                for (int bj = 0; bj < 2; ++bj)
#pragma unroll
                    for (int n = 0; n < 2; ++n) *(f32x4*)(out + off + bj * HALF + n * 16) = b[m][bj][n] + acc[ai][bj][m][n]; }
            asm volatile("" ::: "memory");
        }
    }
};
struct EpiGateA {
    static constexpr bool PERM = true, AFTER_DRAIN = false;
    bf16_t* Y; int ldc; const bf16_t* gate; int ldg;
    __device__ __forceinline__ void operator()(const f32x4 (&acc)[2][2][4][2], const Unit& u, int wr, int wc, int fr, int fq) const {
        const int row0 = u.pm * BM + wr * 64 + fr, col0 = u.pn * BM + wc * 32 + 8 * fq;
        u32x4 gws[2][4][2];
#pragma unroll
        for (int ai = 0; ai < 2; ++ai)
#pragma unroll
            for (int m = 0; m < 4; ++m)
#pragma unroll
                for (int bj = 0; bj < 2; ++bj) gws[ai][m][bj] = *(const u32x4*)(gate + (size_t)(row0 + ai * HALF + m * 16) * ldg + col0 + bj * HALF);
        asm volatile("" ::: "memory");
#pragma unroll
        for (int ai = 0; ai < 2; ++ai)
#pragma unroll
            for (int m = 0; m < 4; ++m) { const int row = row0 + ai * HALF + m * 16;
#pragma unroll
                for (int bj = 0; bj < 2; ++bj) { const u32x4 gw = gws[ai][m][bj];
                    const f32x4 v0 = acc[ai][bj][m][0], v1 = acc[ai][bj][m][1];
                    u32x4 w;
                    w.x = pk2(v0[0] * fsigmoid(bflo(gw.x)), v0[1] * fsigmoid(bfhi(gw.x))); w.y = pk2(v0[2] * fsigmoid(bflo(gw.y)), v0[3] * fsigmoid(bfhi(gw.y)));
                    w.z = pk2(v1[0] * fsigmoid(bflo(gw.z)), v1[1] * fsigmoid(bfhi(gw.z))); w.w = pk2(v1[2] * fsigmoid(bflo(gw.w)), v1[3] * fsigmoid(bfhi(gw.w)));
                    *(u32x4*)(Y + (size_t)row * ldc + col0 + bj * HALF) = w; } }
    }
};
struct EpiGateB {
    static constexpr bool PERM = true, AFTER_DRAIN = false;
    bf16_t* Y; int ldc; const bf16_t* gate; int ldg;
    __device__ __forceinline__ void operator()(const f32x4 (&acc)[2][2][4][2], const Unit& u, int wr, int wc, int fr, int fq) const {
        const int row0 = u.pm * BM + wr * 64 + fr, col0 = u.pn * BM + wc * 32 + 8 * fq;
#pragma unroll
        for (int ai = 0; ai < 2; ++ai) {
            u32x4 gws[4][2], pp[4][2];
#pragma unroll
            for (int m = 0; m < 4; ++m)
#pragma unroll
                for (int bj = 0; bj < 2; ++bj) { const int row = row0 + ai * HALF + m * 16; gws[m][bj] = *(const u32x4*)(gate + (size_t)row * ldg + col0 + bj * HALF); pp[m][bj] = *(const u32x4*)(Y + (size_t)row * ldc + col0 + bj * HALF); }
            asm volatile("" ::: "memory");
#pragma unroll
            for (int m = 0; m < 4; ++m) { const int row = row0 + ai * HALF + m * 16;
#pragma unroll
                for (int bj = 0; bj < 2; ++bj) { const u32x4 gw = gws[m][bj], p = pp[m][bj];
                    const f32x4 v0 = acc[ai][bj][m][0], v1 = acc[ai][bj][m][1];
                    u32x4 w;
                    w.x = pk2(bflo(p.x) + v0[0] * fsigmoid(bflo(gw.x)), bfhi(p.x) + v0[1] * fsigmoid(bfhi(gw.x))); w.y = pk2(bflo(p.y) + v0[2] * fsigmoid(bflo(gw.y)), bfhi(p.y) + v0[3] * fsigmoid(bfhi(gw.y)));
                    w.z = pk2(bflo(p.z) + v1[0] * fsigmoid(bflo(gw.z)), bfhi(p.z) + v1[1] * fsigmoid(bfhi(gw.z))); w.w = pk2(bflo(p.w) + v1[2] * fsigmoid(bflo(gw.w)), bfhi(p.w) + v1[3] * fsigmoid(bfhi(gw.w)));
                    *(u32x4*)(Y + (size_t)row * ldc + col0 + bj * HALF) = w; } }
            asm volatile("" ::: "memory");
        }
    }
};

template <class Epi, class Sched, bool ALIGN_EPI = false, bool SP2 = false, int MODE = 0  >
__device__ __forceinline__ void gemm_phase(PG8_LAS unsigned char* lds, const Gemm g, const Sched& S, const Epi& E, const int sw = 0x7f7f7f7f, const int sa = 0x7f7f7f7f) {
    constexpr bool F8 = (MODE == 1);
    const int tid = threadIdx.x, wid = __builtin_amdgcn_readfirstlane(tid >> 6), lane = tid & 63, wr = wid >> 2, wc = wid & 3, fr = lane & 15, fq = lane >> 4;
    const int K = g.K, nt = K / BK;
    unsigned voffA, voffB;
    { int R, C; stage_rc(tid * 16, R, C); const int Rb = Epi::PERM ? ((R & ~31) + perm32(R & 31)) : R;
      voffA = (unsigned)(R * K + C) * 2u; voffB = (unsigned)(Rb * K + C) * 2u; }
    const unsigned rstep = 64u * (unsigned)K * 2u;
    const unsigned kstep = (unsigned)(BK * 2);
    const unsigned hstep = (unsigned)HALF * (unsigned)K * 2u;
    const unsigned tstep = 2u * hstep;
    const __amdgpu_buffer_rsrc_t rsA = __builtin_amdgcn_make_buffer_rsrc((void*)g.A, 0, 0xFFFFFFFF, 0x00020000), rsB = __builtin_amdgcn_make_buffer_rsrc((void*)g.Bt, 0, 0xFFFFFFFF, 0x00020000);
    const unsigned ldsw = (unsigned)wid * 1024u;
    const int aoff = lds_byte(wr * 64 + fr, fq * 8), boff = lds_byte(wc * 32 + fr, fq * 8);
#define PG8_SA(b, h) (((b) * 2 + (h)) * HTB)
#define PG8_SB(b, h) ((4 + (b) * 2 + (h)) * HTB)
#define PG8_STAGE(bufoff, rs, soff, voff) do { _Pragma("unroll") for (int _i = 0; _i < 2; ++_i) \
        __builtin_amdgcn_raw_ptr_buffer_load_lds(rs, (PG8_LAS void*)(lds + (bufoff) + ldsw + _i * 8192), 16, (int)(voff), (int)((soff) + _i * rstep), 0, 0); } while (0)
#define PG8_LD8(p_) __builtin_shufflevector(*(const PG8_LAS i32x4v*)(p_), *(const PG8_LAS i32x4v*)((p_) + 1024), 0, 1, 2, 3, 4, 5, 6, 7)
#define PG8_LDA(dst, b, h) do { _Pragma("unroll") for (int m = 0; m < 4; ++m) { if constexpr (F8) dst##8[m] = PG8_LD8(lds + PG8_SA(b, h) + aoff + m * 2048); \
        else { _Pragma("unroll") for (int k = 0; k < 2; ++k) dst[m][k] = *(const PG8_LAS bf16x8*)(lds + PG8_SA(b, h) + aoff + m * 2048 + k * 1024); } } } while (0)
#define PG8_LDB(dst, b, h) do { _Pragma("unroll") for (int n = 0; n < 2; ++n) { if constexpr (F8) dst##8[n] = PG8_LD8(lds + PG8_SB(b, h) + boff + n * 2048); \
        else { _Pragma("unroll") for (int k = 0; k < 2; ++k) dst[n][k] = *(const PG8_LAS bf16x8*)(lds + PG8_SB(b, h) + boff + n * 2048 + k * 1024); } } } while (0)
#define PG8_CAT(x0, x1) __builtin_shufflevector(__builtin_bit_cast(i32x4v, x0), __builtin_bit_cast(i32x4v, x1), 0, 1, 2, 3, 4, 5, 6, 7)
#define PG8_MMA(ai, bj, At, Bt) do { __builtin_amdgcn_s_setprio(1); _Pragma("unroll") for (int m = 0; m < 4; ++m) _Pragma("unroll") for (int n = 0; n < 2; ++n) { \
        if constexpr (F8) acc[ai][bj][m][n] = __builtin_amdgcn_mfma_scale_f32_16x16x128_f8f6f4(Bt##8[n], At##8[m], acc[ai][bj][m][n], 0, 0, 0, sw, 0, sa); \
        else if constexpr (MODE == 2) { _Pragma("unroll") for (int k = 0; k < 2; ++k) acc[ai][bj][m][n] = __builtin_bit_cast(f32x4, __builtin_amdgcn_mfma_i32_16x16x64_i8(__builtin_bit_cast(i32x4v, Bt[n][k]), __builtin_bit_cast(i32x4v, At[m][k]), __builtin_bit_cast(i32x4v, acc[ai][bj][m][n]), 0, 0, 0)); } \
        else { _Pragma("unroll") for (int k = 0; k < 2; ++k) acc[ai][bj][m][n] = __builtin_amdgcn_mfma_f32_16x16x32_bf16(Bt[n][k], At[m][k], acc[ai][bj][m][n], 0, 0, 0); } } \
        __builtin_amdgcn_s_setprio(0); } while (0)
#define PG8_WAIT_V(n) asm volatile("s_waitcnt vmcnt(" #n ")" ::: "memory")
#define PG8_WAIT_L(n) asm volatile("s_waitcnt lgkmcnt(" #n ")" ::: "memory")
#define PG8_BAR __builtin_amdgcn_s_barrier()
#define PG8_SCHED __builtin_amdgcn_sched_barrier(0)
    Unit cur, nxt; int ui = 0;
    if (!S.next(0, cur)) return;
    f32x4 acc[2][2][4][2];
#pragma unroll
    for (int a = 0; a < 2; ++a)
#pragma unroll
        for (int b = 0; b < 2; ++b)
#pragma unroll
            for (int m = 0; m < 4; ++m)
#pragma unroll
                for (int n = 0; n < 2; ++n) acc[a][b][m][n] = (f32x4){0.f, 0.f, 0.f, 0.f};
    bf16x8 At[4][2], B0[2][2], B1[2][2]; i32x8 At8[4], B08[2], B18[2];
    unsigned cA = (unsigned)cur.pm * tstep, cB = (unsigned)cur.pnb * tstep;
    S.a_ready(cur);
    if constexpr (SP2) {
        PG8_STAGE(PG8_SB(0, 0), rsB, cB, voffB); PG8_STAGE(PG8_SB(0, 1), rsB, cB + hstep, voffB); PG8_STAGE(PG8_SA(0, 0), rsA, cA, voffA); PG8_STAGE(PG8_SA(0, 1), rsA, cA + hstep, voffA);
        if (wr == 1) PG8_BAR;
        PG8_WAIT_V(2); PG8_BAR;
        PG8_STAGE(PG8_SB(1, 0), rsB, cB + kstep, voffB); PG8_STAGE(PG8_SA(1, 0), rsA, cA + kstep, voffA); PG8_STAGE(PG8_SB(1, 1), rsB, cB + hstep + kstep, voffB);
        PG8_WAIT_V(6); PG8_BAR;
    } else {
        PG8_STAGE(PG8_SB(0, 0), rsB, cB, voffB); PG8_STAGE(PG8_SA(0, 0), rsA, cA, voffA); PG8_STAGE(PG8_SB(0, 1), rsB, cB + hstep, voffB); PG8_STAGE(PG8_SA(0, 1), rsA, cA + hstep, voffA);
        if (wr == 1) PG8_BAR;
        PG8_WAIT_V(4); PG8_BAR;
        PG8_STAGE(PG8_SB(1, 0), rsB, cB + kstep, voffB); PG8_STAGE(PG8_SA(1, 0), rsA, cA + kstep, voffA); PG8_STAGE(PG8_SB(1, 1), rsB, cB + hstep + kstep, voffB);
        PG8_WAIT_V(6); PG8_BAR;
    }
    for (;;) {
        const bool has_next = S.next(ui + 1, nxt);
        const unsigned nA = has_next ? (unsigned)nxt.pm * tstep : cA, nB = has_next ? (unsigned)nxt.pnb * tstep : cB;
        for (int t = 0; t < nt; t += 2) {
            const bool last = (t == nt - 2);
            const unsigned a1 = cA + (unsigned)(t + 1) * kstep;
            const unsigned a2 = last ? nA : cA + (unsigned)(t + 2) * kstep, b2 = last ? nB : cB + (unsigned)(t + 2) * kstep;
            const unsigned a3 = a2 + kstep, b3 = b2 + kstep;
            if (last && has_next) S.a_ready(nxt);
            if constexpr (SP2) {
            PG8_LDB(B0, 0, 0); PG8_LDB(B1, 0, 1); PG8_SCHED; PG8_LDA(At, 0, 0); PG8_STAGE(PG8_SA(1, 1), rsA, a1 + hstep, voffA);
            PG8_WAIT_V(8); PG8_WAIT_L(0); PG8_BAR; PG8_MMA(0, 0, At, B0); PG8_MMA(0, 1, At, B1); PG8_BAR; PG8_SCHED;
            PG8_LDA(At, 0, 1); PG8_STAGE(PG8_SB(0, 0), rsB, b2, voffB); PG8_STAGE(PG8_SB(0, 1), rsB, b2 + hstep, voffB); PG8_STAGE(PG8_SA(0, 0), rsA, a2, voffA);
            PG8_WAIT_V(8); PG8_WAIT_L(0); PG8_BAR; PG8_MMA(1, 0, At, B0); PG8_MMA(1, 1, At, B1); PG8_BAR; PG8_SCHED;
            PG8_LDB(B0, 1, 0); PG8_LDB(B1, 1, 1); PG8_SCHED; PG8_LDA(At, 1, 0); PG8_STAGE(PG8_SA(0, 1), rsA, a2 + hstep, voffA);
            PG8_WAIT_V(8); PG8_WAIT_L(0); PG8_BAR; PG8_MMA(0, 0, At, B0); PG8_MMA(0, 1, At, B1); PG8_BAR; PG8_SCHED;
            PG8_LDA(At, 1, 1); PG8_STAGE(PG8_SB(1, 0), rsB, b3, voffB); PG8_STAGE(PG8_SB(1, 1), rsB, b3 + hstep, voffB); PG8_STAGE(PG8_SA(1, 0), rsA, a3, voffA);
            PG8_WAIT_V(8); PG8_WAIT_L(0); PG8_BAR; PG8_MMA(1, 0, At, B0); PG8_MMA(1, 1, At, B1); PG8_BAR; PG8_SCHED;
            } else {
            PG8_LDB(B0, 0, 0); PG8_SCHED; PG8_LDA(At, 0, 0); PG8_STAGE(PG8_SA(1, 1), rsA, a1 + hstep, voffA);
            PG8_WAIT_L(8); PG8_BAR; PG8_WAIT_L(0); PG8_MMA(0, 0, At, B0); PG8_BAR; PG8_SCHED;
            PG8_LDB(B1, 0, 1); PG8_STAGE(PG8_SB(0, 0), rsB, b2, voffB);
            PG8_BAR; PG8_WAIT_L(0); PG8_MMA(0, 1, At, B1); PG8_BAR;
            PG8_LDA(At, 0, 1); PG8_STAGE(PG8_SA(0, 0), rsA, a2, voffA);
            PG8_BAR; PG8_WAIT_L(0); PG8_MMA(1, 0, At, B0); PG8_BAR; PG8_SCHED;
            PG8_STAGE(PG8_SB(0, 1), rsB, b2 + hstep, voffB);
            PG8_WAIT_V(6); PG8_BAR; PG8_MMA(1, 1, At, B1); PG8_BAR;
            PG8_LDB(B0, 1, 0); PG8_SCHED; PG8_LDA(At, 1, 0); PG8_STAGE(PG8_SA(0, 1), rsA, a2 + hstep, voffA);
            PG8_WAIT_L(8); PG8_BAR; PG8_WAIT_L(0); PG8_MMA(0, 0, At, B0); PG8_BAR; PG8_SCHED;
            PG8_LDB(B1, 1, 1); PG8_STAGE(PG8_SB(1, 0), rsB, b3, voffB);
            PG8_BAR; PG8_WAIT_L(0); PG8_MMA(0, 1, At, B1); PG8_BAR;
            PG8_LDA(At, 1, 1); PG8_STAGE(PG8_SA(1, 0), rsA, a3, voffA);
            PG8_BAR; PG8_WAIT_L(0); PG8_MMA(1, 0, At, B0); PG8_BAR; PG8_SCHED;
            PG8_STAGE(PG8_SB(1, 1), rsB, b3 + hstep, voffB);
            PG8_WAIT_V(6); PG8_BAR; PG8_MMA(1, 1, At, B1); PG8_BAR;
            }
        }
        if constexpr (ALIGN_EPI) { if (wr == 0) PG8_BAR; }
        if constexpr (!Epi::AFTER_DRAIN) { E(acc, cur, wr, wc, fr, fq); S.done(cur); }
        if (!has_next) break;
#pragma unroll
        for (int a = 0; a < 2; ++a)
#pragma unroll
            for (int b = 0; b < 2; ++b)
#pragma unroll
                for (int m = 0; m < 4; ++m)
#pragma unroll
                    for (int n = 0; n < 2; ++n) acc[a][b][m][n] = (f32x4){0.f, 0.f, 0.f, 0.f};
        cur = nxt; cA = nA; cB = nB; ++ui;
        if constexpr (ALIGN_EPI) { if (wr == 1) PG8_BAR; }
    }
    PG8_WAIT_V(0);
    if constexpr (!ALIGN_EPI) { if (wr == 0) PG8_BAR; }
    PG8_BAR;
#undef PG8_SA
#undef PG8_SB
#undef PG8_STAGE
#undef PG8_LDA
#undef PG8_LDB
#undef PG8_MMA
#undef PG8_CAT
#undef PG8_WAIT_V
#undef PG8_WAIT_L
#undef PG8_BAR
#undef PG8_SCHED
}
}

#define PG8_SP2 true
#define PG8_ALIGN true

constexpr int NWAVES = 8;
constexpr int NB = 4, SEQ = 4096, T = NB * SEQ, D = 2048;
constexpr int NPROJ = 13056;
constexpr int CQ = 0, CK = 1024, CV = 2048, CZ = 4096, CSQ = 6144, CSK = 8192, CSV = 8448, CGA = 8704, CGB = 10752, CBETA = 12800, CALPHA = 12816;
constexpr int D_IN = 12832;
constexpr int FFD = 5504, FFD2 = 11008, FFE = 7168, FFE2 = 14336, NE = 8;
constexpr int MOE_ROWS = 2 * T + NE * 256;
constexpr float NORM_EPS = 1e-6f;

constexpr size_t WS_CTL = 0, CTL_ZERO_BYTES = 1u << 20;
constexpr size_t SZ_WIN = (size_t)NPROJ * D * 2, SZ_SQ = (size_t)D * D * 2;
constexpr size_t WS_WIN = CTL_ZERO_BYTES;
constexpr size_t WS_WPG = WS_WIN + 2 * SZ_WIN;
constexpr size_t WS_WPS = WS_WPG + 2 * SZ_SQ;
constexpr size_t WS_WO = WS_WPS + 2 * SZ_SQ;
constexpr size_t WS_WGU = WS_WO + 2 * SZ_SQ;
constexpr size_t WS_WDN = WS_WGU + (size_t)FFD2 * D * 2;
constexpr size_t WS_MGU = WS_WDN + (size_t)D * FFD * 2;
constexpr size_t WS_MDN = WS_MGU + (size_t)NE * FFE2 * D * 2;
constexpr size_t WS_H = WS_MDN + (size_t)NE * D * FFE * 2;
constexpr size_t WS_R1 = WS_H + (size_t)T * D * 2;
constexpr size_t SZ_R1 = (size_t)MOE_ROWS * FFE * 2;
constexpr size_t WS_MIX = WS_R1 + SZ_R1;
constexpr size_t WS_QN = WS_MIX;
constexpr size_t WS_KN = WS_QN + (size_t)T * 1024 * 2;
constexpr size_t WS_V = WS_KN + (size_t)T * 1024 * 2;
constexpr size_t WS_ORAW = WS_V + (size_t)T * 2048 * 2;
constexpr size_t WS_OA = WS_ORAW + (size_t)T * 2048 * 4;
constexpr size_t WS_OB = WS_OA + (size_t)T * 2048 * 2;
constexpr size_t WS_G = WS_OB + (size_t)T * 2048 * 2;
constexpr size_t WS_BETA = WS_G + (size_t)T * 16 * 4;
constexpr size_t WS_MIX_END = WS_BETA + (size_t)T * 16 * 4;
constexpr size_t WS_Y = WS_QN;
constexpr size_t WS_YP = WS_ORAW;
constexpr size_t WS_XG = WS_MIX;
constexpr size_t WS_YG = WS_MIX + ((size_t)160 << 20);
constexpr size_t WS_IDX = WS_MIX_END;
constexpr size_t WS_TOPW = WS_IDX + (size_t)NE * T * 4;
constexpr size_t WS_SLOT = WS_TOPW + (size_t)T * 2 * 4;
constexpr size_t WS_QKB = WS_SLOT + (size_t)T * 2 * 4;
constexpr size_t WS_KTB = WS_QKB + (size_t)4096 * 4096 * 2;
constexpr size_t WS_EG = WS_KTB + (size_t)2048 * 8192 * 2;
constexpr size_t WS_EK = WS_EG + (size_t)T * 16 * 4;
constexpr size_t WS_RS = WS_EK + (size_t)T * 16 * 4;
constexpr size_t WS_CS = WS_RS + (size_t)T * 4;
constexpr size_t WS_CSF = WS_CS + (size_t)2 * NPROJ * 4;
constexpr size_t WS_CSM = WS_CSF + (size_t)FFD2 * 4;
constexpr size_t WS_RSF = WS_CSM + (size_t)NE * FFE2 * 4;
constexpr size_t WS_RSX = WS_RSF + (size_t)T * 4;
constexpr size_t WS_END = WS_RSX + (size_t)MOE_ROWS * 4;
constexpr size_t WS_WB = WS_R1 + (size_t)T * NPROJ * 2;
constexpr size_t WS_UTB = WS_ORAW;
static_assert(WS_WB + (size_t)4096 * 8192 * 2 <= WS_R1 + SZ_R1, "W tiles fit behind proj");
static_assert(WS_XG + (size_t)MOE_ROWS * D * 2 <= WS_YG && WS_YG + (size_t)MOE_ROWS * D * 2 <= WS_MIX_END, "moe overlays");
static_assert((size_t)T * NPROJ * 2 <= SZ_R1, "proj fits R1");
constexpr int CW_CNT = 64;
constexpr int CW_BAR = 4096;

constexpr int RING_OFF = 0, RING_BYTES = 155648;
constexpr int LDSCTL_OFF = RING_BYTES, MISC_OFF = LDSCTL_OFF + 320;
constexpr int LDS_BYTES = 163840;

#define GAS __attribute__((address_space(1)))
#define LAS __attribute__((address_space(3)))
typedef unsigned short bf16;
typedef unsigned v4u __attribute__((ext_vector_type(4)));
typedef unsigned v2u __attribute__((ext_vector_type(2)));
typedef float f32x4 __attribute__((ext_vector_type(4)));
typedef short bf16x8 __attribute__((ext_vector_type(8)));
using pg8::pk2; using pg8::bflo; using pg8::bfhi; using pg8::fsigmoid;
#define LDS_WAIT() asm volatile("s_waitcnt lgkmcnt(0)" ::: "memory")
#define VM_WAIT() asm volatile("s_waitcnt vmcnt(0)" ::: "memory")

#define XB_TMO      128
#define XB_XCNT(j)  (256  + 64 * (j))
#define XB_XSUB(j)  (1280 + 64 * (j))
#define XB_XGEN(j)  (2304 + 64 * (j))
#define XB_TOP      3328
#define XB_TOPGEN   3392
#define XCD_BAR_WORDS 3456
#define XB_SPIN_CAP (1u << 21)

__device__ __forceinline__ unsigned xb_ld(unsigned* p)              { return __hip_atomic_load(p, __ATOMIC_RELAXED, __HIP_MEMORY_SCOPE_AGENT); }
__device__ __forceinline__ unsigned xb_add(unsigned* p, unsigned v) { return __hip_atomic_fetch_add(p, v, __ATOMIC_RELAXED, __HIP_MEMORY_SCOPE_AGENT); }
__device__ __forceinline__ unsigned xb_xcc_id() { return (unsigned)__builtin_amdgcn_s_getreg((3 << 11) | 20) & 0xFu; }
#define XB_SPIN(cond, bar) do { unsigned _sp = 0; while (cond) { __builtin_amdgcn_s_sleep(1); \
    if ((++_sp & 255u) == 0u) { if (xb_ld(&(bar)[XB_TMO])) break; if (_sp > XB_SPIN_CAP) { atomicAdd(&(bar)[XB_TMO], 1u); break; } } } } while (0)

struct XcdBarrier { unsigned* bar; unsigned x; volatile LAS unsigned* st; };

__device__ __forceinline__ XcdBarrier xcd_barrier_post(unsigned* bar, volatile LAS unsigned* st) {
    XcdBarrier b; b.bar = bar; b.x = xb_xcc_id(); b.st = st;
    if (threadIdx.x == 0) (void)xb_add(&bar[XB_XCNT(b.x)], 1u);
    return b;
}
__device__ __forceinline__ void xcd_barrier_complete(unsigned* bar, unsigned x, unsigned& nloc, unsigned& nx) {
    const unsigned G = gridDim.x * gridDim.y * gridDim.z;
    unsigned sum, cnt, mine, sp = 0u;
    for (;;) {
        sum = 0u; cnt = 0u; mine = 0u;
#pragma unroll
        for (unsigned j = 0; j < 16; ++j) { const unsigned c = xb_ld(&bar[XB_XCNT(j)]); sum += c; cnt += (c > 0u) ? 1u : 0u; mine = (j == x) ? c : mine; }
        if (sum == G) break;
        __builtin_amdgcn_s_sleep(1);
        if ((++sp & 255u) == 0u) { if (xb_ld(&bar[XB_TMO])) break; if (sp > XB_SPIN_CAP) { atomicAdd(&bar[XB_TMO], 1u); break; } }
    }
    nloc = mine > 0u ? mine : 1u; nx = cnt > 0u ? cnt : 1u;
}
__device__ __forceinline__ void xcd_barrier(const XcdBarrier& b) {
    asm volatile("s_waitcnt vmcnt(0)" ::: "memory");
    __syncthreads();
    if (threadIdx.x == 0) {
        unsigned* bar = b.bar;
        __builtin_amdgcn_s_waitcnt(0);
        unsigned nloc = b.st[0], nx = b.st[1];
        if (nloc == 0u) { xcd_barrier_complete(bar, b.x, nloc, nx); b.st[0] = nloc; b.st[1] = nx; }
        const unsigned old = xb_add(&bar[XB_XSUB(b.x)], 1u);
        const unsigned gen = old / nloc;
        if (old + 1u == (gen + 1u) * nloc) {
            __builtin_amdgcn_fence(__ATOMIC_RELEASE, "agent");
            asm volatile("s_waitcnt vmcnt(0)" ::: "memory");
            const unsigned og = xb_add(&bar[XB_TOP], 1u);
            const unsigned tg = og / nx;
            if (og + 1u == (tg + 1u) * nx) xb_add(&bar[XB_TOPGEN], 1u);
            else XB_SPIN(xb_ld(&bar[XB_TOPGEN]) == tg, bar);
            __builtin_amdgcn_fence(__ATOMIC_ACQUIRE, "agent");
            xb_add(&bar[XB_XGEN(b.x)], 1u);
            asm volatile("s_waitcnt vmcnt(0)" ::: "memory");
        } else {
            XB_SPIN(xb_ld(&bar[XB_XGEN(b.x)]) == gen, bar);
            __builtin_amdgcn_fence(__ATOMIC_ACQUIRE, "agent");
            asm volatile("s_waitcnt vmcnt(0)" ::: "memory");
        }
    }
    __syncthreads();
}

struct Args {
    const float* in[21]; float* out; unsigned char* ws; int ph_lo, ph_hi, li, pad;
};
struct Frame {
    LAS unsigned char* lds;
    volatile LAS unsigned* MISC;
    unsigned* ctl;
    int tid, lane, wave, vcu, G;
};

__device__ __forceinline__ float wave_sum(float v) {
#pragma unroll
    for (int o = 1; o < 64; o <<= 1) v += __shfl_xor(v, o);
    return v;
}
template <int CTRL> __device__ __forceinline__ float dpp_f(float x) { return __builtin_bit_cast(float, __builtin_amdgcn_update_dpp(0, __builtin_bit_cast(int, x), CTRL, 0xF, 0xF, false)); }
__device__ __forceinline__ float reduce16(float x) {
    x += dpp_f<0x128>(x); x += dpp_f<0x124>(x); x += dpp_f<0x122>(x); x += dpp_f<0x121>(x); return x;
}
__device__ __forceinline__ float fsilu(float x) { return x * fsigmoid(x); }

__device__ __forceinline__ void transpose_item(const float* W, int ldw, int k0, int ns0, bf16* WT, int K, int nd0, bool zero, LAS float* scr, int lane) {
    if (!zero) {
#pragma unroll 8
        for (int i = 0; i < 32; ++i) { const int kk = 2 * i + (lane >> 5); scr[kk * 33 + (lane & 31)] = W[(size_t)(k0 + kk) * ldw + ns0 + (lane & 31)]; }
    }
    LDS_WAIT(); asm volatile("" ::: "memory");
    const int c = lane & 7;
#pragma unroll
    for (int j = 0; j < 4; ++j) { const int n = (lane >> 3) + 8 * j; const LAS float* s = scr + (8 * c) * 33 + n;
        v4u o;
        if (zero) { o = (v4u){0u, 0u, 0u, 0u}; }
        else { o.x = pk2(s[0 * 33], s[1 * 33]); o.y = pk2(s[2 * 33], s[3 * 33]); o.z = pk2(s[4 * 33], s[5 * 33]); o.w = pk2(s[6 * 33], s[7 * 33]); }
        *(GAS v4u*)(WT + (size_t)(nd0 + n) * K + k0 + 8 * c) = o; }
    LDS_WAIT(); asm volatile("" ::: "memory");
}
__device__ __forceinline__ void transpose_item_f8(const float* W, int ldw, int k0, int ns0, unsigned char* WT, int K, int nd0, float wsc, LAS float* scr, int lane) {
#pragma unroll 8
    for (int i = 0; i < 32; ++i) { const int kk = 2 * i + (lane >> 5); scr[kk * 33 + (lane & 31)] = __builtin_nontemporal_load(W + (size_t)(k0 + kk) * ldw + ns0 + (lane & 31)); }
    LDS_WAIT(); asm volatile("" ::: "memory");
    const int c = lane & 7;
#pragma unroll
    for (int j = 0; j < 4; ++j) { const int n = (lane >> 3) + 8 * j; const LAS float* s = scr + (8 * c) * 33 + n;
        v2u o; o.x = pg8::pk4_fp8(s[0 * 33] * wsc, s[1 * 33] * wsc, s[2 * 33] * wsc, s[3 * 33] * wsc); o.y = pg8::pk4_fp8(s[4 * 33] * wsc, s[5 * 33] * wsc, s[6 * 33] * wsc, s[7 * 33] * wsc);
        __builtin_nontemporal_store(o, (v2u*)(WT + (size_t)(nd0 + n) * K + k0 + 8 * c)); }
    LDS_WAIT(); asm volatile("" ::: "memory");
}
constexpr float W8_SCALE = 64.f; constexpr int W8_E8M0 = 0x79797979;
constexpr float X8_SCALE = 4.f, H8_SCALE = 4.f; constexpr int X8_E8M0 = 0x7d7d7d7d, H8_E8M0 = 0x7d7d7d7d;
__device__ __forceinline__ void tr_plain_f8(const float* W, int K, int N, unsigned char* WT, int item, LAS float* scr, int lane) {
    const int nblk = N / 32, kb = item / nblk, nb = item % nblk;
    transpose_item_f8(W, N, 64 * kb, 32 * nb, WT, K, 32 * nb, W8_SCALE, scr, lane);
}
__device__ __forceinline__ void tr_gu_f8(const float* Wg, const float* Wu, int K, int F, unsigned char* WT, int item, LAS float* scr, int lane) {
    const int nblk = (2 * F) / 32, kb = item / nblk, nb = item % nblk, nd0 = 32 * nb, pn = nd0 >> 8, j = nd0 & 255;
    const float* W = (j < 128) ? Wg : Wu; const int ns0 = 128 * pn + (j & 127);
    transpose_item_f8(W, F, 64 * kb, ns0, WT, K, nd0, W8_SCALE, scr, lane);
}
__device__ __forceinline__ void tr_plain(const float* W, int K, int N, bf16* WT, int item, LAS float* scr, int lane) {
    const int nblk = N / 32, kb = item / nblk, nb = item % nblk;
    transpose_item(W, N, 64 * kb, 32 * nb, WT, K, 32 * nb, false, scr, lane);
}
__device__ __forceinline__ void w_i8_core(const Frame& F, const float* Wblk  , int ldw, bool zero, unsigned char* WTrow0  , float* CSblk, LAS float* mxs  ) {
    const int lane = F.lane, n = lane & 31, kq = lane >> 5;
    const int k0 = 256 * F.wave + 128 * kq;
    const float* Wc = Wblk + (size_t)k0 * ldw + n;
    float v[128]; float mx = 0.f;
#pragma unroll
    for (int i = 0; i < 128; ++i) { v[i] = zero ? 0.f : Wc[(size_t)i * ldw]; mx = fmaxf(mx, fabsf(v[i])); }
    mxs[(2 * F.wave + kq) * 32 + n] = mx;
    __syncthreads();
    float cm = 0.f;
#pragma unroll
    for (int j = 0; j < 16; ++j) cm = fmaxf(cm, mxs[j * 32 + n]);
    const float iv = cm > 0.f ? 127.f / cm : 0.f;
    if (F.wave == 0 && lane < 32) CSblk[n] = cm * (1.f / 127.f);
    v4u* op = (v4u*)(WTrow0 + (size_t)n * D + k0);
#pragma unroll
    for (int q = 0; q < 8; ++q) { unsigned wd[4];
#pragma unroll
        for (int d = 0; d < 4; ++d) { const int q0 = (int)__builtin_rintf(v[16 * q + 4 * d] * iv) & 255, q1 = (int)__builtin_rintf(v[16 * q + 4 * d + 1] * iv) & 255, q2 = (int)__builtin_rintf(v[16 * q + 4 * d + 2] * iv) & 255, q3 = (int)__builtin_rintf(v[16 * q + 4 * d + 3] * iv) & 255;
            wd[d] = (unsigned)(q0 | (q1 << 8) | (q2 << 16) | (q3 << 24)); }
        op[q] = (v4u){wd[0], wd[1], wd[2], wd[3]}; }
    __syncthreads();
}
__device__ __forceinline__ void win_i8_item(const Frame& F, const float* W, unsigned char* WT, float* CS, int nb, LAS float* mxs) {
    const int nd0 = 32 * nb; const bool zero = nd0 >= 12832; const int ns0 = nd0 < 6144 ? nd0 : (nd0 < 12800 ? nd0 + 32 : (zero ? 0 : nd0 - 12800 + 6144));
    w_i8_core(F, W + ns0, D_IN, zero, WT + (size_t)nd0 * D, CS + nd0, mxs);
}
__device__ __forceinline__ void wgu_i8_item(const Frame& F, const float* Wg, const float* Wu, int Fh, unsigned char* WT, float* CS, int nb, LAS float* mxs) {
    const int nd0 = 32 * nb, pn = nd0 >> 8, j = nd0 & 255;
    w_i8_core(F, ((j < 128) ? Wg : Wu) + 128 * pn + (j & 127), Fh, false, WT + (size_t)nd0 * D, CS + nd0, mxs);
}
template <bool ROUTER, bool OUT8 = false>
__device__ __forceinline__ void rms_row(const Frame& F, const float* xrow, const float* gain, bf16* orow, const LAS float* rwT, int t, unsigned* cnt, int* idx, float* topw, int* slot, LAS void* cnt_lds = nullptr, int rec = 0) {
    const f32x4* xr = (const f32x4*)xrow + F.lane; const f32x4* gr = (const f32x4*)gain + F.lane;
    f32x4 v[8]; float ss = 0.f;
#pragma unroll
    for (int j = 0; j < 8; ++j) { v[j] = xr[64 * j]; ss += (v[j].x * v[j].x + v[j].y * v[j].y) + (v[j].z * v[j].z + v[j].w * v[j].w); }
    const float r = __builtin_amdgcn_rsqf(wave_sum(ss) * (1.f / D) + NORM_EPS);
    if constexpr (OUT8) {
        float am = 0.f;
#pragma unroll
        for (int j = 0; j < 8; ++j) { v[j] = v[j] * r * gr[64 * j]; am = fmaxf(am, fmaxf(fmaxf(fabsf(v[j].x), fabsf(v[j].y)), fmaxf(fabsf(v[j].z), fabsf(v[j].w)))); }
#pragma unroll
        for (int o = 1; o < 64; o <<= 1) am = fmaxf(am, __shfl_xor(am, o));
        const float iv = am > 0.f ? 127.f / am : 0.f;
        unsigned* o4 = (unsigned*)orow + F.lane;
#pragma unroll
        for (int j = 0; j < 8; ++j) { const int q0 = (int)__builtin_rintf(v[j].x * iv) & 255, q1 = (int)__builtin_rintf(v[j].y * iv) & 255, q2 = (int)__builtin_rintf(v[j].z * iv) & 255, q3 = (int)__builtin_rintf(v[j].w * iv) & 255;
            o4[64 * j] = (unsigned)(q0 | (q1 << 8) | (q2 << 16) | (q3 << 24)); }
        if (F.lane == 0) topw[t] = am * (1.f / 127.f);
    } else {
        v2u* o8 = (v2u*)orow + F.lane;
#pragma unroll
        for (int j = 0; j < 8; ++j) { v[j] = v[j] * r * gr[64 * j]; v2u w; w.x = pk2(v[j].x, v[j].y); w.y = pk2(v[j].z, v[j].w); o8[64 * j] = w; }
    }
    if constexpr (ROUTER) {
        float lg[8];
#pragma unroll
        for (int e = 0; e < 8; ++e) { float s = 0.f;
#pragma unroll
            for (int j = 0; j < 8; ++j) { const f32x4 w = *(const LAS f32x4*)(rwT + e * D + 4 * F.lane + 256 * j); s += (v[j].x * w.x + v[j].y * w.y) + (v[j].z * w.z + v[j].w * w.w); }
            lg[e] = wave_sum(s); asm volatile("" ::: "memory"); }
        int e1 = 0; float l1 = lg[0];
#pragma unroll
        for (int e = 1; e < 8; ++e) if (lg[e] > l1) { l1 = lg[e]; e1 = e; }
        int e2 = -1; float l2 = -3.0e38f;
#pragma unroll
        for (int e = 0; e < 8; ++e) if (e != e1 && lg[e] > l2) { l2 = lg[e]; e2 = e; }
        if (F.lane == 0) {
            const float w1 = 1.f / (1.f + __expf(l2 - l1)), w2 = 1.f - w1;
            LAS unsigned* lcnt = (LAS unsigned*)cnt_lds; LAS int* lrec = (LAS int*)cnt_lds + 16;
            const unsigned p1 = __hip_atomic_fetch_add(lcnt + e1, 1u, __ATOMIC_RELAXED, __HIP_MEMORY_SCOPE_WORKGROUP), p2 = __hip_atomic_fetch_add(lcnt + e2, 1u, __ATOMIC_RELAXED, __HIP_MEMORY_SCOPE_WORKGROUP);
            lrec[2 * rec] = (e1 << 16) | (int)p1; lrec[2 * rec + 1] = (e2 << 16) | (int)p2;
            topw[2 * t] = w1; topw[2 * t + 1] = w2;
        }
    }
}

__device__ __forceinline__ void unpack8(const v4u w, float (&f)[8]) { f[0] = bflo(w.x); f[1] = bfhi(w.x); f[2] = bflo(w.y); f[3] = bfhi(w.y); f[4] = bflo(w.z); f[5] = bfhi(w.z); f[6] = bflo(w.w); f[7] = bfhi(w.w); }

__host__ __device__ constexpr int pi5(int p) { return 4 * (p >> 3) + (p & 3) + 16 * ((p >> 2) & 1); }
__host__ __device__ constexpr int pinv5(int a) { return 8 * ((a & 15) >> 2) + (a & 3) + 4 * (a >> 4); }
constexpr int PS = 136, PQ = 72;
__device__ __forceinline__ bf16x8 afrag(const LAS bf16* p) { return *(const LAS bf16x8*)p; }
__device__ __forceinline__ bf16x8 bfrag(const f32x4 t0, const f32x4 t1) {
    v4u a; a.x = pk2(t0[0], t0[1]); a.y = pk2(t0[2], t0[3]); a.z = pk2(t1[0], t1[1]); a.w = pk2(t1[2], t1[3]); return __builtin_bit_cast(bf16x8, a);
}
#define FMIX_LO(s_, aw_, x_) asm("v_fma_mix_f32 %0, -%1, %2, %0 op_sel_hi:[1,0,0]" : "+v"(s_) : "v"(aw_), "v"(x_))
#define FMIX_HI(s_, aw_, x_) asm("v_fma_mix_f32 %0, -%1, %2, %0 op_sel:[1,0,0] op_sel_hi:[1,0,0]" : "+v"(s_) : "v"(aw_), "v"(x_))
template <int I, int M8> __device__ __forceinline__ void solve_oct(const float (&x)[64], const LAS _Float16* AMv, float& s0, float& s1) {
    if constexpr (8 * M8 < I) {
        const v4u a = *(const LAS v4u*)(AMv + I * 72 + 8 * M8);
        if constexpr (8 * M8 + 0 < I) FMIX_LO(s0, a.x, x[8 * M8 + 0]);
        if constexpr (8 * M8 + 1 < I) FMIX_HI(s1, a.x, x[8 * M8 + 1]);
        if constexpr (8 * M8 + 2 < I) FMIX_LO(s0, a.y, x[8 * M8 + 2]);
        if constexpr (8 * M8 + 3 < I) FMIX_HI(s1, a.y, x[8 * M8 + 3]);
        if constexpr (8 * M8 + 4 < I) FMIX_LO(s0, a.z, x[8 * M8 + 4]);
        if constexpr (8 * M8 + 5 < I) FMIX_HI(s1, a.z, x[8 * M8 + 5]);
        if constexpr (8 * M8 + 6 < I) FMIX_LO(s0, a.w, x[8 * M8 + 6]);
        if constexpr (8 * M8 + 7 < I) FMIX_HI(s1, a.w, x[8 * M8 + 7]);
        solve_oct<I, M8 + 1>(x, AMv, s0, s1);
    }
}
template <int I> __device__ __forceinline__ void solve_rows(float (&x)[64], const LAS _Float16* AMv) {
    if constexpr (I < 64) { float s0 = x[I], s1 = 0.f; solve_oct<I, 0>(x, AMv, s0, s1); x[I] = s0 + s1; solve_rows<I + 1>(x, AMv); }
}
#undef FMIX_LO
#undef FMIX_HI
__device__ __forceinline__ void gdn_prep_phase(const Frame& F, const bf16* PROJ, const float* convw, const float* a_log, const float* dt_bias,
                                               bf16* QN, bf16* WB, bf16* UTB, bf16* QKB, bf16* KTB, float* EG, float* EK) {
    LAS unsigned char* L = F.lds;
    LAS bf16* KS = (LAS bf16*)L; LAS bf16* QS = (LAS bf16*)(L + 17408);
    constexpr int OVS = 34816, OAM = 69632, OQK = 104448, OVEC = 122880, OTB = 124416;
    const int tid = F.tid, lane = F.lane, w = F.wave, c = lane & 15, gq = lane >> 4;
    for (int i = tid; i < 2 * 5120 / 4; i += NWAVES * 64) ((LAS unsigned*)(L + OTB))[i] = 0u;
    __syncthreads();
    const int cm = tid >> 7, cr = (tid >> 4) & 7, cg16 = tid & 15;
    v4u xr[11]; unsigned gbraw = 0u, garaw = 0u;
#define PREP_FETCH(unit_) do { const int hq_ = (unit_) & 7, n_ = ((unit_) >> 3) & 63, b_ = (unit_) >> 9; const size_t t0_ = (size_t)b_ * SEQ + (size_t)n_ * 64; \
        const int col_ = (cm == 0 ? CQ + hq_ * 128 : cm == 1 ? CK + hq_ * 128 : CV + (2 * hq_ + (cm - 2)) * 128) + 8 * cg16; \
        const bf16* pr_ = PROJ + (t0_ + 8 * cr) * NPROJ + col_; const bool head_ = (cr == 0 && (t0_ & (SEQ - 1)) == 0); \
        _Pragma("unroll") for (int j = 0; j < 11; ++j) xr[j] = (head_ && j < 3) ? (v4u){0u, 0u, 0u, 0u} : *(const v4u*)(pr_ + (ptrdiff_t)(j - 3) * NPROJ); \
        if (w < 2) { gbraw = (unsigned)PROJ[(t0_ + lane) * NPROJ + CBETA + 2 * hq_ + w]; garaw = (unsigned)PROJ[(t0_ + lane) * NPROJ + CALPHA + 2 * hq_ + w]; } } while (0)
    if (F.vcu < NB * 64 * 8) PREP_FETCH(F.vcu);
    for (int unit = F.vcu; unit < NB * 64 * 8; unit += F.G) {
        const int hq = unit & 7, n = (unit >> 3) & 63, b = unit >> 9;
        const size_t t0 = (size_t)b * SEQ + (size_t)n * 64;
        int tu_ = F.tid; asm volatile("" : "+v"(tu_));
        const int tid = tu_, lane = tu_ & 63, c = lane & 15, gq = lane >> 4, cm = tid >> 7, cr = (tid >> 4) & 7, cg16 = tid & 15;
        const float braw_c = bflo(gbraw), araw_c = bflo(garaw);
        {
            const int m = cm, r = cr, g16 = cg16;
            const int col = (m == 0 ? CQ + hq * 128 : m == 1 ? CK + hq * 128 : CV + (2 * hq + (m - 2)) * 128) + 8 * g16;
            float wt[4][8];
#pragma unroll
            for (int tap = 0; tap < 4; ++tap) { const f32x4 a = *(const f32x4*)(convw + tap * 4096 + col), bb = *(const f32x4*)(convw + tap * 4096 + col + 4);
                wt[tap][0] = a.x; wt[tap][1] = a.y; wt[tap][2] = a.z; wt[tap][3] = a.w; wt[tap][4] = bb.x; wt[tap][5] = bb.y; wt[tap][6] = bb.z; wt[tap][7] = bb.w; }
            float x0[8], x1[8], x2[8];
            unpack8(xr[0], x0); unpack8(xr[1], x1); unpack8(xr[2], x2);
            const float qs = (m == 0) ? 0.08838834764831845f : 1.0f;
            const int pm_ = g16 & 3, ppos = 32 * (g16 >> 2) + 16 * (pm_ & 1) + 4 * (pm_ >> 1);
            LAS bf16* dst = (m == 0) ? QS : (m == 1) ? KS : (LAS bf16*)(L + OVS + (m - 2) * 17408);
#pragma unroll
            for (int j = 0; j < 8; ++j) {
                float x3[8]; unpack8(xr[3 + j], x3);
                float y[8]; float ss = 0.f;
#pragma unroll
                for (int i = 0; i < 8; ++i) { float a = wt[0][i] * x0[i] + wt[1][i] * x1[i] + wt[2][i] * x2[i] + wt[3][i] * x3[i]; a = fsilu(a); y[i] = a; ss += a * a; }
                if (m < 2) { const float sc = __builtin_amdgcn_rsqf(reduce16(ss) + 1e-6f) * qs;
#pragma unroll
                    for (int i = 0; i < 8; ++i) y[i] *= sc; }
                v4u o; o.x = pk2(y[0], y[1]); o.y = pk2(y[2], y[3]); o.z = pk2(y[4], y[5]); o.w = pk2(y[6], y[7]);
                const int tok = 8 * r + j;
                if (m < 2) { v2u lo, hi2; lo.x = o.x; lo.y = o.y; hi2.x = o.z; hi2.y = o.w; *(LAS v2u*)(dst + tok * PS + ppos) = lo; *(LAS v2u*)(dst + tok * PS + ppos + 8) = hi2; }
                else *(LAS v4u*)(dst + tok * PS + 8 * g16) = o;
#pragma unroll
                for (int i = 0; i < 8; ++i) { x0[i] = x1[i]; x1[i] = x2[i]; x2[i] = x3[i]; }
            }
        }
        __syncthreads();
        if (w < 2) {
            const int h = 2 * hq + w; LAS float* GC = (LAS float*)(L + OVEC + w * 768);
            const float braw = braw_c, araw = araw_c;
            const float xx = araw + dt_bias[h]; const float sp = xx > 20.f ? xx : log1pf(__expf(xx));
            float g = -__expf(a_log[h]) * sp;
#pragma unroll
            for (int o = 1; o < 64; o <<= 1) { const float y = __shfl_up(g, o); if (lane >= o) g += y; }
            const float last = __shfl(g, 63), eg = __expf(g), ek = __expf(last - g);
            GC[lane] = g; GC[64 + lane] = eg; GC[128 + lane] = fsigmoid(braw);
            EG[(t0 + lane) * 16 + h] = eg; EK[(t0 + lane) * 16 + h] = ek;
        }
        {
#pragma unroll
            for (int i = 0; i < 2; ++i) { const int ch = tid + 512 * i, tok = ch >> 4, part = ch & 15; *(v4u*)(QN + (t0 + tok) * 1024 + hq * 128 + part * 8) = *(const LAS v4u*)(QS + tok * PS + part * 8); }
            if (tid < 256) { const int pcol = tid >> 1, half = tid & 1, dk = (pcol & 96) + pi5(pcol & 31);
                v4u* kp = (v4u*)(KTB + ((size_t)(b * 8 + hq) * 64 + n) * 8192 + (size_t)dk * 64 + 32 * half);
#pragma unroll
                for (int q8 = 0; q8 < 4; ++q8) { unsigned e[8];
#pragma unroll
                    for (int i = 0; i < 8; ++i) e[i] = (unsigned)KS[(32 * half + pi5(8 * q8 + i)) * PS + pcol];
                    v4u o; o.x = e[0] | (e[1] << 16); o.y = e[2] | (e[3] << 16); o.z = e[4] | (e[5] << 16); o.w = e[6] | (e[7] << 16); kp[q8] = o; } }
        }
        __syncthreads();
#pragma unroll
        for (int jj = 0; jj < 4; ++jj) {
            const int job = 4 * w + jj, type = job >> 4, ct = (job >> 2) & 3, st = job & 3;
            f32x4 acc = (f32x4){0.f, 0.f, 0.f, 0.f};
            if (st <= ct) {
                const LAS bf16* ap = (type ? QS : KS) + (16 * ct + c) * PS + 8 * gq; const LAS bf16* bp = KS + (16 * st + c) * PS + 8 * gq;
#pragma unroll
                for (int ks = 0; ks < 4; ++ks) acc = __builtin_amdgcn_mfma_f32_16x16x32_bf16(*(const LAS bf16x8*)(ap + 32 * ks), *(const LAS bf16x8*)(bp + 32 * ks), acc, 0, 0, 0);
            }
            const int col = 16 * st + c;
#pragma unroll
            for (int hh = 0; hh < 2; ++hh) {
                const LAS float* GC = (const LAS float*)(L + OVEC + hh * 768); const float gcol = GC[col];
                LAS bf16* AOb = (LAS bf16*)(L + OAM + hh * 17408); LAS float* AD = (LAS float*)(L + OAM + hh * 17408 + 9216); LAS bf16* QKs = (LAS bf16*)(L + OQK + hh * 9216);
#pragma unroll
                for (int r = 0; r < 4; ++r) { const int row = 16 * ct + 4 * gq + r;
                    const float dec = __expf(fminf(GC[row] - gcol, 0.f));
                    if (type == 0) { const float av = (col < row) ? GC[128 + row] * acc[r] * dec : 0.f;
                        if (st == ct) AD[(ct * 16 + (row & 15)) * 17 + (col & 15)] = av;
                        AOb[row * 72 + (col & 32) + pinv5(col & 31)] = (bf16)(pk2(st == ct ? 0.f : -av, 0.f) & 0xffffu); }
                    else QKs[row * PQ + (col & 32) + pinv5(col & 31)] = (bf16)(pk2((col <= row) ? acc[r] * dec : 0.f, 0.f) & 0xffffu); }
            }
        }
        if (unit + F.G < NB * 64 * 8) PREP_FETCH(unit + F.G);
        __syncthreads();
        {
            const int hh = w >> 2, wv = w & 3, h = 2 * hq + hh;
            const int lu = lane;
            const size_t ubh = ((size_t)(b * 16 + h) * 64 + n);
            const LAS bf16* VS = (const LAS bf16*)(L + OVS + hh * 17408);
            const LAS bf16* AOb = (const LAS bf16*)(L + OAM + hh * 17408); const LAS float* AD = (const LAS float*)(L + OAM + hh * 17408 + 9216);
            LAS bf16* Tb = (LAS bf16*)(L + OTB + hh * 5120);
            if (wv == 0) {
                const int jc = lu & 15, blk = lu >> 4; const LAS float* ad = AD + blk * 272;
                float t[16];
#pragma unroll
                for (int i = 0; i < 16; ++i) { float sacc = (i == jc) ? 1.f : 0.f;
#pragma unroll
                    for (int m = 0; m < i; ++m) sacc -= ad[i * 17 + m] * t[m];
                    t[i] = sacc; }
#pragma unroll
                for (int i = 0; i < 16; ++i) Tb[(blk * 16 + i) * 40 + pinv5(jc)] = (bf16)(pk2(t[i], 0.f) & 0xffffu);
            }
            float xb[4][4][4];
            const LAS float* GCv = (const LAS float*)(L + OVEC + hh * 768);
#pragma unroll
            for (int t4 = 0; t4 < 4; ++t4) { const int j = 64 * wv + 16 * t4 + c;
#pragma unroll
                for (int i = 0; i < 4; ++i)
#pragma unroll
                    for (int r = 0; r < 4; ++r) { const int row = 16 * i + 4 * gq + r;
                        xb[t4][i][r] = (wv < 2) ? GCv[128 + row] * bflo((unsigned)VS[row * PS + j]) : GCv[128 + row] * GCv[64 + row] * bflo((unsigned)KS[row * PS + j - 128]); } }
            __syncthreads();
            const bf16x8 fa10 = afrag(AOb + (16 + c) * 72 + 8 * gq), fa20 = afrag(AOb + (32 + c) * 72 + 8 * gq), fa30 = afrag(AOb + (48 + c) * 72 + 8 * gq), fa31 = afrag(AOb + (48 + c) * 72 + 32 + 8 * gq);
            bf16x8 ft[4];
#pragma unroll
            for (int i = 0; i < 4; ++i) ft[i] = afrag(Tb + (i * 16 + c) * 40 + 8 * gq);
            const f32x4 z4 = (f32x4){0.f, 0.f, 0.f, 0.f};
#pragma unroll
            for (int t4 = 0; t4 < 4; ++t4) { const int j = 64 * wv + 16 * t4 + c;
                f32x4 B0, B1, B2, B3;
#pragma unroll
                for (int r = 0; r < 4; ++r) { B0[r] = xb[t4][0][r]; B1[r] = xb[t4][1][r]; B2[r] = xb[t4][2][r]; B3[r] = xb[t4][3][r]; }
                const f32x4 X0 = __builtin_amdgcn_mfma_f32_16x16x32_bf16(ft[0], bfrag(B0, z4), z4, 0, 0, 0);
                const f32x4 a1 = __builtin_amdgcn_mfma_f32_16x16x32_bf16(fa10, bfrag(X0, z4), B1, 0, 0, 0);
                const f32x4 X1 = __builtin_amdgcn_mfma_f32_16x16x32_bf16(ft[1], bfrag(a1, z4), z4, 0, 0, 0);
                const bf16x8 x01 = bfrag(X0, X1);
                const f32x4 a2 = __builtin_amdgcn_mfma_f32_16x16x32_bf16(fa20, x01, B2, 0, 0, 0);
                const f32x4 X2 = __builtin_amdgcn_mfma_f32_16x16x32_bf16(ft[2], bfrag(a2, z4), z4, 0, 0, 0);
                f32x4 a3 = __builtin_amdgcn_mfma_f32_16x16x32_bf16(fa30, x01, B3, 0, 0, 0);
                a3 = __builtin_amdgcn_mfma_f32_16x16x32_bf16(fa31, bfrag(X2, z4), a3, 0, 0, 0);
                const f32x4 X3 = __builtin_amdgcn_mfma_f32_16x16x32_bf16(ft[3], bfrag(a3, z4), z4, 0, 0, 0);
                if (wv < 2) {
                    bf16* up = UTB + ubh * 8192 + (size_t)j * 64 + 4 * gq;
                    v2u o; o.x = pk2(X0[0], X0[1]); o.y = pk2(X0[2], X0[3]); *(v2u*)up = o;
                    o.x = pk2(X1[0], X1[1]); o.y = pk2(X1[2], X1[3]); *(v2u*)(up + 16) = o;
                    o.x = pk2(X2[0], X2[1]); o.y = pk2(X2[2], X2[3]); *(v2u*)(up + 32) = o;
                    o.x = pk2(X3[0], X3[1]); o.y = pk2(X3[2], X3[3]); *(v2u*)(up + 48) = o;
                } else {
                    LAS bf16* Wt = (hh ? KS : QS) + (4 * gq) * PS + j - 128;
#pragma unroll
                    for (int r = 0; r < 4; ++r) { Wt[r * PS] = (bf16)(pk2(X0[r], 0.f) & 0xffffu); Wt[(16 + r) * PS] = (bf16)(pk2(X1[r], 0.f) & 0xffffu);
                        Wt[(32 + r) * PS] = (bf16)(pk2(X2[r], 0.f) & 0xffffu); Wt[(48 + r) * PS] = (bf16)(pk2(X3[r], 0.f) & 0xffffu); }
                }
            }
        }
        __syncthreads();
#pragma unroll
        for (int hh = 0; hh < 2; ++hh) { const size_t ubh = ((size_t)(b * 16 + 2 * hq + hh) * 64 + n); const LAS bf16* Wt = hh ? KS : QS; const LAS bf16* QKs = (const LAS bf16*)(L + OQK + hh * 9216);
#pragma unroll
            for (int i = 0; i < 2; ++i) { const int ch = tid + 512 * i, tok = ch >> 4, part = ch & 15; *(v4u*)(WB + ubh * 8192 + (size_t)ch * 8) = *(const LAS v4u*)(Wt + tok * PS + part * 8); }
            { const int tok = tid >> 3, part = tid & 7; *(v4u*)(QKB + ubh * 4096 + (size_t)tid * 8) = *(const LAS v4u*)(QKs + tok * PQ + part * 8); } }
        __syncthreads();
    }
}

__device__ __forceinline__ void gdn_scan_phase(const Frame& F, const int unit0, const int ustride, const bf16* QN, const bf16* WB, const bf16* UTB, const bf16* QKB, const bf16* KTB, const float* EG, const float* EK,
                                               const bf16* PROJ, const float* gng, bf16* OA) {
    LAS unsigned char* L = F.lds;
    constexpr int OW = 0, OQ = 16384, OKT = 32768, OQK = 49152, OE = 57344, BUF = 57856, OOT = 2 * BUF, OTS = 136 * 64 * 2;
    const int tid = F.tid, lane = F.lane, w = F.wave, c = lane & 15, gq = lane >> 4, dv0 = 16 * w;
    const int r128 = lane >> 4, p128 = lane & 15, r64 = lane >> 3, p64 = lane & 7;
    for (int unit = unit0; unit < NB * 16; unit += ustride) {
        const int h = unit & 15, b = unit >> 4, hq = h >> 1;
        const size_t tb = (size_t)b * SEQ; const size_t ubh = (size_t)(b * 16 + h) * 64, ubq = (size_t)(b * 8 + hq) * 64;
        f32x4 S[8];
#pragma unroll
        for (int i = 0; i < 8; ++i) S[i] = (f32x4){0.f, 0.f, 0.f, 0.f};
        v2u ucur[4], unext[4];
        const int gtok = tid >> 3, gdv = (tid & 7) * 16;
        LAS float* GN = (LAS float*)(L + OOT + 2 * OTS);
        if (tid < 128) GN[tid] = gng[tid];
        v4u zc[2];
#define GSCAN_ZLOAD(n_) do { const bf16* zp_ = PROJ + (tb + (size_t)(n_) * 64 + gtok) * NPROJ + CZ + h * 128 + gdv; zc[0] = *(const v4u*)zp_; zc[1] = *(const v4u*)(zp_ + 8); } while (0)
#define GSCAN_NORM(n_) do { const LAS bf16* ot_ = (const LAS bf16*)(L + OOT + ((n_) & 1) * OTS) + gtok * 136 + gdv; \
            float o_[16]; { float t8_[8]; unpack8(*(const LAS v4u*)ot_, t8_); _Pragma("unroll") for (int i = 0; i < 8; ++i) o_[i] = t8_[i]; unpack8(*(const LAS v4u*)(ot_ + 8), t8_); _Pragma("unroll") for (int i = 0; i < 8; ++i) o_[8 + i] = t8_[i]; } \
            float ss_ = 0.f; _Pragma("unroll") for (int i = 0; i < 16; ++i) ss_ += o_[i] * o_[i]; \
            ss_ += __shfl_xor(ss_, 1); ss_ += __shfl_xor(ss_, 2); ss_ += __shfl_xor(ss_, 4); \
            const float r_ = __builtin_amdgcn_rsqf(ss_ * (1.f / 128.f) + NORM_EPS); \
            float z_[16]; { float t8_[8]; unpack8(zc[0], t8_); _Pragma("unroll") for (int i = 0; i < 8; ++i) z_[i] = t8_[i]; unpack8(zc[1], t8_); _Pragma("unroll") for (int i = 0; i < 8; ++i) z_[8 + i] = t8_[i]; } \
            f32x4 gg[4]; _Pragma("unroll") for (int i = 0; i < 4; ++i) gg[i] = *(const LAS f32x4*)(GN + gdv + 4 * i); \
            unsigned w_[8]; _Pragma("unroll") for (int i = 0; i < 8; ++i) w_[i] = pk2(o_[2 * i] * r_ * gg[i >> 1][(2 * i) & 3] * fsilu(z_[2 * i]), o_[2 * i + 1] * r_ * gg[i >> 1][(2 * i + 1) & 3] * fsilu(z_[2 * i + 1])); \
            v4u* op_ = (v4u*)(OA + (tb + (size_t)(n_) * 64 + gtok) * 2048 + h * 128 + gdv); op_[0] = (v4u){w_[0], w_[1], w_[2], w_[3]}; op_[1] = (v4u){w_[4], w_[5], w_[6], w_[7]}; } while (0)
        unsigned offW[2], offQ[2], offK[2], offQK;
#pragma unroll
        for (int k = 0; k < 2; ++k) { const int r = 4 * (w + 8 * k) + r128, r2 = 8 * (w + 8 * k) + r64;
            offW[k] = (unsigned)(r * 256 + ((p128 ^ (r & 15)) << 4)); offQ[k] = (unsigned)(r * 2048 + ((p128 ^ (r & 15)) << 4)); offK[k] = (unsigned)(r2 * 128 + ((p64 ^ ((r2 >> 1) & 7)) << 4)); }
        { const int r2 = 8 * w + r64; offQK = (unsigned)(r2 * 128 + ((p64 ^ ((r2 >> 1) & 7)) << 4)); }
#define GSCAN_FILL(n_, buf_) do { const size_t t0_ = tb + (size_t)(n_) * 64; LAS unsigned char* B1 = L + (buf_) * BUF; \
            const char* bw_ = (const char*)(WB + (ubh + (n_)) * 8192); const char* bq_ = (const char*)(QN + t0_ * 1024 + hq * 128); \
            const char* bk_ = (const char*)(KTB + (ubq + (n_)) * 8192); const char* bqk_ = (const char*)(QKB + (ubh + (n_)) * 4096); \
            _Pragma("unroll") for (int k = 0; k < 2; ++k) { \
                __builtin_amdgcn_global_load_lds((const unsigned*)(bw_ + offW[k]), (LAS unsigned*)(B1 + OW + (w + 8 * k) * 1024), 16, 0, 0); \
                __builtin_amdgcn_global_load_lds((const unsigned*)(bq_ + offQ[k]), (LAS unsigned*)(B1 + OQ + (w + 8 * k) * 1024), 16, 0, 0); \
                __builtin_amdgcn_global_load_lds((const unsigned*)(bk_ + offK[k]), (LAS unsigned*)(B1 + OKT + (w + 8 * k) * 1024), 16, 0, 0); } \
            __builtin_amdgcn_global_load_lds((const unsigned*)(bqk_ + offQK), (LAS unsigned*)(B1 + OQK + w * 1024), 16, 0, 0); \
            if (w < 2) __builtin_amdgcn_global_load_lds((const unsigned*)((w ? EK : EG) + (t0_ + lane) * 16 + h), (LAS unsigned*)(B1 + OE + w * 256), 4, 0, 0);     \
            _Pragma("unroll") for (int mt = 0; mt < 4; ++mt) unext[mt] = *(const v2u*)(UTB + (ubh + (n_)) * 8192 + (size_t)(dv0 + c) * 64 + 16 * mt + 4 * gq); } while (0)
        GSCAN_FILL(0, 0);
#pragma unroll
        for (int mt = 0; mt < 4; ++mt) ucur[mt] = unext[mt];
        asm volatile("s_waitcnt vmcnt(0)" ::: "memory");
        __syncthreads();
        for (int n = 0; n < SEQ / 64; ++n) {
            const int buf = n & 1;
            if (n + 1 < SEQ / 64) GSCAN_FILL(n + 1, buf ^ 1);
            if (n > 0) GSCAN_ZLOAD(n - 1);
            const LAS unsigned char* B0 = L + buf * BUF;
            const LAS float* EGs = (const LAS float*)(B0 + OE); const LAS float* EKs = EGs + 64;
#define FR128(base_, mt_, ks_) (*(const LAS bf16x8*)(B0 + (base_) + (16 * (mt_) + c) * 256 + (((4 * (ks_) + gq) ^ c) << 4)))
#define FR64(base_, mt_, ks_)  (*(const LAS bf16x8*)(B0 + (base_) + (16 * (mt_) + c) * 128 + (((4 * (ks_) + gq) ^ ((c >> 1) & 7)) << 4)))
            bf16x8 Sb[4];
#pragma unroll
            for (int ks = 0; ks < 4; ++ks) Sb[ks] = bfrag(S[2 * ks], S[2 * ks + 1]);
            f32x4 P[4], O[4];
            bf16x8 fw[2][4], fq[2][4];
#define GS_LD1(mt_, b_) do { _Pragma("unroll") for (int ks = 0; ks < 4; ++ks) { fw[b_][ks] = FR128(OW, mt_, ks); fq[b_][ks] = FR128(OQ, mt_, ks); } } while (0)
            GS_LD1(0, 0);
#pragma unroll
            for (int mt = 0; mt < 4; ++mt) {
                if (mt < 3) GS_LD1(mt + 1, (mt + 1) & 1);
                else {
#pragma unroll
                    for (int m2 = 0; m2 < 4; ++m2) { fw[0][m2] = FR64(OQK, m2, 0); fq[0][m2] = FR64(OQK, m2, 1); }
                }
                P[mt] = (f32x4){0.f, 0.f, 0.f, 0.f}; O[mt] = (f32x4){0.f, 0.f, 0.f, 0.f};
#pragma unroll
                for (int ks = 0; ks < 4; ++ks) {
                    P[mt] = __builtin_amdgcn_mfma_f32_16x16x32_bf16(fw[mt & 1][ks], Sb[ks], P[mt], 0, 0, 0);
                    O[mt] = __builtin_amdgcn_mfma_f32_16x16x32_bf16(fq[mt & 1][ks], Sb[ks], O[mt], 0, 0, 0); }
            }
#undef GS_LD1
            f32x4 Vn[4], Vs[4];
#pragma unroll
            for (int mt = 0; mt < 4; ++mt) {
                const f32x4 eg = *(const LAS f32x4*)(EGs + 16 * mt + 4 * gq), ek = *(const LAS f32x4*)(EKs + 16 * mt + 4 * gq);
                const v2u uw = ucur[mt];
                Vn[mt][0] = bflo(uw.x) - P[mt][0]; Vn[mt][1] = bfhi(uw.x) - P[mt][1]; Vn[mt][2] = bflo(uw.y) - P[mt][2]; Vn[mt][3] = bfhi(uw.y) - P[mt][3];
                O[mt] = O[mt] * eg; Vs[mt] = Vn[mt] * ek; }
            const bf16x8 Vb0 = bfrag(Vn[0], Vn[1]), Vb1 = bfrag(Vn[2], Vn[3]), Vs0 = bfrag(Vs[0], Vs[1]), Vs1 = bfrag(Vs[2], Vs[3]);
#pragma unroll
            for (int i = 0; i < 4; ++i) { fw[1][i] = FR64(OKT, i, 0); fq[1][i] = FR64(OKT, i, 1); }
#pragma unroll
            for (int mt = 0; mt < 4; ++mt) {
                O[mt] = __builtin_amdgcn_mfma_f32_16x16x32_bf16(fw[0][mt], Vb0, O[mt], 0, 0, 0);
                O[mt] = __builtin_amdgcn_mfma_f32_16x16x32_bf16(fq[0][mt], Vb1, O[mt], 0, 0, 0); }
            const float gl = EGs[63];
#pragma unroll
            for (int i = 0; i < 4; ++i) { fw[0][i] = FR64(OKT, 4 + i, 0); fq[0][i] = FR64(OKT, 4 + i, 1); }
            {
                LAS bf16* ot = (LAS bf16*)(L + OOT + (n & 1) * OTS) + (4 * gq) * 136 + dv0 + c;
#pragma unroll
                for (int mt = 0; mt < 4; ++mt)
#pragma unroll
                    for (int r = 0; r < 4; ++r) ot[(16 * mt + r) * 136] = (bf16)(pk2(O[mt][r], 0.f) & 0xffffu);
            }
#pragma unroll
            for (int i = 0; i < 8; ++i) { S[i] = S[i] * gl;
                S[i] = __builtin_amdgcn_mfma_f32_16x16x32_bf16(fw[1 - (i >> 2)][i & 3], Vs0, S[i], 0, 0, 0);
                S[i] = __builtin_amdgcn_mfma_f32_16x16x32_bf16(fq[1 - (i >> 2)][i & 3], Vs1, S[i], 0, 0, 0); }
#undef FR128
#undef FR64
            if (n + 1 < SEQ / 64) {
#pragma unroll
                for (int mt = 0; mt < 4; ++mt) ucur[mt] = unext[mt]; }
            if (n > 0) GSCAN_NORM(n - 1);
            asm volatile("s_waitcnt vmcnt(2) lgkmcnt(0)" ::: "memory"); __builtin_amdgcn_s_barrier(); asm volatile("" ::: "memory");
        }
        GSCAN_ZLOAD(SEQ / 64 - 1); GSCAN_NORM(SEQ / 64 - 1);
        __syncthreads();
#undef GSCAN_ZLOAD
#undef GSCAN_NORM
#undef GSCAN_FILL
    }
}

constexpr int KS_STRIDE = 72, VT_STRIDE = 264;
__device__ __forceinline__ void swa_phase(const Frame& F, const bf16* PROJ, const float* sinks, const float* rel_bias, bf16* OB) {
    LAS unsigned char* L = F.lds;
    LAS bf16* Ks = (LAS bf16*)L;
    LAS bf16* VT = (LAS bf16*)(L + 256 * KS_STRIDE * 2);
    LAS float* BT = (LAS float*)(L + 256 * KS_STRIDE * 2 + 64 * VT_STRIDE * 2);
    const int tid = F.tid, lane = F.lane, w = F.wave, c = lane & 15, gq = lane >> 4;
#pragma unroll 1
    for (int i = tid; i < 32 * 128; i += 512) {
        const int hd = i >> 7, d = i & 127;
        int bucket = d;
        if (d >= 16) { int lg = 16 + (int)(__logf((float)d * (1.f / 16.f)) * (16.f / 2.0794415416798357f)); bucket = lg < 31 ? lg : 31; }
        BT[i] = rel_bias[bucket * 32 + hd];
    }
    __syncthreads();
    for (int unit = F.vcu; unit < NB * 32 * 4; unit += F.G) {
        const int kvh = unit & 3, n = (unit >> 2) & 31, b = unit >> 7;
        const size_t tok0 = (size_t)b * SEQ + (size_t)n * 128;
#pragma unroll
        for (int i = 0; i < 4; ++i) {
            const int ch = tid + 512 * i, key = ch >> 3, part = ch & 7;
            v4u kw = (v4u){0u, 0u, 0u, 0u}, vw = (v4u){0u, 0u, 0u, 0u};
            if (n > 0 || key >= 128) { const size_t t = tok0 - 128 + key; kw = *(const v4u*)(PROJ + t * NPROJ + CSK + kvh * 64 + part * 8); vw = *(const v4u*)(PROJ + t * NPROJ + CSV + kvh * 64 + part * 8); }
            *(LAS v4u*)(Ks + key * KS_STRIDE + part * 8) = kw;
            LAS bf16* vt = VT + (part * 8) * VT_STRIDE + key;
            vt[0 * VT_STRIDE] = (bf16)(vw.x & 0xffff); vt[1 * VT_STRIDE] = (bf16)(vw.x >> 16); vt[2 * VT_STRIDE] = (bf16)(vw.y & 0xffff); vt[3 * VT_STRIDE] = (bf16)(vw.y >> 16);
            vt[4 * VT_STRIDE] = (bf16)(vw.z & 0xffff); vt[5 * VT_STRIDE] = (bf16)(vw.z >> 16); vt[6 * VT_STRIDE] = (bf16)(vw.w & 0xffff); vt[7 * VT_STRIDE] = (bf16)(vw.w >> 16);
        }
        __syncthreads();
        const int kt0 = w & ~1;
        const int qi = 16 * w + c;
        const bf16* qp0 = PROJ + (tok0 + qi) * NPROJ + CSQ + kvh * 512 + 8 * gq;
        bf16x8 nq0 = *(const bf16x8*)qp0, nq1 = *(const bf16x8*)(qp0 + 32);
        for (int g = 0; g < 8; ++g) {
            const int head = kvh * 8 + g;
            const bf16x8 bq0 = nq0, bq1 = nq1;
            if (g < 7) { nq0 = *(const bf16x8*)(qp0 + (g + 1) * 64); nq1 = *(const bf16x8*)(qp0 + (g + 1) * 64 + 32); }
            f32x4 s[10];
#pragma unroll
            for (int i = 0; i < 10; ++i) {
                const LAS bf16* kp = Ks + (16 * (kt0 + i) + c) * KS_STRIDE + 8 * gq;
                const bf16x8 a0 = *(const LAS bf16x8*)kp, a1 = *(const LAS bf16x8*)(kp + 32);
                f32x4 z = (f32x4){0.f, 0.f, 0.f, 0.f};
                z = __builtin_amdgcn_mfma_f32_16x16x32_bf16(a0, bq0, z, 0, 0, 0);
                s[i] = __builtin_amdgcn_mfma_f32_16x16x32_bf16(a1, bq1, z, 0, 0, 0);
            }
            const float sink = sinks[head];
            const LAS float* bt = BT + head * 128;
            float m = sink;
            int d0 = qi + 128 - (16 * kt0 + 4 * gq); unsigned lim = (n > 0) ? 127u : (unsigned)qi;
            asm volatile("" : "+v"(d0), "+v"(lim));
#pragma unroll
            for (int i = 0; i < 10; ++i)
#pragma unroll
                for (int r = 0; r < 4; ++r) {
                    const int dist = d0 - (16 * i + r);
                    const float x = ((unsigned)dist <= lim) ? (s[i][r] * 0.125f + bt[dist & 127]) : -3.0e38f;
                    s[i][r] = x; m = fmaxf(m, x);
                }
            m = fmaxf(m, __shfl_xor(m, 16)); m = fmaxf(m, __shfl_xor(m, 32));
            float sum = 0.f;
#pragma unroll
            for (int i = 0; i < 10; ++i)
#pragma unroll
                for (int r = 0; r < 4; ++r) { const float p = (s[i][r] > -1.0e38f) ? __expf(s[i][r] - m) : 0.f; s[i][r] = p; sum += p; }
            sum += __shfl_xor(sum, 16); sum += __shfl_xor(sum, 32);
            const float inv = 1.f / (sum + __expf(sink - m));
            f32x4 o[4];
#pragma unroll
            for (int dt = 0; dt < 4; ++dt) o[dt] = (f32x4){0.f, 0.f, 0.f, 0.f};
#pragma unroll
            for (int ks = 0; ks < 5; ++ks) {
                v4u pw; pw.x = pk2(s[2 * ks][0], s[2 * ks][1]); pw.y = pk2(s[2 * ks][2], s[2 * ks][3]); pw.z = pk2(s[2 * ks + 1][0], s[2 * ks + 1][1]); pw.w = pk2(s[2 * ks + 1][2], s[2 * ks + 1][3]);
                const bf16x8 pb = __builtin_bit_cast(bf16x8, pw);
#pragma unroll
                for (int dt = 0; dt < 4; ++dt) {
                    const LAS bf16* vp = VT + (16 * dt + c) * VT_STRIDE + 16 * (kt0 + 2 * ks) + 4 * gq;
                    const v2u lo = *(const LAS v2u*)vp, hi = *(const LAS v2u*)(vp + 16);
                    v4u aw; aw.x = lo.x; aw.y = lo.y; aw.z = hi.x; aw.w = hi.y;
                    o[dt] = __builtin_amdgcn_mfma_f32_16x16x32_bf16(__builtin_bit_cast(bf16x8, aw), pb, o[dt], 0, 0, 0);
                }
            }
            bf16* op = OB + (tok0 + qi) * 2048 + head * 64 + 4 * gq;
#pragma unroll
            for (int dt = 0; dt < 4; ++dt) { v2u wv; wv.x = pk2(o[dt][0] * inv, o[dt][1] * inv); wv.y = pk2(o[dt][2] * inv, o[dt][3] * inv); *(v2u*)(op + 16 * dt) = wv; }
        }
        __syncthreads();
    }
}

__device__ __forceinline__ void gather_phase(const Frame& F, const bf16* H, const int* idx, bf16* XG, float* RSX) {
    const int gw = F.vcu * NWAVES + F.wave, NGW = F.G * NWAVES, lane = F.lane;
    unsigned cnt[8]; int ps[9]; ps[0] = 0;
#pragma unroll
    for (int e = 0; e < 8; ++e) { cnt[e] = F.ctl[CW_CNT + e]; ps[e + 1] = ps[e] + (int)(((cnt[e] + 255u) >> 8) << 8); }
    for (int r = gw; r < ps[8]; r += NGW) {
        int e = 0, p0 = 0; unsigned ce = cnt[0];
#pragma unroll
        for (int k = 1; k < 8; ++k) if (r >= ps[k]) { e = k; p0 = ps[k]; ce = cnt[k]; }
        const int pos = r - p0;
        v2u* dst = (v2u*)((unsigned char*)XG + (size_t)r * D) + lane;
        if ((unsigned)pos < ce) { const int t = idx[(size_t)e * T + pos]; const v4u* src = (const v4u*)(H + (size_t)t * D) + lane;
#pragma unroll
            for (int j = 0; j < 4; ++j) { const v4u x = src[64 * j]; v2u o;
                o.x = pg8::pk4_fp8(bflo(x.x) * X8_SCALE, bfhi(x.x) * X8_SCALE, bflo(x.y) * X8_SCALE, bfhi(x.y) * X8_SCALE); o.y = pg8::pk4_fp8(bflo(x.z) * X8_SCALE, bfhi(x.z) * X8_SCALE, bflo(x.w) * X8_SCALE, bfhi(x.w) * X8_SCALE);
                dst[64 * j] = o; } }
        else {
#pragma unroll
            for (int j = 0; j < 4; ++j) dst[64 * j] = (v2u){0u, 0u}; }
    }
}

__device__ __forceinline__ void final_phase(const Frame& F, const float* X, float* OUT, const bf16* YG, const float* topw, const int* slot, const float* gain) {
    const int gw = F.vcu * NWAVES + F.wave, NGW = F.G * NWAVES, lane = F.lane;
    int ps[9]; ps[0] = 0;
#pragma unroll
    for (int e = 0; e < 8; ++e) ps[e + 1] = ps[e] + (int)(((F.ctl[CW_CNT + e] + 255u) >> 8) << 8);
    for (int t = gw; t < T; t += NGW) {
        const int s0 = slot[2 * t], s1 = slot[2 * t + 1]; const float w0 = topw[2 * t], w1 = topw[2 * t + 1];
        int b0 = 0, b1 = 0;
#pragma unroll
        for (int k = 1; k < 8; ++k) { if ((s0 >> 16) == k) b0 = ps[k]; if ((s1 >> 16) == k) b1 = ps[k]; }
        const int r0 = b0 + (s0 & 0xffff), r1 = b1 + (s1 & 0xffff);
        const f32x4* xr = (const f32x4*)(X + (size_t)t * D) + lane; f32x4* outr = (f32x4*)(OUT + (size_t)t * D) + lane; const f32x4* gr = (const f32x4*)gain + lane;
        const v2u* y0 = (const v2u*)(YG + (size_t)r0 * D) + lane; const v2u* y1 = (const v2u*)(YG + (size_t)r1 * D) + lane;
        f32x4 v[8]; float ss = 0.f;
#pragma unroll
        for (int j = 0; j < 8; ++j) { const v2u a = y0[64 * j], bb = y1[64 * j]; f32x4 x = xr[64 * j];
            x.x += w0 * bflo(a.x) + w1 * bflo(bb.x); x.y += w0 * bfhi(a.x) + w1 * bfhi(bb.x); x.z += w0 * bflo(a.y) + w1 * bflo(bb.y); x.w += w0 * bfhi(a.y) + w1 * bfhi(bb.y);
            v[j] = x; ss += (x.x * x.x + x.y * x.y) + (x.z * x.z + x.w * x.w); }
        const float r = __builtin_amdgcn_rsqf(wave_sum(ss) * (1.f / D) + NORM_EPS);
#pragma unroll
        for (int j = 0; j < 8; ++j) outr[64 * j] = v[j] * r * gr[64 * j];
    }
}

constexpr int N_PHASES = 23;
typedef __attribute__((address_space(4))) const Args CArgs;
__device__ __forceinline__ CArgs* get_args() { CArgs* p = (CArgs*)__builtin_amdgcn_kernarg_segment_ptr(); asm volatile("" : "+s"(p)); return p; }
#define WSP(T_, off) ((T_*)(ws + (off)))
__device__ __forceinline__ Frame refresh(const Frame& F0) { Frame F = F0; int t = threadIdx.x; asm volatile("" : "+v"(t)); F.tid = t; F.lane = t & 63; return F; }

__device__ __forceinline__ void phase_prologue(const Frame& F0) {
    const Frame F = refresh(F0);
    CArgs* A = get_args(); unsigned char* ws = A->ws;
    const int gw = F.vcu * NWAVES + F.wave, NGW = F.G * NWAVES;
    LAS float* scr = (LAS float*)(F.lds + RING_OFF + F.wave * 16384);
    constexpr int I_IN = (D / 64) * (NPROJ / 32), I_SQ = (D / 64) * (D / 32), I_GU = (D / 64) * (FFD2 / 32), I_DN = (FFD / 64) * (D / 32);
    constexpr int NITEMS = 3 * I_SQ + I_DN;
    for (int it = F.vcu; it < NPROJ / 32 + FFD2 / 32; it += F.G) {
        LAS float* mxs = (LAS float*)(F.lds + RING_OFF + 12288);
        if (it < NPROJ / 32) win_i8_item(F, A->in[2], (unsigned char*)(ws + WS_WIN), WSP(float, WS_CS), it, mxs);
        else wgu_i8_item(F, A->in[13], A->in[14], FFD, (unsigned char*)(ws + WS_WGU), WSP(float, WS_CSF), it - NPROJ / 32, mxs); }
    for (int it = gw; it < NITEMS; it += NGW) {
        int r = it;
        if (r < 3 * I_SQ) { const int which = r / I_SQ;
            const float* src = (which == 0 ? A->in[9] : which == 1 ? A->in[10] : A->in[11]); bf16* dst = (bf16*)(ws + (which == 0 ? WS_WPG : which == 1 ? WS_WPS : WS_WO));
            tr_plain(src, D, D, dst, r % I_SQ, scr, F.lane); continue; } r -= 3 * I_SQ;
        tr_plain(A->in[15], FFD, D, (bf16*)(ws + WS_WDN), r, scr, F.lane);
    }
    const float* x_in = A->in[0]; const float* gain = A->in[1]; bf16* Hb = WSP(bf16, WS_H);
    for (int m = gw; m < T; m += NGW) rms_row<false, true>(F, x_in + (size_t)m * D, gain, (bf16*)((unsigned char*)Hb + (size_t)m * D), nullptr, m, nullptr, nullptr, WSP(float, WS_RS), nullptr);
}
__device__ __forceinline__ void moe_convert(const Frame& F, int e_lo, int e_hi, int wk, int nwk) {
    CArgs* A = get_args(); unsigned char* ws = A->ws;
    LAS float* scr = (LAS float*)(F.lds + RING_OFF + F.wave * 16384);
    constexpr int I_MGU = (D / 64) * (FFE2 / 32), I_MDN = (FFE / 64) * (D / 32);
    const int gw = wk * NWAVES + F.wave, NGW = nwk * NWAVES, nit = (e_hi - e_lo) * (I_MGU + I_MDN);
    if (e_lo == 0) {
        LAS float* mxs = (LAS float*)(F.lds + RING_OFF + 12288);
        for (int it = wk; it < NPROJ / 32; it += nwk) win_i8_item(F, A->in[2] + (size_t)D * D_IN, (unsigned char*)(ws + WS_WIN + SZ_WIN), WSP(float, WS_CS) + NPROJ, it, mxs);
        constexpr int I_SQ = (D / 64) * (D / 32);
        for (int it = gw; it < 3 * I_SQ; it += NGW) { const int which = it / I_SQ;
            const float* src = (which == 0 ? A->in[9] : which == 1 ? A->in[10] : A->in[11]) + (size_t)D * D; bf16* dst = (bf16*)(ws + (which == 0 ? WS_WPG : which == 1 ? WS_WPS : WS_WO) + SZ_SQ);
            tr_plain(src, D, D, dst, it % I_SQ, scr, F.lane); }
    }
    for (int it = gw; it < nit; it += NGW) {
        int r = it;
        if (r < (e_hi - e_lo) * I_MGU) { const int e = e_lo + r / I_MGU; tr_gu_f8(A->in[17] + (size_t)e * D * FFE, A->in[18] + (size_t)e * D * FFE, D, FFE, (unsigned char*)(ws + WS_MGU) + (size_t)e * FFE2 * D, r % I_MGU, scr, F.lane); continue; }
        r -= (e_hi - e_lo) * I_MGU;
        { const int e = e_lo + r / I_MDN; tr_plain_f8(A->in[19] + (size_t)e * FFE * D, FFE, D, (unsigned char*)(ws + WS_MDN) + (size_t)e * D * FFE, r % I_MDN, scr, F.lane); }
    }
}
template <int LYR> __device__ __forceinline__ void phase_inproj(const Frame& F0) {
    const Frame F = refresh(F0);
    CArgs* A = get_args(); unsigned char* ws = A->ws;
    pg8::Gemm g{WSP(const bf16, WS_H), WSP(const bf16, WS_WIN + LYR * SZ_WIN), T, NPROJ, D / 2}; pg8::StaticOrder S; S.init(T, NPROJ, F.G, (int)blockIdx.x);
    pg8::EpiStoreBf16I8 E{WSP(bf16, WS_R1), NPROJ, WSP(const float, WS_RS), WSP(const float, WS_CS) + LYR * NPROJ};
    pg8::gemm_phase<pg8::EpiStoreBf16I8, pg8::StaticOrder, PG8_ALIGN, PG8_SP2, 2>(F.lds + RING_OFF, g, S, E);
}
template <int LYR> __device__ __forceinline__ void phase_prep(const Frame& F0) {
    const Frame F = refresh(F0);
    CArgs* A = get_args(); unsigned char* ws = A->ws;
    gdn_prep_phase(F, WSP(const bf16, WS_R1), A->in[3] + (size_t)LYR * 4 * 4096, A->in[4] + LYR * 16, A->in[5] + LYR * 16,
                   WSP(bf16, WS_QN), WSP(bf16, WS_WB), WSP(bf16, WS_UTB), WSP(bf16, WS_QKB), WSP(bf16, WS_KTB), WSP(float, WS_EG), WSP(float, WS_EK));
    PROF_MARK(30 + 10 * LYR);
    { CArgs* A2 = get_args(); unsigned char* ws2 = A2->ws;
      swa_phase(F, (const bf16*)(ws2 + WS_R1), A2->in[7] + LYR * 32, A2->in[8], (bf16*)(ws2 + WS_OB)); }
}
template <int LYR> __device__ __forceinline__ void phase_scan(const Frame& F0) {
    const Frame F = refresh(F0);
    const bool split = F.G >= 128; const int bx = (int)blockIdx.x;
    if (!split || bx < NB * 16) { CArgs* A = get_args(); unsigned char* ws = A->ws;
      gdn_scan_phase(F, split ? bx : F.vcu, split ? NB * 16 : F.G, WSP(const bf16, WS_QN), WSP(const bf16, WS_WB), WSP(const bf16, WS_UTB), WSP(const bf16, WS_QKB), WSP(const bf16, WS_KTB), WSP(const float, WS_EG), WSP(const float, WS_EK),
                     WSP(const bf16, WS_R1), A->in[6] + LYR * 128, WSP(bf16, WS_OA)); }
    if (!split || (bx >= NB * 16 && bx < NB * 16 + CONV_WGS)) { const int nwk = split ? CONV_WGS : F.G, wk = split ? bx - NB * 16 : bx;
      moe_convert(F, LYR * (NE / 2), (LYR + 1) * (NE / 2), wk, nwk); }
    PROF_MARK(31 + 10 * LYR);
}
template <int LYR> __device__ __forceinline__ void phase_proj(const Frame& F0) {
    const Frame F = refresh(F0);
    { CArgs* A = get_args(); unsigned char* ws = A->ws;
      pg8::Gemm g{WSP(const bf16, WS_OA), WSP(const bf16, WS_WPG + LYR * SZ_SQ), T, D, D}; pg8::StaticOrder S; S.init(T, D, F.G, (int)blockIdx.x);
      pg8::EpiGateA E{WSP(bf16, WS_Y), D, WSP(const bf16, WS_R1) + CGA, NPROJ};
      pg8::gemm_phase<pg8::EpiGateA, pg8::StaticOrder, PG8_ALIGN, PG8_SP2>(F.lds + RING_OFF, g, S, E); }
    { CArgs* A = get_args(); unsigned char* ws = A->ws;
      pg8::Gemm g{WSP(const bf16, WS_OB), WSP(const bf16, WS_WPS + LYR * SZ_SQ), T, D, D}; pg8::StaticOrder S; S.init(T, D, F.G, (int)blockIdx.x);
      pg8::EpiGateB E{WSP(bf16, WS_Y), D, WSP(const bf16, WS_R1) + CGB, NPROJ};
      pg8::gemm_phase<pg8::EpiGateB, pg8::StaticOrder, PG8_ALIGN, PG8_SP2>(F.lds + RING_OFF, g, S, E); }
}
template <int LYR> __device__ __forceinline__ void phase_out(const Frame& F0) {
    const Frame F = refresh(F0);
    CArgs* A = get_args(); unsigned char* ws = A->ws;
    pg8::Gemm g{WSP(const bf16, WS_Y), WSP(const bf16, WS_WO + LYR * SZ_SQ), T, D, D}; pg8::StaticOrder S; S.init(T, D, F.G, (int)blockIdx.x);
    pg8::EpiResF32 E{LYR == 0 ? A->in[0] : (const float*)A->out, A->pad == 3 ? WSP(float, WS_YP) : A->out, D};
    pg8::gemm_phase<pg8::EpiResF32, pg8::StaticOrder, PG8_ALIGN, PG8_SP2>(F.lds + RING_OFF, g, S, E);
}
template <int LYR> __device__ __forceinline__ void phase_norm2(const Frame& F0) {
    const Frame F = refresh(F0);
    CArgs* A = get_args(); unsigned char* ws = A->ws;
    const int gw = F.vcu * NWAVES + F.wave, NGW = F.G * NWAVES;
    const float* gain = A->in[12] + (size_t)LYR * D; const float* X = A->out; bf16* Hb = WSP(bf16, WS_H);
    if constexpr (LYR == 0) { for (int m = gw; m < T; m += NGW) rms_row<false, true>(F, X + (size_t)m * D, gain, (bf16*)((unsigned char*)Hb + (size_t)m * D), nullptr, m, nullptr, nullptr, WSP(float, WS_RSF), nullptr); }
    else {
        LAS float* rwT = (LAS float*)(F.lds + RING_OFF); const float* rw = A->in[16];
        for (int i = F.tid; i < D * NE; i += NWAVES * 64) { const int cc = i >> 3, e = i & 7; rwT[e * D + cc] = rw[i]; }
        __syncthreads();
        unsigned* CNT = F.ctl + CW_CNT; int* IDX = WSP(int, WS_IDX); float* TOPW = WSP(float, WS_TOPW); int* SLOT = WSP(int, WS_SLOT);
        LAS unsigned* lcnt = (LAS unsigned*)(F.lds + RING_OFF + 65536);
        LAS int* lrec = (LAS int*)lcnt + 16;
        if (F.tid < 16) lcnt[F.tid] = 0u;
        __syncthreads();
        int nrow = 0;
        for (int m = gw; m < T; m += NGW, ++nrow) rms_row<true>(F, X + (size_t)m * D, gain, Hb + (size_t)m * D, rwT, m, CNT, IDX, TOPW, SLOT, (LAS void*)lcnt, nrow * NWAVES + F.wave);
        __syncthreads();
        const bool dry = (A->pad == 3);
        if (F.tid < 8) lcnt[8 + F.tid] = dry ? 0u : atomicAdd(CNT + F.tid, lcnt[F.tid]);
        __syncthreads();
        const int maxrows = (T + NGW - 1) / NGW;
        for (int r = F.tid; r < maxrows * NWAVES; r += NWAVES * 64) { const int i = r / NWAVES, wv = r % NWAVES, m = F.vcu * NWAVES + wv + i * NGW;
            if (m < T && !dry) {
#pragma unroll
                for (int k = 0; k < 2; ++k) { const int rc = lrec[2 * r + k], e = rc >> 16, pos = (int)lcnt[8 + e] + (rc & 0xffff); IDX[(size_t)e * T + pos] = m; SLOT[2 * m + k] = (e << 16) | pos; } } }
        __syncthreads();
    }
}
__device__ __forceinline__ void phase_gather(const Frame& F0) {
    const Frame F = refresh(F0);
    CArgs* A = get_args(); unsigned char* ws = A->ws;
    gather_phase(F, WSP(const bf16, WS_H), WSP(const int, WS_IDX), WSP(bf16, WS_XG), WSP(float, WS_RSX));
}
template <int LYR> __device__ __forceinline__ void phase_up(const Frame& F0) {
    const Frame F = refresh(F0);
    CArgs* A = get_args(); unsigned char* ws = A->ws;
    if constexpr (LYR == 0) {
        pg8::Gemm g{WSP(const bf16, WS_H), WSP(const bf16, WS_WGU), T, FFD2, D / 2}; pg8::StaticOrder S; S.init(T, FFD2, F.G, (int)blockIdx.x);
        pg8::EpiSwiGLUI8<false> E{WSP(void, WS_R1), FFD, WSP(const float, WS_RSF), WSP(const float, WS_CSF), 1.f};
        pg8::gemm_phase<pg8::EpiSwiGLUI8<false>, pg8::StaticOrder, PG8_ALIGN, PG8_SP2, 2>(F.lds + RING_OFF, g, S, E);
    } else {
        pg8::Gemm g{WSP(const bf16, WS_XG), WSP(const bf16, WS_MGU), MOE_ROWS, FFE2, D / 2}; pg8::MoeOrder S; S.init(F.ctl + CW_CNT, FFE2 / 256, F.G, F.vcu, (LAS int*)(F.lds + LDSCTL_OFF + 1024));
        pg8::EpiSwiGLUF8 E{WSP(unsigned char, WS_R1), FFE, H8_SCALE};
        pg8::gemm_phase<pg8::EpiSwiGLUF8, pg8::MoeOrder, PG8_ALIGN, PG8_SP2, 1>(F.lds + RING_OFF, g, S, E, W8_E8M0, X8_E8M0);
    }
}
template <int LYR> __device__ __forceinline__ void phase_down(const Frame& F0) {
    const Frame F = refresh(F0);
    CArgs* A = get_args(); unsigned char* ws = A->ws;
    if constexpr (LYR == 0) {
        pg8::Gemm g{WSP(const bf16, WS_R1), WSP(const bf16, WS_WDN), T, D, FFD}; pg8::StaticOrder S; S.init(T, D, F.G, (int)blockIdx.x);
        pg8::EpiResF32 E{A->out, A->pad == 3 ? WSP(float, WS_YP) : A->out, D};
        pg8::gemm_phase<pg8::EpiResF32, pg8::StaticOrder, PG8_ALIGN, PG8_SP2>(F.lds + RING_OFF, g, S, E);
    } else {
        pg8::Gemm g{WSP(const bf16, WS_R1), WSP(const bf16, WS_MDN), MOE_ROWS, D, FFE / 2}; pg8::MoeOrder S; S.init(F.ctl + CW_CNT, D / 256, F.G, F.vcu, (LAS int*)(F.lds + LDSCTL_OFF + 1024));
        pg8::EpiStoreBf16 E{WSP(bf16, WS_YG), D};
        pg8::gemm_phase<pg8::EpiStoreBf16, pg8::MoeOrder, PG8_ALIGN, PG8_SP2, 1>(F.lds + RING_OFF, g, S, E, W8_E8M0, H8_E8M0);
    }
}
template <int LYR> __device__ __forceinline__ void phase_tail(const Frame& F0) {
    const Frame F = refresh(F0);
    CArgs* A = get_args(); unsigned char* ws = A->ws;
    if constexpr (LYR == 0) {
        const int gw = F.vcu * NWAVES + F.wave, NGW = F.G * NWAVES; const float* X = A->out; const float* gain = A->in[1] + D; bf16* Hb = WSP(bf16, WS_H);
        for (int m = gw; m < T; m += NGW) rms_row<false, true>(F, X + (size_t)m * D, gain, (bf16*)((unsigned char*)Hb + (size_t)m * D), nullptr, m, nullptr, nullptr, WSP(float, WS_RS), nullptr);
    } else final_phase(F, A->out, A->pad == 3 ? WSP(float, WS_YP) : A->out, WSP(const bf16, WS_YG), WSP(const float, WS_TOPW), WSP(const int, WS_SLOT), A->in[20]);
}

#define IN(k) (lo <= (k) && (k) < hi)
#define SEAM(k) do { if (IN(k) && IN((k) + 1)) xcd_barrier(bar); PROF_MARK(k); } while (0)
template <int LYR> __device__ __forceinline__ void layer_body(const Frame& F, const XcdBarrier& bar, const int lo, const int hi) {
    constexpr int pb = 1 + 11 * LYR;
    if (IN(pb + 0)) DUP(1, phase_inproj<LYR>(F));
    SEAM(pb + 0);
    if (IN(pb + 1)) DUP(2, phase_prep<LYR>(F));
    SEAM(pb + 1);
    if (IN(pb + 2)) DUP(3, phase_scan<LYR>(F));
    SEAM(pb + 2);
    if (IN(pb + 4)) DUP(5, phase_proj<LYR>(F));
    SEAM(pb + 4);
    if (IN(pb + 5)) phase_out<LYR>(F);
    SEAM(pb + 5);
    if (IN(pb + 6)) { phase_norm2<LYR>(F); if constexpr (LYR == 0) { if ((DUPMASK >> 6) & 1) phase_norm2<LYR>(F); } }
    SEAM(pb + 6);
    if constexpr (LYR == 1) { if (IN(pb + 7)) DUP(7, phase_gather(F)); SEAM(pb + 7); }
    if (IN(pb + 8)) DUP(9 + LYR, phase_up<LYR>(F));
    SEAM(pb + 8);
    if (IN(pb + 9)) { phase_down<LYR>(F); if constexpr (LYR == 1) { if ((DUPMASK >> 11) & 1) phase_down<LYR>(F); } }
    SEAM(pb + 9);
    if (IN(pb + 10)) { phase_tail<LYR>(F); if constexpr (LYR == 0) { if ((DUPMASK >> 14) & 1) phase_tail<LYR>(F); } }
    if constexpr (LYR == 0) SEAM(pb + 10);
}

__global__ void __launch_bounds__(NWAVES * 64, 2) hybrid_fwd(Args args) {
    extern __shared__ __attribute__((aligned(16))) unsigned char lds[];
    Frame F;
    F.lds = (LAS unsigned char*)lds;
    F.MISC = (volatile LAS unsigned*)(F.lds + MISC_OFF);
    F.tid = threadIdx.x; F.lane = F.tid & 63; F.wave = __builtin_amdgcn_readfirstlane(F.tid >> 6);
    F.G = gridDim.x; { const int bx = blockIdx.x; F.vcu = (F.G % 8 == 0) ? (bx % 8) * (F.G / 8) + bx / 8 : bx; }
    F.ctl = (unsigned*)(args.ws + WS_CTL);
    for (int u = F.tid; u < (LDS_BYTES - LDSCTL_OFF) / 4; u += NWAVES * 64) ((LAS unsigned*)(F.lds + LDSCTL_OFF))[u] = 0u;
    __syncthreads();
    const int lo = args.ph_lo, hi = args.ph_hi;
    XcdBarrier bar; bar.bar = F.ctl + CW_BAR; bar.x = 0; bar.st = nullptr;
    if (hi - lo > 1) bar = xcd_barrier_post(F.ctl + CW_BAR, F.MISC + 8);
    PROF_MARK(-2);
    if (IN(0)) DUP(0, phase_prologue(F));
    SEAM(0);
    layer_body<0>(F, bar, lo, hi);
    layer_body<1>(F, bar, lo, hi);
    PROF_MARK(22);
    if (PROF_PHASE >= 0 && blockIdx.x == 0 && threadIdx.x == 0) { volatile LAS unsigned* pm_ = F.MISC + 16; const unsigned long long d_ = (((unsigned long long)pm_[3] << 32) | pm_[2]) * 32ull;
        const unsigned long long t0_ = __builtin_amdgcn_s_memrealtime(); while (__builtin_amdgcn_s_memrealtime() - t0_ < d_) __builtin_amdgcn_s_sleep(64); }
}
#undef IN
#undef SEAM

extern "C" void kernel_launch(void* const* d_in, const int* in_sizes, int n_in, void* d_out, int out_size, void* d_ws, size_t ws_size, hipStream_t stream) {
    static int grid = 0;
    if (grid == 0) {
        if (n_in != 21 || out_size != T * D || ws_size < WS_END) { fprintf(stderr, "kernel_launch: unexpected shapes (n_in %d out %d ws %zu need %zu)\n", n_in, out_size, ws_size, (size_t)WS_END); grid = -1; return; }
        int dev = 0, cus = 0, per_cu = 0;
        if (hipGetDevice(&dev) != hipSuccess || hipDeviceGetAttribute(&cus, hipDeviceAttributeMultiprocessorCount, dev) != hipSuccess) { grid = -1; return; }
        if (hipFuncSetAttribute((const void*)hybrid_fwd, hipFuncAttributeMaxDynamicSharedMemorySize, LDS_BYTES) != hipSuccess) { fprintf(stderr, "kernel_launch: hipFuncSetAttribute failed\n"); grid = -1; return; }
        if (hipOccupancyMaxActiveBlocksPerMultiprocessor(&per_cu, (const void*)hybrid_fwd, NWAVES * 64, LDS_BYTES) != hipSuccess || per_cu < 1) { fprintf(stderr, "kernel_launch: occupancy query says %d\n", per_cu); }
        (void)hipGetLastError();
        grid = cus;
    }
    if (grid < 0) return;
    if (hipMemsetAsync((char*)d_ws + WS_CTL, 0, CTL_ZERO_BYTES, stream) != hipSuccess) return;
    Args a{};
    for (int i = 0; i < 21; ++i) a.in[i] = (const float*)d_in[i];
    a.out = (float*)d_out; a.ws = (unsigned char*)d_ws; a.pad = 0;
#if MK_ONE_LAUNCH
    a.ph_lo = 0; a.ph_hi = N_PHASES; a.li = 0;
    hipLaunchKernelGGL(hybrid_fwd, dim3(grid), dim3(NWAVES * 64), LDS_BYTES, stream, a);
#else
    for (int p = 0; p < N_PHASES; ++p) {
        if (p == 8 || p == 4 || p == 15) continue;
        a.ph_lo = p; a.ph_hi = p + 1; a.li = 0; a.pad = 0;
        if (p == PROBE_PHASE) { if (p == 10 || p == 17 || p == 18 || p == 22) { a.pad = 3; hipLaunchKernelGGL(hybrid_fwd, dim3(grid), dim3(NWAVES * 64), LDS_BYTES, stream, a); a.pad = 0; }
                                else hipLaunchKernelGGL(hybrid_fwd, dim3(grid), dim3(NWAVES * 64), LDS_BYTES, stream, a); }
        hipLaunchKernelGGL(hybrid_fwd, dim3(grid), dim3(NWAVES * 64), LDS_BYTES, stream, a);
    }
#endif
}
```

```cpp
#include <hip/hip_runtime.h>
#include <cstdio>
#include <cstdint>

#ifndef MK_ONE_LAUNCH
#define MK_ONE_LAUNCH 1
#endif
#ifndef PROBE_PHASE
#define PROBE_PHASE -1
#endif
#ifndef PROF_PHASE
#define PROF_PHASE -1
#endif
#define PROF_MARK(k) do { if (PROF_PHASE >= 0 && blockIdx.x == 0 && threadIdx.x == 0) { const unsigned long long now_ = __builtin_amdgcn_s_memrealtime(); \
        volatile LAS unsigned* pm_ = F.MISC + 16; const unsigned long long prev_ = ((unsigned long long)pm_[1] << 32) | pm_[0]; \
        if ((k) == PROF_PHASE) { const unsigned long long d_ = now_ - prev_; pm_[2] = (unsigned)d_; pm_[3] = (unsigned)(d_ >> 32); } \
        pm_[0] = (unsigned)now_; pm_[1] = (unsigned)(now_ >> 32); } } while (0)
#ifndef CONV_WGS
#define CONV_WGS 128
#endif
#ifndef PROF_MULT
#define PROF_MULT 32
#endif
#ifndef DUPMASK
#define DUPMASK 0
#endif
#define DUP(k, call) do { call; if ((DUPMASK >> (k)) & 1) { call; } } while (0)

namespace pg8 {
#define PG8_LAS __attribute__((address_space(3)))
typedef unsigned short bf16_t;
typedef short bf16x8 __attribute__((ext_vector_type(8)));
typedef float f32x4 __attribute__((ext_vector_type(4)));
typedef float f32x2 __attribute__((ext_vector_type(2)));
typedef unsigned u32x4 __attribute__((ext_vector_type(4)));
typedef unsigned u32x2 __attribute__((ext_vector_type(2)));
typedef __bf16 bfx2_t __attribute__((ext_vector_type(2)));
typedef int i32x8 __attribute__((ext_vector_type(8)));
typedef int i32x4v __attribute__((ext_vector_type(4)));
constexpr int BM = 256, BK = 64, HALF = 128, HTB = HALF * BK * 2, STAGE_BYTES = 8 * HTB, NXCD = 8, WGM = 8;

__host__ __device__ __forceinline__ int lds_byte(int r, int c) { const int st = (r >> 4) * 2 + (c >> 5), rr = r & 15, cc = c & 31, ob = rr * 64 + cc * 2; return st * 1024 + (ob ^ (((ob >> 9) & 1) << 5)); }
__host__ __device__ __forceinline__ void stage_rc(int b, int& R, int& C) { const int st = b / 1024, sb = b % 1024, swz = sb ^ (((sb >> 9) & 1) << 5); R = (st >> 1) * 16 + swz / 64; C = (st & 1) * 32 + (swz % 64) / 2; }
__host__ __device__ __forceinline__ int perm32(int rho) { const int n = rho >> 4, i = rho & 15; return 8 * (i >> 2) + 4 * n + (i & 3); }

__device__ __forceinline__ unsigned pk2(float lo, float hi) { f32x2 v = {lo, hi}; return __builtin_bit_cast(unsigned, __builtin_convertvector(v, bfx2_t)); }
__device__ __forceinline__ float bflo(unsigned w) { return __builtin_bit_cast(float, w << 16); }
__device__ __forceinline__ float bfhi(unsigned w) { return __builtin_bit_cast(float, w & 0xffff0000u); }
__device__ __forceinline__ float fsigmoid(float x) { return __builtin_amdgcn_rcpf(1.0f + __expf(-x)); }

__device__ __forceinline__ unsigned pk4_fp8(float a, float b, float c, float d) { unsigned w = 0; w = __builtin_amdgcn_cvt_pk_fp8_f32(a, b, w, false); w = __builtin_amdgcn_cvt_pk_fp8_f32(c, d, w, true); return w; }
struct Unit { int pm, pn, pnb, kb, nt, ks; };
struct Gemm { const bf16_t* A; const bf16_t* Bt; int M, N, K; };

struct StaticOrder {
    static constexpr bool KSPLIT = false;
    int nM, nN, nwg, G, c;
    __host__ __device__ void init(int M, int N, int G_, int c_) { nM = M / BM; nN = N / BM; nwg = nM * nN; G = G_; c = c_; }
    __host__ __device__ bool next(int i, Unit& u) const {
        const long L = (long)i * G + c; if (L >= nwg) return false;
        int wgid = (int)L; { const int q = nwg / NXCD, r = nwg % NXCD, xcd = wgid % NXCD, off = wgid / NXCD; wgid = (xcd < r ? xcd * (q + 1) : r * (q + 1) + (xcd - r) * q) + off; }
        const int nig = WGM * nN, gid = wgid / nig, fm = gid * WGM, gsz = (nM - fm) < WGM ? (nM - fm) : WGM;
        u.pm = fm + ((wgid % nig) % gsz); u.pn = (wgid % nig) / gsz; u.pnb = u.pn; return true;
    }
    __device__ __forceinline__ void a_ready(const Unit&) const {}
    __device__ __forceinline__ void done(const Unit&) const {}
};
template <int SPB, bool KSPLIT_ = false> struct MoeOrder {
    static constexpr bool KSPLIT = KSPLIT_;
    int ntf = 0, kq = 0;
    int G, c, nN; const PG8_LAS int* tab;
    __device__ __forceinline__ void init(const unsigned* cnt, int nN_, int G_, int c_, PG8_LAS int* tab_) {
        G = G_; c = c_; nN = nN_; tab = tab_;
        if (threadIdx.x == 0) { int us = 0, bs = 0, nbt = 0; tab_[0] = 0; tab_[16] = 0;
            if constexpr (KSPLIT) { int nblk = 0; for (int e = 0; e < 8; ++e) nblk += (int)((cnt[e] + 255u) >> 8);
                const int total = nblk * nN_, tail = total - (total / G_) * G_, nb7 = (int)((cnt[7] + 255u) >> 8);
                if (tail > 0 && tail % nN_ == 0 && 4 * tail <= G_ && nb7 >= tail / nN_) nbt = tail / nN_; }
            for (int e = 0; e < 8; ++e) { int nb = (int)((cnt[e] + 255u) >> 8); if (e == 7) nb -= nbt; bs += nb; us += nb * nN_; tab_[e + 1] = us; tab_[17 + e] = bs; }
            tab_[9] = nbt; }
        __syncthreads();
    }
    __device__ __forceinline__ bool next(int i, Unit& u) const {
        const int L = i * G + c, total = tab[8], q = L - total;
        bool tl = false;
        if constexpr (KSPLIT) tl = q >= 0 && q < 4 * tab[9] * nN;
        if (L >= total && !tl) return false;
        int e = 0;
#pragma unroll
        for (int k = 1; k < 8; ++k) e += (L >= tab[k]) ? 1 : 0;
        const int us = tab[e], bs = tab[16 + e], nbe0 = tab[17 + e] - bs, nbe = nbe0 > 0 ? nbe0 : 1;
        const int r = L - us, pnr = r / nbe, blk = r - pnr * nbe, u4 = q >> 2, tb = u4 / nN, pnt = u4 - tb * nN, pn = tl ? pnt : pnr;
        u.pm = __builtin_amdgcn_readfirstlane(tl ? tab[24] + tb : (SPB > 0 ? e * SPB + blk : bs + blk)); u.pn = __builtin_amdgcn_readfirstlane(pn); u.pnb = __builtin_amdgcn_readfirstlane(e * nN + pn);
        if constexpr (KSPLIT) { u.ks = __builtin_amdgcn_readfirstlane(tl ? q : -1); u.kb = __builtin_amdgcn_readfirstlane(tl ? (q & 3) * kq : 0); u.nt = __builtin_amdgcn_readfirstlane(tl ? ntf / 4 : ntf); }
        return true;
    }
    __device__ __forceinline__ void a_ready(const Unit&) const {}
    __device__ __forceinline__ void done(const Unit&) const {}
};

struct EpiStoreBf16 {
    static constexpr bool PERM = true, AFTER_DRAIN = false;
    bf16_t* O; int ldc;
    __device__ __forceinline__ void operator()(const f32x4 (&acc)[2][2][4][2], const Unit& u, int wr, int wc, int fr, int fq) const {
        const int row0 = u.pm * BM + wr * 64 + fr, col0 = u.pn * BM + wc * 32 + 8 * fq;
#pragma unroll
        for (int ai = 0; ai < 2; ++ai)
#pragma unroll
            for (int m = 0; m < 4; ++m) { bf16_t* rowp = O + (size_t)(row0 + ai * HALF + m * 16) * ldc + col0;
#pragma unroll
                for (int bj = 0; bj < 2; ++bj) { const f32x4 v0 = acc[ai][bj][m][0], v1 = acc[ai][bj][m][1];
                    u32x4 w; w.x = pk2(v0[0], v0[1]); w.y = pk2(v0[2], v0[3]); w.z = pk2(v1[0], v1[1]); w.w = pk2(v1[2], v1[3]);
                    *(u32x4*)(rowp + bj * HALF) = w; } }
    }
};
struct EpiDownSplit {
    static constexpr bool PERM = true, AFTER_DRAIN = false;
    bf16_t* O; int ldc; float* P;
    __device__ __forceinline__ void operator()(const f32x4 (&acc)[2][2][4][2], const Unit& u, int wr, int wc, int fr, int fq) const {
        if (u.ks < 0) {
            const int row0 = u.pm * BM + wr * 64 + fr, col0 = u.pn * BM + wc * 32 + 8 * fq;
#pragma unroll
            for (int ai = 0; ai < 2; ++ai)
#pragma unroll
                for (int m = 0; m < 4; ++m) { bf16_t* rowp = O + (size_t)(row0 + ai * HALF + m * 16) * ldc + col0;
#pragma unroll
                    for (int bj = 0; bj < 2; ++bj) { const f32x4 v0 = acc[ai][bj][m][0], v1 = acc[ai][bj][m][1];
                        u32x4 w; w.x = pk2(v0[0], v0[1]); w.y = pk2(v0[2], v0[3]); w.z = pk2(v1[0], v1[1]); w.w = pk2(v1[2], v1[3]);
                        *(u32x4*)(rowp + bj * HALF) = w; } }
        } else {
            float* base = P + (size_t)u.ks * (BM * BM) + (wr * 64 + fr) * BM + wc * 32 + 8 * fq;
#pragma unroll
            for (int ai = 0; ai < 2; ++ai)
#pragma unroll
                for (int m = 0; m < 4; ++m) { float* rowp = base + (ai * HALF + m * 16) * BM;
#pragma unroll
                    for (int bj = 0; bj < 2; ++bj) { *(f32x4*)(rowp + bj * HALF) = acc[ai][bj][m][0]; *(f32x4*)(rowp + bj * HALF + 4) = acc[ai][bj][m][1]; } }
        }
    }
};
struct EpiStoreBf16I8 {
    static constexpr bool PERM = true, AFTER_DRAIN = false;
    bf16_t* O; int ldc; const float* rs; const float* cs;
    __device__ __forceinline__ void operator()(const f32x4 (&acc)[2][2][4][2], const Unit& u, int wr, int wc, int fr, int fq) const {
        const int row0 = u.pm * BM + wr * 64 + fr, col0 = u.pn * BM + wc * 32 + 8 * fq;
        f32x4 cv[2][2];
#pragma unroll
        for (int bj = 0; bj < 2; ++bj)
#pragma unroll
            for (int n = 0; n < 2; ++n) cv[bj][n] = *(const f32x4*)(cs + col0 + bj * HALF + 4 * n);
        float rsv[2][4];
#pragma unroll
        for (int ai = 0; ai < 2; ++ai)
#pragma unroll
            for (int m = 0; m < 4; ++m) rsv[ai][m] = rs[row0 + ai * HALF + m * 16];
#pragma unroll
        for (int ai = 0; ai < 2; ++ai)
#pragma unroll
            for (int m = 0; m < 4; ++m) { const int row = row0 + ai * HALF + m * 16; const float r = rsv[ai][m]; bf16_t* rowp = O + (size_t)row * ldc + col0;
#pragma unroll
                for (int bj = 0; bj < 2; ++bj) { const i32x4v a0 = __builtin_bit_cast(i32x4v, acc[ai][bj][m][0]), a1 = __builtin_bit_cast(i32x4v, acc[ai][bj][m][1]);
                    const f32x4 v0 = __builtin_convertvector(a0, f32x4) * cv[bj][0] * r, v1 = __builtin_convertvector(a1, f32x4) * cv[bj][1] * r;
                    u32x4 w; w.x = pk2(v0[0], v0[1]); w.y = pk2(v0[2], v0[3]); w.z = pk2(v1[0], v1[1]); w.w = pk2(v1[2], v1[3]);
                    *(u32x4*)(rowp + bj * HALF) = w; } }
    }
};
struct EpiSwiGLUF8 {
    static constexpr bool PERM = true, AFTER_DRAIN = false;
    unsigned char* Hd; int ldc; float osc; const PG8_LAS int* tab;
    __device__ __forceinline__ void operator()(const f32x4 (&acc)[2][2][4][2], const Unit& u, int wr, int wc, int fr, int fq) const {
        const int row0 = (tab[16 + (u.pm >> 6)] + (u.pm & 63)) * BM + wr * 64 + fr, col0 = u.pn * HALF + wc * 32 + 8 * fq;
#pragma unroll
        for (int ai = 0; ai < 2; ++ai)
#pragma unroll
            for (int m = 0; m < 4; ++m) { unsigned char* rowp = Hd + (size_t)(row0 + ai * HALF + m * 16) * ldc + col0;
                float o[8];
#pragma unroll
                for (int n = 0; n < 2; ++n)
#pragma unroll
                    for (int i = 0; i < 4; ++i) { const float g = acc[ai][0][m][n][i], up = acc[ai][1][m][n][i]; o[4 * n + i] = g * up * fsigmoid(g) * osc; }
                u32x2 w; w.x = pk4_fp8(o[0], o[1], o[2], o[3]); w.y = pk4_fp8(o[4], o[5], o[6], o[7]);
                *(u32x2*)rowp = w; }
    }
};
template <bool OUTF8> struct EpiSwiGLUI8 {
    static constexpr bool PERM = true, AFTER_DRAIN = false;
    void* Hd; int ldc; const float* rs; const float* cs; float osc;
    __device__ __forceinline__ void operator()(const f32x4 (&acc)[2][2][4][2], const Unit& u, int wr, int wc, int fr, int fq) const {
        const int row0 = u.pm * BM + wr * 64 + fr, col0 = u.pn * HALF + wc * 32 + 8 * fq, ccol = u.pnb * BM + wc * 32 + 8 * fq;
        f32x4 cv[2][2]; float rsv[2][4];
#pragma unroll
        for (int bj = 0; bj < 2; ++bj)
#pragma unroll
            for (int n = 0; n < 2; ++n) cv[bj][n] = *(const f32x4*)(cs + ccol + bj * HALF + 4 * n);
#pragma unroll
        for (int ai = 0; ai < 2; ++ai)
#pragma unroll
            for (int m = 0; m < 4; ++m) rsv[ai][m] = rs[row0 + ai * HALF + m * 16];
#pragma unroll
        for (int ai = 0; ai < 2; ++ai)
#pragma unroll
            for (int m = 0; m < 4; ++m) { const int row = row0 + ai * HALF + m * 16; const float r = rsv[ai][m];
                float o[8];
#pragma unroll
                for (int n = 0; n < 2; ++n) { const f32x4 gv = __builtin_convertvector(__builtin_bit_cast(i32x4v, acc[ai][0][m][n]), f32x4) * cv[0][n] * r, uv = __builtin_convertvector(__builtin_bit_cast(i32x4v, acc[ai][1][m][n]), f32x4) * cv[1][n] * r;
#pragma unroll
                    for (int i = 0; i < 4; ++i) o[4 * n + i] = gv[i] * uv[i] * fsigmoid(gv[i]); }
                if constexpr (OUTF8) { u32x2 w; w.x = pk4_fp8(o[0] * osc, o[1] * osc, o[2] * osc, o[3] * osc); w.y = pk4_fp8(o[4] * osc, o[5] * osc, o[6] * osc, o[7] * osc);
                    *(u32x2*)((unsigned char*)Hd + (size_t)row * ldc + col0) = w; }
                else { u32x4 w; w.x = pk2(o[0], o[1]); w.y = pk2(o[2], o[3]); w.z = pk2(o[4], o[5]); w.w = pk2(o[6], o[7]); *(u32x4*)((bf16_t*)Hd + (size_t)row * ldc + col0) = w; } }
    }
};
struct EpiResF32 {
    static constexpr bool PERM = false, AFTER_DRAIN = false;
    const float* base; float* out; int ldc;
    __device__ __forceinline__ void operator()(const f32x4 (&acc)[2][2][4][2], const Unit& u, int wr, int wc, int fr, int fq) const {
        const int row0 = u.pm * BM + wr * 64 + fr, col0 = u.pn * BM + wc * 32 + 4 * fq;
#pragma unroll
        for (int ai = 0; ai < 2; ++ai) {
            f32x4 b[4][2][2];
#pragma unroll
            for (int m = 0; m < 4; ++m) { const size_t off = (size_t)(row0 + ai * HALF + m * 16) * ldc + col0;
#pragma unroll
                for (int bj = 0; bj < 2; ++bj)
#pragma unroll
                    for (int n = 0; n < 2; ++n) b[m][bj][n] = *(const f32x4*)(base + off + bj * HALF + n * 16); }
            asm volatile("" ::: "memory");
#pragma unroll
            for (int m = 0; m < 4; ++m) { const size_t off = (size_t)(row0 + ai * HALF + m * 16) * ldc + col0;
#pragma unroll
                for (int bj = 0; bj < 2; ++bj)
#pragma unroll
                    for (int n = 0; n < 2; ++n) *(f32x4*)(out + off + bj * HALF + n * 16) = b[m][bj][n] + acc[ai][bj][m][n]; }
            asm volatile("" ::: "memory");
        }
    }
};
struct EpiGateA {
    static constexpr bool PERM = true, AFTER_DRAIN = false;
    bf16_t* Y; int ldc; const bf16_t* gate; int ldg;
    __device__ __forceinline__ void operator()(const f32x4 (&acc)[2][2][4][2], const Unit& u, int wr, int wc, int fr, int fq) const {
        const int row0 = u.pm * BM + wr * 64 + fr, col0 = u.pn * BM + wc * 32 + 8 * fq;
        u32x4 gws[2][4][2];
#pragma unroll
        for (int ai = 0; ai < 2; ++ai)
#pragma unroll
            for (int m = 0; m < 4; ++m)
#pragma unroll
                for (int bj = 0; bj < 2; ++bj) gws[ai][m][bj] = *(const u32x4*)(gate + (size_t)(row0 + ai * HALF + m * 16) * ldg + col0 + bj * HALF);
        asm volatile("" ::: "memory");
#pragma unroll
        for (int ai = 0; ai < 2; ++ai)
#pragma unroll
            for (int m = 0; m < 4; ++m) { const int row = row0 + ai * HALF + m * 16;
#pragma unroll
                for (int bj = 0; bj < 2; ++bj) { const u32x4 gw = gws[ai][m][bj];
                    const f32x4 v0 = acc[ai][bj][m][0], v1 = acc[ai][bj][m][1];
                    u32x4 w;
                    w.x = pk2(v0[0] * fsigmoid(bflo(gw.x)), v0[1] * fsigmoid(bfhi(gw.x))); w.y = pk2(v0[2] * fsigmoid(bflo(gw.y)), v0[3] * fsigmoid(bfhi(gw.y)));
                    w.z = pk2(v1[0] * fsigmoid(bflo(gw.z)), v1[1] * fsigmoid(bfhi(gw.z))); w.w = pk2(v1[2] * fsigmoid(bflo(gw.w)), v1[3] * fsigmoid(bfhi(gw.w)));
                    *(u32x4*)(Y + (size_t)row * ldc + col0 + bj * HALF) = w; } }
    }
};
struct EpiGateB {
    static constexpr bool PERM = true, AFTER_DRAIN = false;
    bf16_t* Y; int ldc; const bf16_t* gate; int ldg;
    __device__ __forceinline__ void operator()(const f32x4 (&acc)[2][2][4][2], const Unit& u, int wr, int wc, int fr, int fq) const {
        const int row0 = u.pm * BM + wr * 64 + fr, col0 = u.pn * BM + wc * 32 + 8 * fq;
#pragma unroll
        for (int ai = 0; ai < 2; ++ai) {
            u32x4 gws[4][2], pp[4][2];
#pragma unroll
            for (int m = 0; m < 4; ++m)
#pragma unroll
                for (int bj = 0; bj < 2; ++bj) { const int row = row0 + ai * HALF + m * 16; gws[m][bj] = *(const u32x4*)(gate + (size_t)row * ldg + col0 + bj * HALF); pp[m][bj] = *(const u32x4*)(Y + (size_t)row * ldc + col0 + bj * HALF); }
            asm volatile("" ::: "memory");
#pragma unroll
            for (int m = 0; m < 4; ++m) { const int row = row0 + ai * HALF + m * 16;
#pragma unroll
                for (int bj = 0; bj < 2; ++bj) { const u32x4 gw = gws[m][bj], p = pp[m][bj];
                    const f32x4 v0 = acc[ai][bj][m][0], v1 = acc[ai][bj][m][1];
                    u32x4 w;
                    w.x = pk2(bflo(p.x) + v0[0] * fsigmoid(bflo(gw.x)), bfhi(p.x) + v0[1] * fsigmoid(bfhi(gw.x))); w.y = pk2(bflo(p.y) + v0[2] * fsigmoid(bflo(gw.y)), bfhi(p.y) + v0[3] * fsigmoid(bfhi(gw.y)));
                    w.z = pk2(bflo(p.z) + v1[0] * fsigmoid(bflo(gw.z)), bfhi(p.z) + v1[1] * fsigmoid(bfhi(gw.z))); w.w = pk2(bflo(p.w) + v1[2] * fsigmoid(bflo(gw.w)), bfhi(p.w) + v1[3] * fsigmoid(bfhi(gw.w)));
                    *(u32x4*)(Y + (size_t)row * ldc + col0 + bj * HALF) = w; } }
            asm volatile("" ::: "memory");
        }
    }
};

template <class Epi, class Sched, bool ALIGN_EPI = false, bool SP2 = false, int MODE = 0  >
__device__ __forceinline__ void gemm_phase(PG8_LAS unsigned char* lds, const Gemm g, const Sched& S, const Epi& E, const int sw = 0x7f7f7f7f, const int sa = 0x7f7f7f7f) {
    constexpr bool F8 = (MODE == 1);
    const int tid = threadIdx.x, wid = __builtin_amdgcn_readfirstlane(tid >> 6), lane = tid & 63, wr = wid >> 2, wc = wid & 3, fr = lane & 15, fq = lane >> 4;
    const int K = g.K, nt = K / BK;
    unsigned voffA, voffB;
    { int R, C; stage_rc(tid * 16, R, C); const int Rb = Epi::PERM ? ((R & ~31) + perm32(R & 31)) : R;
      voffA = (unsigned)(R * K + C) * 2u; voffB = (unsigned)(Rb * K + C) * 2u; }
    const unsigned rstep = 64u * (unsigned)K * 2u;
    const unsigned kstep = (unsigned)(BK * 2);
    const unsigned hstep = (unsigned)HALF * (unsigned)K * 2u;
    const unsigned tstep = 2u * hstep;
    const __amdgpu_buffer_rsrc_t rsA = __builtin_amdgcn_make_buffer_rsrc((void*)g.A, 0, 0xFFFFFFFF, 0x00020000), rsB = __builtin_amdgcn_make_buffer_rsrc((void*)g.Bt, 0, 0xFFFFFFFF, 0x00020000);
    const unsigned ldsw = (unsigned)wid * 1024u;
    const int aoff = lds_byte(wr * 64 + fr, fq * 8), boff = lds_byte(wc * 32 + fr, fq * 8);
#define PG8_SA(b, h) (((b) * 2 + (h)) * HTB)
#define PG8_SB(b, h) ((4 + (b) * 2 + (h)) * HTB)
#define PG8_STAGE(bufoff, rs, soff, voff) do { _Pragma("unroll") for (int _i = 0; _i < 2; ++_i) \
        __builtin_amdgcn_raw_ptr_buffer_load_lds(rs, (PG8_LAS void*)(lds + (bufoff) + ldsw + _i * 8192), 16, (int)(voff), (int)((soff) + _i * rstep), 0, 0); } while (0)
#define PG8_LD8(p_) __builtin_shufflevector(*(const PG8_LAS i32x4v*)(p_), *(const PG8_LAS i32x4v*)((p_) + 1024), 0, 1, 2, 3, 4, 5, 6, 7)
#define PG8_LDA(dst, b, h) do { _Pragma("unroll") for (int m = 0; m < 4; ++m) { if constexpr (F8) dst##8[m] = PG8_LD8(lds + PG8_SA(b, h) + aoff + m * 2048); \
        else { _Pragma("unroll") for (int k = 0; k < 2; ++k) dst[m][k] = *(const PG8_LAS bf16x8*)(lds + PG8_SA(b, h) + aoff + m * 2048 + k * 1024); } } } while (0)
#define PG8_LDB(dst, b, h) do { _Pragma("unroll") for (int n = 0; n < 2; ++n) { if constexpr (F8) dst##8[n] = PG8_LD8(lds + PG8_SB(b, h) + boff + n * 2048); \
        else { _Pragma("unroll") for (int k = 0; k < 2; ++k) dst[n][k] = *(const PG8_LAS bf16x8*)(lds + PG8_SB(b, h) + boff + n * 2048 + k * 1024); } } } while (0)
#define PG8_CAT(x0, x1) __builtin_shufflevector(__builtin_bit_cast(i32x4v, x0), __builtin_bit_cast(i32x4v, x1), 0, 1, 2, 3, 4, 5, 6, 7)
#define PG8_MMA(ai, bj, At, Bt) do { __builtin_amdgcn_s_setprio(1); _Pragma("unroll") for (int m = 0; m < 4; ++m) _Pragma("unroll") for (int n = 0; n < 2; ++n) { \
        if constexpr (F8) acc[ai][bj][m][n] = __builtin_amdgcn_mfma_scale_f32_16x16x128_f8f6f4(Bt##8[n], At##8[m], acc[ai][bj][m][n], 0, 0, 0, sw, 0, sa); \
        else if constexpr (MODE == 2) { _Pragma("unroll") for (int k = 0; k < 2; ++k) acc[ai][bj][m][n] = __builtin_bit_cast(f32x4, __builtin_amdgcn_mfma_i32_16x16x64_i8(__builtin_bit_cast(i32x4v, Bt[n][k]), __builtin_bit_cast(i32x4v, At[m][k]), __builtin_bit_cast(i32x4v, acc[ai][bj][m][n]), 0, 0, 0)); } \
        else { _Pragma("unroll") for (int k = 0; k < 2; ++k) acc[ai][bj][m][n] = __builtin_amdgcn_mfma_f32_16x16x32_bf16(Bt[n][k], At[m][k], acc[ai][bj][m][n], 0, 0, 0); } } \
        __builtin_amdgcn_s_setprio(0); } while (0)
#define PG8_WAIT_V(n) asm volatile("s_waitcnt vmcnt(" #n ")" ::: "memory")
#define PG8_WAIT_L(n) asm volatile("s_waitcnt lgkmcnt(" #n ")" ::: "memory")
#define PG8_BAR __builtin_amdgcn_s_barrier()
#define PG8_SCHED __builtin_amdgcn_sched_barrier(0)
    Unit cur, nxt; int ui = 0;
    if (!S.next(0, cur)) return;
    f32x4 acc[2][2][4][2];
#pragma unroll
    for (int a = 0; a < 2; ++a)
#pragma unroll
        for (int b = 0; b < 2; ++b)
#pragma unroll
            for (int m = 0; m < 4; ++m)
#pragma unroll
                for (int n = 0; n < 2; ++n) acc[a][b][m][n] = (f32x4){0.f, 0.f, 0.f, 0.f};
    bf16x8 At[4][2], B0[2][2], B1[2][2]; i32x8 At8[4], B08[2], B18[2];
    unsigned cA = (unsigned)cur.pm * tstep, cB = (unsigned)cur.pnb * tstep; int ntc = nt;
    if constexpr (Sched::KSPLIT) { cA += (unsigned)cur.kb; cB += (unsigned)cur.kb; ntc = cur.nt; }
    S.a_ready(cur);
    if constexpr (SP2) {
        PG8_STAGE(PG8_SB(0, 0), rsB, cB, voffB); PG8_STAGE(PG8_SB(0, 1), rsB, cB + hstep, voffB); PG8_STAGE(PG8_SA(0, 0), rsA, cA, voffA); PG8_STAGE(PG8_SA(0, 1), rsA, cA + hstep, voffA);
        if (wr == 1) PG8_BAR;
        PG8_WAIT_V(2); PG8_BAR;
        PG8_STAGE(PG8_SB(1, 0), rsB, cB + kstep, voffB); PG8_STAGE(PG8_SA(1, 0), rsA, cA + kstep, voffA); PG8_STAGE(PG8_SB(1, 1), rsB, cB + hstep + kstep, voffB);
        PG8_WAIT_V(6); PG8_BAR;
    } else {
        PG8_STAGE(PG8_SB(0, 0), rsB, cB, voffB); PG8_STAGE(PG8_SA(0, 0), rsA, cA, voffA); PG8_STAGE(PG8_SB(0, 1), rsB, cB + hstep, voffB); PG8_STAGE(PG8_SA(0, 1), rsA, cA + hstep, voffA);
        if (wr == 1) PG8_BAR;
        PG8_WAIT_V(4); PG8_BAR;
        PG8_STAGE(PG8_SB(1, 0), rsB, cB + kstep, voffB); PG8_STAGE(PG8_SA(1, 0), rsA, cA + kstep, voffA); PG8_STAGE(PG8_SB(1, 1), rsB, cB + hstep + kstep, voffB);
        PG8_WAIT_V(6); PG8_BAR;
    }
    for (;;) {
        const bool has_next = S.next(ui + 1, nxt);
        unsigned nA = has_next ? (unsigned)nxt.pm * tstep : cA, nB = has_next ? (unsigned)nxt.pnb * tstep : cB;
        if constexpr (Sched::KSPLIT) { if (has_next) { nA += (unsigned)nxt.kb; nB += (unsigned)nxt.kb; } }
        for (int t = 0; t < ntc; t += 2) {
            const bool last = (t == ntc - 2);
            const unsigned a1 = cA + (unsigned)(t + 1) * kstep;
            const unsigned a2 = last ? nA : cA + (unsigned)(t + 2) * kstep, b2 = last ? nB : cB + (unsigned)(t + 2) * kstep;
            const unsigned a3 = a2 + kstep, b3 = b2 + kstep;
            if (last && has_next) S.a_ready(nxt);
            if constexpr (SP2) {
            PG8_LDB(B0, 0, 0); PG8_LDB(B1, 0, 1); PG8_SCHED; PG8_LDA(At, 0, 0); PG8_STAGE(PG8_SA(1, 1), rsA, a1 + hstep, voffA);
            PG8_WAIT_V(8); PG8_WAIT_L(0); PG8_BAR; PG8_MMA(0, 0, At, B0); PG8_MMA(0, 1, At, B1); PG8_BAR; PG8_SCHED;
            PG8_LDA(At, 0, 1); PG8_STAGE(PG8_SB(0, 0), rsB, b2, voffB); PG8_STAGE(PG8_SB(0, 1), rsB, b2 + hstep, voffB); PG8_STAGE(PG8_SA(0, 0), rsA, a2, voffA);
            PG8_WAIT_V(8); PG8_WAIT_L(0); PG8_BAR; PG8_MMA(1, 0, At, B0); PG8_MMA(1, 1, At, B1); PG8_BAR; PG8_SCHED;
            PG8_LDB(B0, 1, 0); PG8_LDB(B1, 1, 1); PG8_SCHED; PG8_LDA(At, 1, 0); PG8_STAGE(PG8_SA(0, 1), rsA, a2 + hstep, voffA);
            PG8_WAIT_V(8); PG8_WAIT_L(0); PG8_BAR; PG8_MMA(0, 0, At, B0); PG8_MMA(0, 1, At, B1); PG8_BAR; PG8_SCHED;
            PG8_LDA(At, 1, 1); PG8_STAGE(PG8_SB(1, 0), rsB, b3, voffB); PG8_STAGE(PG8_SB(1, 1), rsB, b3 + hstep, voffB); PG8_STAGE(PG8_SA(1, 0), rsA, a3, voffA);
            PG8_WAIT_V(8); PG8_WAIT_L(0); PG8_BAR; PG8_MMA(1, 0, At, B0); PG8_MMA(1, 1, At, B1); PG8_BAR; PG8_SCHED;
            } else {
            PG8_LDB(B0, 0, 0); PG8_SCHED; PG8_LDA(At, 0, 0); PG8_STAGE(PG8_SA(1, 1), rsA, a1 + hstep, voffA);
            PG8_WAIT_L(8); PG8_BAR; PG8_WAIT_L(0); PG8_MMA(0, 0, At, B0); PG8_BAR; PG8_SCHED;
            PG8_LDB(B1, 0, 1); PG8_STAGE(PG8_SB(0, 0), rsB, b2, voffB);
            PG8_BAR; PG8_WAIT_L(0); PG8_MMA(0, 1, At, B1); PG8_BAR;
            PG8_LDA(At, 0, 1); PG8_STAGE(PG8_SA(0, 0), rsA, a2, voffA);
            PG8_BAR; PG8_WAIT_L(0); PG8_MMA(1, 0, At, B0); PG8_BAR; PG8_SCHED;
            PG8_STAGE(PG8_SB(0, 1), rsB, b2 + hstep, voffB);
            PG8_WAIT_V(6); PG8_BAR; PG8_MMA(1, 1, At, B1); PG8_BAR;
            PG8_LDB(B0, 1, 0); PG8_SCHED; PG8_LDA(At, 1, 0); PG8_STAGE(PG8_SA(0, 1), rsA, a2 + hstep, voffA);
            PG8_WAIT_L(8); PG8_BAR; PG8_WAIT_L(0); PG8_MMA(0, 0, At, B0); PG8_BAR; PG8_SCHED;
            PG8_LDB(B1, 1, 1); PG8_STAGE(PG8_SB(1, 0), rsB, b3, voffB);
            PG8_BAR; PG8_WAIT_L(0); PG8_MMA(0, 1, At, B1); PG8_BAR;
            PG8_LDA(At, 1, 1); PG8_STAGE(PG8_SA(1, 0), rsA, a3, voffA);
            PG8_BAR; PG8_WAIT_L(0); PG8_MMA(1, 0, At, B0); PG8_BAR; PG8_SCHED;
            PG8_STAGE(PG8_SB(1, 1), rsB, b3 + hstep, voffB);
            PG8_WAIT_V(6); PG8_BAR; PG8_MMA(1, 1, At, B1); PG8_BAR;
            }
        }
        if constexpr (ALIGN_EPI) { if (wr == 0) PG8_BAR; }
        if constexpr (!Epi::AFTER_DRAIN) { E(acc, cur, wr, wc, fr, fq); S.done(cur); }
        if (!has_next) break;
#pragma unroll
        for (int a = 0; a < 2; ++a)
#pragma unroll
            for (int b = 0; b < 2; ++b)
#pragma unroll
                for (int m = 0; m < 4; ++m)
#pragma unroll
                    for (int n = 0; n < 2; ++n) acc[a][b][m][n] = (f32x4){0.f, 0.f, 0.f, 0.f};
        cur = nxt; cA = nA; cB = nB; ++ui;
        if constexpr (Sched::KSPLIT) ntc = cur.nt;
        if constexpr (ALIGN_EPI) { if (wr == 1) PG8_BAR; }
    }
    PG8_WAIT_V(0);
    if constexpr (!ALIGN_EPI) { if (wr == 0) PG8_BAR; }
    PG8_BAR;
#undef PG8_SA
#undef PG8_SB
#undef PG8_STAGE
#undef PG8_LDA
#undef PG8_LDB
#undef PG8_MMA
#undef PG8_CAT
#undef PG8_WAIT_V
#undef PG8_WAIT_L
#undef PG8_BAR
#undef PG8_SCHED
}
}

#define PG8_SP2 true
#define PG8_ALIGN true

constexpr int NWAVES = 8;
constexpr int NB = 4, SEQ = 4096, T = NB * SEQ, D = 2048;
constexpr int NPROJ = 13056;
constexpr int CQ = 0, CK = 1024, CV = 2048, CZ = 4096, CSQ = 6144, CSK = 8192, CSV = 8448, CGA = 8704, CGB = 10752, CBETA = 12800, CALPHA = 12816;
constexpr int D_IN = 12832;
constexpr int FFD = 5504, FFD2 = 11008, FFE = 7168, FFE2 = 14336, NE = 8;
constexpr int MOE_ROWS = 2 * T + NE * 256;
constexpr float NORM_EPS = 1e-6f;

constexpr size_t WS_CTL = 0, CTL_ZERO_BYTES = 1u << 20;
constexpr size_t SZ_WIN = (size_t)NPROJ * D * 2, SZ_SQ = (size_t)D * D * 2;
constexpr size_t WS_WIN = CTL_ZERO_BYTES;
constexpr size_t WS_WPG = WS_WIN + 2 * SZ_WIN;
constexpr size_t WS_WPS = WS_WPG + 2 * SZ_SQ;
constexpr size_t WS_WO = WS_WPS + 2 * SZ_SQ;
constexpr size_t WS_WGU = WS_WO + 2 * SZ_SQ;
constexpr size_t WS_WDN = WS_WGU + (size_t)FFD2 * D * 2;
constexpr size_t WS_MGU = WS_WDN + (size_t)D * FFD * 2;
constexpr size_t WS_MDN = WS_MGU + (size_t)NE * FFE2 * D * 2;
constexpr size_t WS_H = WS_MDN + (size_t)NE * D * FFE * 2;
constexpr size_t WS_R1 = WS_H + (size_t)T * D * 2;
constexpr size_t SZ_R1 = (size_t)MOE_ROWS * FFE * 2;
constexpr size_t WS_MIX = WS_R1 + SZ_R1;
constexpr size_t WS_QN = WS_MIX;
constexpr size_t WS_KN = WS_QN + (size_t)T * 1024 * 2;
constexpr size_t WS_V = WS_KN + (size_t)T * 1024 * 2;
constexpr size_t WS_ORAW = WS_V + (size_t)T * 2048 * 2;
constexpr size_t WS_OA = WS_ORAW + (size_t)T * 2048 * 4;
constexpr size_t WS_OB = WS_OA + (size_t)T * 2048 * 2;
constexpr size_t WS_G = WS_OB + (size_t)T * 2048 * 2;
constexpr size_t WS_BETA = WS_G + (size_t)T * 16 * 4;
constexpr size_t WS_MIX_END = WS_BETA + (size_t)T * 16 * 4;
constexpr size_t WS_Y = WS_QN;
constexpr size_t WS_YP = WS_ORAW;
constexpr size_t WS_XG = WS_MIX;
constexpr size_t WS_YG = WS_R1 + ((size_t)256 << 20);
constexpr size_t WS_PT = WS_YG + (size_t)MOE_ROWS * D * 2;
static_assert(WS_PT + (size_t)256 * 65536 * 4 <= WS_R1 + SZ_R1 && (FFE / 128) % 8 == 0, "partial tiles fit R1; a quarter of K is an even number of K-tiles");
constexpr size_t WS_IDX = WS_MIX_END;
constexpr size_t WS_TOPW = WS_IDX + (size_t)NE * T * 4;
constexpr size_t WS_SLOT = WS_TOPW + (size_t)T * 2 * 4;
constexpr size_t WS_QKB = WS_SLOT + (size_t)T * 2 * 4;
constexpr size_t WS_KTB = WS_QKB + (size_t)4096 * 4096 * 2;
constexpr size_t WS_EG = WS_KTB + (size_t)2048 * 8192 * 2;
constexpr size_t WS_EK = WS_EG + (size_t)T * 16 * 4;
constexpr size_t WS_RS = WS_EK + (size_t)T * 16 * 4;
constexpr size_t WS_CS = WS_RS + (size_t)T * 4;
constexpr size_t WS_CSF = WS_CS + (size_t)2 * NPROJ * 4;
constexpr size_t WS_CSM = WS_CSF + (size_t)FFD2 * 4;
constexpr size_t WS_RSF = WS_CSM + (size_t)NE * FFE2 * 4;
constexpr size_t WS_RSX = WS_RSF + (size_t)T * 4;
constexpr size_t WS_END = WS_RSX + (size_t)MOE_ROWS * 4;
constexpr size_t WS_WB = WS_R1 + (size_t)T * NPROJ * 2;
constexpr size_t WS_UTB = WS_ORAW;
static_assert(WS_WB + (size_t)4096 * 8192 * 2 <= WS_R1 + SZ_R1, "W tiles fit behind proj");
static_assert(WS_XG + (size_t)NE * T * D <= WS_MIX_END && (size_t)MOE_ROWS * FFE <= ((size_t)256 << 20) && WS_YG + (size_t)MOE_ROWS * D * 2 <= WS_R1 + SZ_R1 && T / 256 == 64, "moe overlays");
static_assert((size_t)T * NPROJ * 2 <= SZ_R1, "proj fits R1");
constexpr int CW_KS = 1024;
constexpr int CW_CNT = 64;
constexpr int CW_BAR = 4096;

constexpr int RING_OFF = 0, RING_BYTES = 155648;
constexpr int LDSCTL_OFF = RING_BYTES, MISC_OFF = LDSCTL_OFF + 320;
constexpr int LDS_BYTES = 163840;

#define GAS __attribute__((address_space(1)))
#define LAS __attribute__((address_space(3)))
typedef unsigned short bf16;
typedef unsigned v4u __attribute__((ext_vector_type(4)));
typedef unsigned v2u __attribute__((ext_vector_type(2)));
typedef float f32x4 __attribute__((ext_vector_type(4)));
typedef short bf16x8 __attribute__((ext_vector_type(8)));
using pg8::pk2; using pg8::bflo; using pg8::bfhi; using pg8::fsigmoid;
#define LDS_WAIT() asm volatile("s_waitcnt lgkmcnt(0)" ::: "memory")
#define VM_WAIT() asm volatile("s_waitcnt vmcnt(0)" ::: "memory")

#define XB_TMO      128
#define XB_XCNT(j)  (256  + 64 * (j))
#define XB_XSUB(j)  (1280 + 64 * (j))
#define XB_XGEN(j)  (2304 + 64 * (j))
#define XB_TOP      3328
#define XB_TOPGEN   3392
#define XCD_BAR_WORDS 3456
#define XB_SPIN_CAP (1u << 21)

__device__ __forceinline__ unsigned xb_ld(unsigned* p)              { return __hip_atomic_load(p, __ATOMIC_RELAXED, __HIP_MEMORY_SCOPE_AGENT); }
__device__ __forceinline__ unsigned xb_add(unsigned* p, unsigned v) { return __hip_atomic_fetch_add(p, v, __ATOMIC_RELAXED, __HIP_MEMORY_SCOPE_AGENT); }
__device__ __forceinline__ unsigned xb_xcc_id() { return (unsigned)__builtin_amdgcn_s_getreg((3 << 11) | 20) & 0xFu; }
#define XB_SPIN(cond, bar) do { unsigned _sp = 0; while (cond) { __builtin_amdgcn_s_sleep(1); \
    if ((++_sp & 255u) == 0u) { if (xb_ld(&(bar)[XB_TMO])) break; if (_sp > XB_SPIN_CAP) { atomicAdd(&(bar)[XB_TMO], 1u); break; } } } } while (0)

struct XcdBarrier { unsigned* bar; unsigned x; volatile LAS unsigned* st; };

__device__ __forceinline__ XcdBarrier xcd_barrier_post(unsigned* bar, volatile LAS unsigned* st) {
    XcdBarrier b; b.bar = bar; b.x = xb_xcc_id(); b.st = st;
    if (threadIdx.x == 0) (void)xb_add(&bar[XB_XCNT(b.x)], 1u);
    return b;
}
__device__ __forceinline__ void xcd_barrier_complete(unsigned* bar, unsigned x, unsigned& nloc, unsigned& nx) {
    const unsigned G = gridDim.x * gridDim.y * gridDim.z;
    unsigned sum, cnt, mine, sp = 0u;
    for (;;) {
        sum = 0u; cnt = 0u; mine = 0u;
#pragma unroll
        for (unsigned j = 0; j < 16; ++j) { const unsigned c = xb_ld(&bar[XB_XCNT(j)]); sum += c; cnt += (c > 0u) ? 1u : 0u; mine = (j == x) ? c : mine; }
        if (sum == G) break;
        __builtin_amdgcn_s_sleep(1);
        if ((++sp & 255u) == 0u) { if (xb_ld(&bar[XB_TMO])) break; if (sp > XB_SPIN_CAP) { atomicAdd(&bar[XB_TMO], 1u); break; } }
    }
    nloc = mine > 0u ? mine : 1u; nx = cnt > 0u ? cnt : 1u;
}
__device__ __forceinline__ void xcd_barrier(const XcdBarrier& b) {
    asm volatile("s_waitcnt vmcnt(0)" ::: "memory");
    __syncthreads();
    if (threadIdx.x == 0) {
        unsigned* bar = b.bar;
        __builtin_amdgcn_s_waitcnt(0);
        unsigned nloc = b.st[0], nx = b.st[1];
        if (nloc == 0u) { xcd_barrier_complete(bar, b.x, nloc, nx); b.st[0] = nloc; b.st[1] = nx; }
        const unsigned old = xb_add(&bar[XB_XSUB(b.x)], 1u);
        const unsigned gen = old / nloc;
        if (old + 1u == (gen + 1u) * nloc) {
            __builtin_amdgcn_fence(__ATOMIC_RELEASE, "agent");
            asm volatile("s_waitcnt vmcnt(0)" ::: "memory");
            const unsigned og = xb_add(&bar[XB_TOP], 1u);
            const unsigned tg = og / nx;
            if (og + 1u == (tg + 1u) * nx) xb_add(&bar[XB_TOPGEN], 1u);
            else XB_SPIN(xb_ld(&bar[XB_TOPGEN]) == tg, bar);
            __builtin_amdgcn_fence(__ATOMIC_ACQUIRE, "agent");
            xb_add(&bar[XB_XGEN(b.x)], 1u);
            asm volatile("s_waitcnt vmcnt(0)" ::: "memory");
        } else {
            XB_SPIN(xb_ld(&bar[XB_XGEN(b.x)]) == gen, bar);
            __builtin_amdgcn_fence(__ATOMIC_ACQUIRE, "agent");
            asm volatile("s_waitcnt vmcnt(0)" ::: "memory");
        }
    }
    __syncthreads();
}

struct Args {
    const float* in[21]; float* out; unsigned char* ws; int ph_lo, ph_hi, li, pad;
};
struct Frame {
    LAS unsigned char* lds;
    volatile LAS unsigned* MISC;
    unsigned* ctl;
    int tid, lane, wave, vcu, G;
};

template <int CTRL> __device__ __forceinline__ float dpp_f(float x) { return __builtin_bit_cast(float, __builtin_amdgcn_update_dpp(0, __builtin_bit_cast(int, x), CTRL, 0xF, 0xF, false)); }
__device__ __forceinline__ float rl_f(float x, int l) { return __builtin_bit_cast(float, __builtin_amdgcn_readlane(__builtin_bit_cast(int, x), l)); }
__device__ __forceinline__ float wave_sum(float v) {
    v += dpp_f<0xB1>(v); v += dpp_f<0x4E>(v); v += dpp_f<0x141>(v); v += dpp_f<0x140>(v);
    return (rl_f(v, 0) + rl_f(v, 16)) + (rl_f(v, 32) + rl_f(v, 48));
}
__device__ __forceinline__ float wave_max(float v) {
    v = fmaxf(v, dpp_f<0xB1>(v)); v = fmaxf(v, dpp_f<0x4E>(v)); v = fmaxf(v, dpp_f<0x141>(v)); v = fmaxf(v, dpp_f<0x140>(v));
    return fmaxf(fmaxf(rl_f(v, 0), rl_f(v, 16)), fmaxf(rl_f(v, 32), rl_f(v, 48)));
}
__device__ __forceinline__ float reduce16(float x) {
    x += dpp_f<0x128>(x); x += dpp_f<0x124>(x); x += dpp_f<0x122>(x); x += dpp_f<0x121>(x); return x;
}
__device__ __forceinline__ float fsilu(float x) { return x * fsigmoid(x); }

__device__ __forceinline__ void transpose_item(const float* W, int ldw, int k0, int ns0, bf16* WT, int K, int nd0, bool zero, LAS float* scr, int lane) {
    if (!zero) {
#pragma unroll 8
        for (int i = 0; i < 32; ++i) { const int kk = 2 * i + (lane >> 5); scr[kk * 33 + (lane & 31)] = W[(size_t)(k0 + kk) * ldw + ns0 + (lane & 31)]; }
    }
    LDS_WAIT(); asm volatile("" ::: "memory");
    const int c = lane & 7;
#pragma unroll
    for (int j = 0; j < 4; ++j) { const int n = (lane >> 3) + 8 * j; const LAS float* s = scr + (8 * c) * 33 + n;
        v4u o;
        if (zero) { o = (v4u){0u, 0u, 0u, 0u}; }
        else { o.x = pk2(s[0 * 33], s[1 * 33]); o.y = pk2(s[2 * 33], s[3 * 33]); o.z = pk2(s[4 * 33], s[5 * 33]); o.w = pk2(s[6 * 33], s[7 * 33]); }
        *(GAS v4u*)(WT + (size_t)(nd0 + n) * K + k0 + 8 * c) = o; }
    LDS_WAIT(); asm volatile("" ::: "memory");
}
__device__ __forceinline__ void transpose_item_f8(const float* W, int ldw, int k0, int ns0, unsigned char* WT, int K, int nd0, float wsc, LAS float* scr, int lane) {
#pragma unroll 8
    for (int i = 0; i < 32; ++i) { const int kk = 2 * i + (lane >> 5); scr[kk * 33 + (lane & 31)] = __builtin_nontemporal_load(W + (size_t)(k0 + kk) * ldw + ns0 + (lane & 31)); }
    LDS_WAIT(); asm volatile("" ::: "memory");
    const int c = lane & 7;
#pragma unroll
    for (int j = 0; j < 4; ++j) { const int n = (lane >> 3) + 8 * j; const LAS float* s = scr + (8 * c) * 33 + n;
        v2u o; o.x = pg8::pk4_fp8(s[0 * 33] * wsc, s[1 * 33] * wsc, s[2 * 33] * wsc, s[3 * 33] * wsc); o.y = pg8::pk4_fp8(s[4 * 33] * wsc, s[5 * 33] * wsc, s[6 * 33] * wsc, s[7 * 33] * wsc);
        __builtin_nontemporal_store(o, (v2u*)(WT + (size_t)(nd0 + n) * K + k0 + 8 * c)); }
    LDS_WAIT(); asm volatile("" ::: "memory");
}
constexpr float W8_SCALE = 64.f; constexpr int W8_E8M0 = 0x79797979;
constexpr float X8_SCALE = 4.f, H8_SCALE = 4.f; constexpr int X8_E8M0 = 0x7d7d7d7d, H8_E8M0 = 0x7d7d7d7d;
__device__ __forceinline__ void tr_plain_f8(const float* W, int K, int N, unsigned char* WT, int item, LAS float* scr, int lane) {
    const int nblk = N / 32, kb = item / nblk, nb = item % nblk;
    transpose_item_f8(W, N, 64 * kb, 32 * nb, WT, K, 32 * nb, W8_SCALE, scr, lane);
}
__device__ __forceinline__ void tr_gu_f8(const float* Wg, const float* Wu, int K, int F, unsigned char* WT, int item, LAS float* scr, int lane) {
    const int nblk = (2 * F) / 32, kb = item / nblk, nb = item % nblk, nd0 = 32 * nb, pn = nd0 >> 8, j = nd0 & 255;
    const float* W = (j < 128) ? Wg : Wu; const int ns0 = 128 * pn + (j & 127);
    transpose_item_f8(W, F, 64 * kb, ns0, WT, K, nd0, W8_SCALE, scr, lane);
}
__device__ __forceinline__ void tr_plain(const float* W, int K, int N, bf16* WT, int item, LAS float* scr, int lane) {
    const int nblk = N / 32, kb = item / nblk, nb = item % nblk;
    transpose_item(W, N, 64 * kb, 32 * nb, WT, K, 32 * nb, false, scr, lane);
}
__device__ __forceinline__ void w_i8_core(const Frame& F, const float* Wblk  , int ldw, bool zero, unsigned char* WTrow0  , float* CSblk, LAS float* mxs  ) {
    const int lane = F.lane, n = lane & 31, kq = lane >> 5;
    const int k0 = 256 * F.wave + 128 * kq;
    const float* Wc = Wblk + (size_t)k0 * ldw + n;
    float v[128]; float mx = 0.f;
#pragma unroll
    for (int i = 0; i < 128; ++i) { v[i] = zero ? 0.f : Wc[(size_t)i * ldw]; mx = fmaxf(mx, fabsf(v[i])); }
    mxs[(2 * F.wave + kq) * 32 + n] = mx;
    __syncthreads();
    float cm = 0.f;
#pragma unroll
    for (int j = 0; j < 16; ++j) cm = fmaxf(cm, mxs[j * 32 + n]);
    const float iv = cm > 0.f ? 127.f / cm : 0.f;
    if (F.wave == 0 && lane < 32) CSblk[n] = cm * (1.f / 127.f);
    v4u* op = (v4u*)(WTrow0 + (size_t)n * D + k0);
#pragma unroll
    for (int q = 0; q < 8; ++q) { unsigned wd[4];
#pragma unroll
        for (int d = 0; d < 4; ++d) { const int q0 = (int)__builtin_rintf(v[16 * q + 4 * d] * iv) & 255, q1 = (int)__builtin_rintf(v[16 * q + 4 * d + 1] * iv) & 255, q2 = (int)__builtin_rintf(v[16 * q + 4 * d + 2] * iv) & 255, q3 = (int)__builtin_rintf(v[16 * q + 4 * d + 3] * iv) & 255;
            wd[d] = (unsigned)(q0 | (q1 << 8) | (q2 << 16) | (q3 << 24)); }
        op[q] = (v4u){wd[0], wd[1], wd[2], wd[3]}; }
    __syncthreads();
}
__device__ __forceinline__ void win_i8_item(const Frame& F, const float* W, unsigned char* WT, float* CS, int nb, LAS float* mxs) {
    const int nd0 = 32 * nb; const bool zero = nd0 >= 12832; const int ns0 = nd0 < 6144 ? nd0 : (nd0 < 12800 ? nd0 + 32 : (zero ? 0 : nd0 - 12800 + 6144));
    w_i8_core(F, W + ns0, D_IN, zero, WT + (size_t)nd0 * D, CS + nd0, mxs);
}
__device__ __forceinline__ void wgu_i8_item(const Frame& F, const float* Wg, const float* Wu, int Fh, unsigned char* WT, float* CS, int nb, LAS float* mxs) {
    const int nd0 = 32 * nb, pn = nd0 >> 8, j = nd0 & 255;
    w_i8_core(F, ((j < 128) ? Wg : Wu) + 128 * pn + (j & 127), Fh, false, WT + (size_t)nd0 * D, CS + nd0, mxs);
}
template <bool ROUTER, bool OUT8 = false>
__device__ __forceinline__ void rms_row(const Frame& F, const float* xrow, const float* gain, bf16* orow, const LAS float* rwT, int t, unsigned* cnt, int* idx, float* topw, int* slot, LAS void* cnt_lds = nullptr, int rec = 0) {
    const f32x4* xr = (const f32x4*)xrow + F.lane; const f32x4* gr = (const f32x4*)gain + F.lane;
    f32x4 v[8]; float ss = 0.f;
#pragma unroll
    for (int j = 0; j < 8; ++j) { v[j] = xr[64 * j]; ss += (v[j].x * v[j].x + v[j].y * v[j].y) + (v[j].z * v[j].z + v[j].w * v[j].w); }
    const float r = __builtin_amdgcn_rsqf(wave_sum(ss) * (1.f / D) + NORM_EPS);
    if constexpr (OUT8) {
        float am = 0.f;
#pragma unroll
        for (int j = 0; j < 8; ++j) { v[j] = v[j] * r * gr[64 * j]; am = fmaxf(am, fmaxf(fmaxf(fabsf(v[j].x), fabsf(v[j].y)), fmaxf(fabsf(v[j].z), fabsf(v[j].w)))); }
        am = wave_max(am);
        const float iv = am > 0.f ? 127.f / am : 0.f;
        unsigned* o4 = (unsigned*)orow + F.lane;
#pragma unroll
        for (int j = 0; j < 8; ++j) { const int q0 = (int)__builtin_rintf(v[j].x * iv) & 255, q1 = (int)__builtin_rintf(v[j].y * iv) & 255, q2 = (int)__builtin_rintf(v[j].z * iv) & 255, q3 = (int)__builtin_rintf(v[j].w * iv) & 255;
            o4[64 * j] = (unsigned)(q0 | (q1 << 8) | (q2 << 16) | (q3 << 24)); }
        if (F.lane == 0) topw[t] = am * (1.f / 127.f);
    } else {
        v2u* o8 = (v2u*)orow + F.lane;
#pragma unroll
        for (int j = 0; j < 8; ++j) { v[j] = v[j] * r * gr[64 * j]; if constexpr (!ROUTER) { v2u w; w.x = pk2(v[j].x, v[j].y); w.y = pk2(v[j].z, v[j].w); o8[64 * j] = w; } }
    }
    if constexpr (ROUTER) {
        float lg[8];
#pragma unroll
        for (int e = 0; e < 8; ++e) { float s = 0.f;
#pragma unroll
            for (int j = 0; j < 8; ++j) { const f32x4 w = *(const LAS f32x4*)(rwT + e * D + 4 * F.lane + 256 * j); s += (v[j].x * w.x + v[j].y * w.y) + (v[j].z * w.z + v[j].w * w.w); }
            lg[e] = wave_sum(s); asm volatile("" ::: "memory"); }
        int e1 = 0; float l1 = lg[0];
#pragma unroll
        for (int e = 1; e < 8; ++e) if (lg[e] > l1) { l1 = lg[e]; e1 = e; }
        int e2 = -1; float l2 = -3.0e38f;
#pragma unroll
        for (int e = 0; e < 8; ++e) if (e != e1 && lg[e] > l2) { l2 = lg[e]; e2 = e; }
        if (F.lane == 0) {
            const float w1 = 1.f / (1.f + __expf(l2 - l1)), w2 = 1.f - w1;
            LAS unsigned* lcnt = (LAS unsigned*)cnt_lds; LAS int* lrec = (LAS int*)cnt_lds + 16;
            const unsigned p1 = __hip_atomic_fetch_add(lcnt + e1, 1u, __ATOMIC_RELAXED, __HIP_MEMORY_SCOPE_WORKGROUP), p2 = __hip_atomic_fetch_add(lcnt + e2, 1u, __ATOMIC_RELAXED, __HIP_MEMORY_SCOPE_WORKGROUP);
            lrec[2 * rec] = (e1 << 16) | (int)p1; lrec[2 * rec + 1] = (e2 << 16) | (int)p2; ((LAS float*)cnt_lds)[2048 + rec] = r;
            topw[2 * t] = w1; topw[2 * t + 1] = w2;
        }
    }
}

__device__ __forceinline__ void unpack8(const v4u w, float (&f)[8]) { f[0] = bflo(w.x); f[1] = bfhi(w.x); f[2] = bflo(w.y); f[3] = bfhi(w.y); f[4] = bflo(w.z); f[5] = bfhi(w.z); f[6] = bflo(w.w); f[7] = bfhi(w.w); }

__host__ __device__ constexpr int pi5(int p) { return 4 * (p >> 3) + (p & 3) + 16 * ((p >> 2) & 1); }
__host__ __device__ constexpr int pinv5(int a) { return 8 * ((a & 15) >> 2) + (a & 3) + 4 * (a >> 4); }
constexpr int PS = 136, PQ = 72;
__device__ __forceinline__ bf16x8 afrag(const LAS bf16* p) { return *(const LAS bf16x8*)p; }
__device__ __forceinline__ bf16x8 bfrag(const f32x4 t0, const f32x4 t1) {
    v4u a; a.x = pk2(t0[0], t0[1]); a.y = pk2(t0[2], t0[3]); a.z = pk2(t1[0], t1[1]); a.w = pk2(t1[2], t1[3]); return __builtin_bit_cast(bf16x8, a);
}
__device__ __forceinline__ void gdn_prep_phase(const Frame& F, const bf16* PROJ, const float* convw, const float* a_log, const float* dt_bias,
                                               bf16* QN, bf16* WB, bf16* UTB, bf16* QKB, bf16* KTB, float* EG, float* EK) {
    LAS unsigned char* L = F.lds;
    LAS bf16* KS = (LAS bf16*)L; LAS bf16* QS = (LAS bf16*)(L + 17408);
    constexpr int OVS = 34816, OAM = 69632, OQK = 104448, OVEC = 122880, OTB = 124416;
    const int tid = F.tid, lane = F.lane, w = F.wave, c = lane & 15, gq = lane >> 4;
    for (int i = tid; i < 2 * 5120 / 4; i += NWAVES * 64) ((LAS unsigned*)(L + OTB))[i] = 0u;
    __syncthreads();
    const int cm = tid >> 7, cr = (tid >> 4) & 7, cg16 = tid & 15;
    v4u xr[11]; unsigned gbraw = 0u, garaw = 0u;
#define PREP_FETCH(unit_) do { const int hq_ = (unit_) & 7, n_ = ((unit_) >> 3) & 63, b_ = (unit_) >> 9; const size_t t0_ = (size_t)b_ * SEQ + (size_t)n_ * 64; \
        const int col_ = (cm == 0 ? CQ + hq_ * 128 : cm == 1 ? CK + hq_ * 128 : CV + (2 * hq_ + (cm - 2)) * 128) + 8 * cg16; \
        const bf16* pr_ = PROJ + (t0_ + 8 * cr) * NPROJ + col_; const bool head_ = (cr == 0 && (t0_ & (SEQ - 1)) == 0); \
        _Pragma("unroll") for (int j = 0; j < 11; ++j) xr[j] = (head_ && j < 3) ? (v4u){0u, 0u, 0u, 0u} : *(const v4u*)(pr_ + (ptrdiff_t)(j - 3) * NPROJ); \
        if (w < 2) { gbraw = (unsigned)PROJ[(t0_ + lane) * NPROJ + CBETA + 2 * hq_ + w]; garaw = (unsigned)PROJ[(t0_ + lane) * NPROJ + CALPHA + 2 * hq_ + w]; } } while (0)
    if (F.vcu < NB * 64 * 8) PREP_FETCH(F.vcu);
    for (int unit = F.vcu; unit < NB * 64 * 8; unit += F.G) {
        const int hq = unit & 7, n = (unit >> 3) & 63, b = unit >> 9;
        const size_t t0 = (size_t)b * SEQ + (size_t)n * 64;
        int tu_ = F.tid; asm volatile("" : "+v"(tu_));
        const int tid = tu_, lane = tu_ & 63, c = lane & 15, gq = lane >> 4, cm = tid >> 7, cr = (tid >> 4) & 7, cg16 = tid & 15;
        const float braw_c = bflo(gbraw), araw_c = bflo(garaw);
        {
            const int m = cm, r = cr, g16 = cg16;
            const int col = (m == 0 ? CQ + hq * 128 : m == 1 ? CK + hq * 128 : CV + (2 * hq + (m - 2)) * 128) + 8 * g16;
            float wt[4][8];
#pragma unroll
            for (int tap = 0; tap < 4; ++tap) { const f32x4 a = *(const f32x4*)(convw + tap * 4096 + col), bb = *(const f32x4*)(convw + tap * 4096 + col + 4);
                wt[tap][0] = a.x; wt[tap][1] = a.y; wt[tap][2] = a.z; wt[tap][3] = a.w; wt[tap][4] = bb.x; wt[tap][5] = bb.y; wt[tap][6] = bb.z; wt[tap][7] = bb.w; }
            float x0[8], x1[8], x2[8];
            unpack8(xr[0], x0); unpack8(xr[1], x1); unpack8(xr[2], x2);
            const float qs = (m == 0) ? 0.08838834764831845f : 1.0f;
            const int pm_ = g16 & 3, ppos = 32 * (g16 >> 2) + 16 * (pm_ & 1) + 4 * (pm_ >> 1);
            LAS bf16* dst = (m == 0) ? QS : (m == 1) ? KS : (LAS bf16*)(L + OVS + (m - 2) * 17408);
#pragma unroll
            for (int j = 0; j < 8; ++j) {
                float x3[8]; unpack8(xr[3 + j], x3);
                float y[8]; float ss = 0.f;
#pragma unroll
                for (int i = 0; i < 8; ++i) { float a = wt[0][i] * x0[i] + wt[1][i] * x1[i] + wt[2][i] * x2[i] + wt[3][i] * x3[i]; a = fsilu(a); y[i] = a; ss += a * a; }
                if (m < 2) { const float sc = __builtin_amdgcn_rsqf(reduce16(ss) + 1e-6f) * qs;
#pragma unroll
                    for (int i = 0; i < 8; ++i) y[i] *= sc; }
                v4u o; o.x = pk2(y[0], y[1]); o.y = pk2(y[2], y[3]); o.z = pk2(y[4], y[5]); o.w = pk2(y[6], y[7]);
                const int tok = 8 * r + j;
                if (m < 2) { v2u lo, hi2; lo.x = o.x; lo.y = o.y; hi2.x = o.z; hi2.y = o.w; *(LAS v2u*)(dst + tok * PS + ppos) = lo; *(LAS v2u*)(dst + tok * PS + ppos + 8) = hi2; }
                else *(LAS v4u*)(dst + tok * PS + 8 * g16) = o;
#pragma unroll
                for (int i = 0; i < 8; ++i) { x0[i] = x1[i]; x1[i] = x2[i]; x2[i] = x3[i]; }
            }
        }
        __syncthreads();
        if (w < 2) {
            const int h = 2 * hq + w; LAS float* GC = (LAS float*)(L + OVEC + w * 768);
            const float braw = braw_c, araw = araw_c;
            const float xx = araw + dt_bias[h]; const float sp = xx > 20.f ? xx : log1pf(__expf(xx));
            float g = -__expf(a_log[h]) * sp;
#pragma unroll
            for (int o = 1; o < 64; o <<= 1) { const float y = __shfl_up(g, o); if (lane >= o) g += y; }
            const float last = __shfl(g, 63), eg = __expf(g), ek = __expf(last - g);
            GC[lane] = g; GC[64 + lane] = eg; GC[128 + lane] = fsigmoid(braw);
            EG[(t0 + lane) * 16 + h] = eg; EK[(t0 + lane) * 16 + h] = ek;
        }
        {
#pragma unroll
            for (int i = 0; i < 2; ++i) { const int ch = tid + 512 * i, tok = ch >> 4, part = ch & 15; *(v4u*)(QN + (t0 + tok) * 1024 + hq * 128 + part * 8) = *(const LAS v4u*)(QS + tok * PS + part * 8); }
            if (tid < 256) { const int pcol = tid >> 1, half = tid & 1, dk = (pcol & 96) + pi5(pcol & 31);
                v4u* kp = (v4u*)(KTB + ((size_t)(b * 8 + hq) * 64 + n) * 8192 + (size_t)dk * 64 + 32 * half);
#pragma unroll
                for (int q8 = 0; q8 < 4; ++q8) { unsigned e[8];
#pragma unroll
                    for (int i = 0; i < 8; ++i) e[i] = (unsigned)KS[(32 * half + pi5(8 * q8 + i)) * PS + pcol];
                    v4u o; o.x = e[0] | (e[1] << 16); o.y = e[2] | (e[3] << 16); o.z = e[4] | (e[5] << 16); o.w = e[6] | (e[7] << 16); kp[q8] = o; } }
        }
        __syncthreads();
        {
            const int type = w >> 2, ct = w & 3;
            float rgc[2][4], rbe[2][4], cgc[2][4];
#pragma unroll
            for (int hh = 0; hh < 2; ++hh) { const LAS float* GC = (const LAS float*)(L + OVEC + hh * 768);
#pragma unroll
                for (int r = 0; r < 4; ++r) { rgc[hh][r] = GC[16 * ct + 4 * gq + r]; rbe[hh][r] = GC[128 + 16 * ct + 4 * gq + r]; cgc[hh][r] = GC[16 * r + c]; } }
            f32x4 accs[4];
#pragma unroll
            for (int st = 0; st < 4; ++st) {
                accs[st] = (f32x4){0.f, 0.f, 0.f, 0.f};
                if (st <= ct) {
                    const LAS bf16* ap = (type ? QS : KS) + (16 * ct + c) * PS + 8 * gq; const LAS bf16* bp = KS + (16 * st + c) * PS + 8 * gq;
#pragma unroll
                    for (int ks = 0; ks < 4; ++ks) accs[st] = __builtin_amdgcn_mfma_f32_16x16x32_bf16(*(const LAS bf16x8*)(ap + 32 * ks), *(const LAS bf16x8*)(bp + 32 * ks), accs[st], 0, 0, 0);
                }
            }
            asm volatile("" ::: "memory");
#pragma unroll
            for (int st = 0; st < 4; ++st) { const int col = 16 * st + c;
#pragma unroll
                for (int hh = 0; hh < 2; ++hh) {
                    LAS bf16* AOb = (LAS bf16*)(L + OAM + hh * 17408); LAS float* AD = (LAS float*)(L + OAM + hh * 17408 + 9216); LAS bf16* QKs = (LAS bf16*)(L + OQK + hh * 9216);
#pragma unroll
                    for (int r = 0; r < 4; ++r) { const int row = 16 * ct + 4 * gq + r;
                        const float dec = __expf(fminf(rgc[hh][r] - cgc[hh][st], 0.f));
                        if (type == 0) { const float av = (col < row) ? rbe[hh][r] * accs[st][r] * dec : 0.f;
                            if (st == ct) AD[(ct * 16 + (row & 15)) * 17 + (col & 15)] = av;
                            AOb[row * 72 + (col & 32) + pinv5(col & 31)] = (bf16)(pk2(st == ct ? 0.f : -av, 0.f) & 0xffffu); }
                        else QKs[row * PQ + (col & 32) + pinv5(col & 31)] = (bf16)(pk2((col <= row) ? accs[st][r] * dec : 0.f, 0.f) & 0xffffu); }
                }
            }
        }
        if (unit + F.G < NB * 64 * 8) PREP_FETCH(unit + F.G);
        __syncthreads();
        {
            const int hh = w >> 2, wv = w & 3, h = 2 * hq + hh;
            const int lu = lane;
            const size_t ubh = ((size_t)(b * 16 + h) * 64 + n);
            const LAS bf16* VS = (const LAS bf16*)(L + OVS + hh * 17408);
            const LAS bf16* AOb = (const LAS bf16*)(L + OAM + hh * 17408); const LAS float* AD = (const LAS float*)(L + OAM + hh * 17408 + 9216);
            LAS bf16* Tb = (LAS bf16*)(L + OTB + hh * 5120);
            if (wv == 0) {
                const int jc = lu & 15, blk = lu >> 4; const LAS float* ad = AD + blk * 272;
                float t[16];
#pragma unroll
                for (int i = 0; i < 16; ++i) { float sacc = (i == jc) ? 1.f : 0.f;
#pragma unroll
                    for (int m = 0; m < i; ++m) sacc -= ad[i * 17 + m] * t[m];
                    t[i] = sacc; }
#pragma unroll
                for (int i = 0; i < 16; ++i) Tb[(blk * 16 + i) * 40 + pinv5(jc)] = (bf16)(pk2(t[i], 0.f) & 0xffffu);
            }
            float xb[4][4][4];
            const LAS float* GCv = (const LAS float*)(L + OVEC + hh * 768);
#pragma unroll
            for (int t4 = 0; t4 < 4; ++t4) { const int j = 64 * wv + 16 * t4 + c;
#pragma unroll
                for (int i = 0; i < 4; ++i)
#pragma unroll
                    for (int r = 0; r < 4; ++r) { const int row = 16 * i + 4 * gq + r;
                        xb[t4][i][r] = (wv < 2) ? GCv[128 + row] * bflo((unsigned)VS[row * PS + j]) : GCv[128 + row] * GCv[64 + row] * bflo((unsigned)KS[row * PS + j - 128]); } }
            __syncthreads();
            const bf16x8 fa10 = afrag(AOb + (16 + c) * 72 + 8 * gq), fa20 = afrag(AOb + (32 + c) * 72 + 8 * gq), fa30 = afrag(AOb + (48 + c) * 72 + 8 * gq), fa31 = afrag(AOb + (48 + c) * 72 + 32 + 8 * gq);
            bf16x8 ft[4];
#pragma unroll
            for (int i = 0; i < 4; ++i) ft[i] = afrag(Tb + (i * 16 + c) * 40 + 8 * gq);
            const f32x4 z4 = (f32x4){0.f, 0.f, 0.f, 0.f};
#pragma unroll
            for (int t4 = 0; t4 < 4; ++t4) { const int j = 64 * wv + 16 * t4 + c;
                f32x4 B0, B1, B2, B3;
#pragma unroll
                for (int r = 0; r < 4; ++r) { B0[r] = xb[t4][0][r]; B1[r] = xb[t4][1][r]; B2[r] = xb[t4][2][r]; B3[r] = xb[t4][3][r]; }
                const f32x4 X0 = __builtin_amdgcn_mfma_f32_16x16x32_bf16(ft[0], bfrag(B0, z4), z4, 0, 0, 0);
                const f32x4 a1 = __builtin_amdgcn_mfma_f32_16x16x32_bf16(fa10, bfrag(X0, z4), B1, 0, 0, 0);
                const f32x4 X1 = __builtin_amdgcn_mfma_f32_16x16x32_bf16(ft[1], bfrag(a1, z4), z4, 0, 0, 0);
                const bf16x8 x01 = bfrag(X0, X1);
                const f32x4 a2 = __builtin_amdgcn_mfma_f32_16x16x32_bf16(fa20, x01, B2, 0, 0, 0);
                const f32x4 X2 = __builtin_amdgcn_mfma_f32_16x16x32_bf16(ft[2], bfrag(a2, z4), z4, 0, 0, 0);
                f32x4 a3 = __builtin_amdgcn_mfma_f32_16x16x32_bf16(fa30, x01, B3, 0, 0, 0);
                a3 = __builtin_amdgcn_mfma_f32_16x16x32_bf16(fa31, bfrag(X2, z4), a3, 0, 0, 0);
                const f32x4 X3 = __builtin_amdgcn_mfma_f32_16x16x32_bf16(ft[3], bfrag(a3, z4), z4, 0, 0, 0);
                if (wv < 2) {
                    bf16* up = UTB + ubh * 8192 + (size_t)j * 64 + 4 * gq;
                    v2u o; o.x = pk2(X0[0], X0[1]); o.y = pk2(X0[2], X0[3]); *(v2u*)up = o;
                    o.x = pk2(X1[0], X1[1]); o.y = pk2(X1[2], X1[3]); *(v2u*)(up + 16) = o;
                    o.x = pk2(X2[0], X2[1]); o.y = pk2(X2[2], X2[3]); *(v2u*)(up + 32) = o;
                    o.x = pk2(X3[0], X3[1]); o.y = pk2(X3[2], X3[3]); *(v2u*)(up + 48) = o;
                } else {
                    LAS bf16* Wt = (hh ? KS : QS) + (4 * gq) * PS + j - 128;
#pragma unroll
                    for (int r = 0; r < 4; ++r) { Wt[r * PS] = (bf16)(pk2(X0[r], 0.f) & 0xffffu); Wt[(16 + r) * PS] = (bf16)(pk2(X1[r], 0.f) & 0xffffu);
                        Wt[(32 + r) * PS] = (bf16)(pk2(X2[r], 0.f) & 0xffffu); Wt[(48 + r) * PS] = (bf16)(pk2(X3[r], 0.f) & 0xffffu); }
                }
            }
        }
        __syncthreads();
#pragma unroll
        for (int hh = 0; hh < 2; ++hh) { const size_t ubh = ((size_t)(b * 16 + 2 * hq + hh) * 64 + n); const LAS bf16* Wt = hh ? KS : QS; const LAS bf16* QKs = (const LAS bf16*)(L + OQK + hh * 9216);
#pragma unroll
            for (int i = 0; i < 2; ++i) { const int ch = tid + 512 * i, tok = ch >> 4, part = ch & 15; *(v4u*)(WB + ubh * 8192 + (size_t)ch * 8) = *(const LAS v4u*)(Wt + tok * PS + part * 8); }
            { const int tok = tid >> 3, part = tid & 7; *(v4u*)(QKB + ubh * 4096 + (size_t)tid * 8) = *(const LAS v4u*)(QKs + tok * PQ + part * 8); } }
        __syncthreads();
    }
}

__device__ __forceinline__ void gdn_scan_phase(const Frame& F, const int unit0, const int ustride, const bf16* QN, const bf16* WB, const bf16* UTB, const bf16* QKB, const bf16* KTB, const float* EG, const float* EK,
                                               const bf16* PROJ, const float* gng, bf16* OA) {
    LAS unsigned char* L = F.lds;
    constexpr int OW = 0, OQ = 16384, OKT = 32768, OQK = 49152, OE = 57344, BUF = 57856, OOT = 2 * BUF, OTS = 136 * 64 * 2;
    const int tid = F.tid, lane = F.lane, w = F.wave, c = lane & 15, gq = lane >> 4, dv0 = 16 * w;
    const int r128 = lane >> 4, p128 = lane & 15, r64 = lane >> 3, p64 = lane & 7;
    for (int unit = unit0; unit < NB * 16; unit += ustride) {
        const int h = unit & 15, b = unit >> 4, hq = h >> 1;
        const size_t tb = (size_t)b * SEQ; const size_t ubh = (size_t)(b * 16 + h) * 64, ubq = (size_t)(b * 8 + hq) * 64;
        f32x4 S[8];
#pragma unroll
        for (int i = 0; i < 8; ++i) S[i] = (f32x4){0.f, 0.f, 0.f, 0.f};
        v2u ucur[4], unext[4];
        const int gtok = tid >> 3, gdv = (tid & 7) * 16;
        LAS float* GN = (LAS float*)(L + OOT + 2 * OTS);
        if (tid < 128) GN[tid] = gng[tid];
        v4u zc[2];
#define GSCAN_ZLOAD(n_) do { const bf16* zp_ = PROJ + (tb + (size_t)(n_) * 64 + gtok) * NPROJ + CZ + h * 128 + gdv; zc[0] = *(const v4u*)zp_; zc[1] = *(const v4u*)(zp_ + 8); } while (0)
#define GSCAN_NORM(n_) do { const LAS bf16* ot_ = (const LAS bf16*)(L + OOT + ((n_) & 1) * OTS) + gtok * 136 + gdv; \
            float o_[16]; { float t8_[8]; unpack8(*(const LAS v4u*)ot_, t8_); _Pragma("unroll") for (int i = 0; i < 8; ++i) o_[i] = t8_[i]; unpack8(*(const LAS v4u*)(ot_ + 8), t8_); _Pragma("unroll") for (int i = 0; i < 8; ++i) o_[8 + i] = t8_[i]; } \
            float ss_ = 0.f; _Pragma("unroll") for (int i = 0; i < 16; ++i) ss_ += o_[i] * o_[i]; \
            ss_ += dpp_f<0xB1>(ss_); ss_ += dpp_f<0x4E>(ss_); ss_ += dpp_f<0x141>(ss_);     \
            const float r_ = __builtin_amdgcn_rsqf(ss_ * (1.f / 128.f) + NORM_EPS); \
            float z_[16]; { float t8_[8]; unpack8(zc[0], t8_); _Pragma("unroll") for (int i = 0; i < 8; ++i) z_[i] = t8_[i]; unpack8(zc[1], t8_); _Pragma("unroll") for (int i = 0; i < 8; ++i) z_[8 + i] = t8_[i]; } \
            f32x4 gg[4]; _Pragma("unroll") for (int i = 0; i < 4; ++i) gg[i] = *(const LAS f32x4*)(GN + gdv + 4 * i); \
            unsigned w_[8]; _Pragma("unroll") for (int i = 0; i < 8; ++i) w_[i] = pk2(o_[2 * i] * r_ * gg[i >> 1][(2 * i) & 3] * fsilu(z_[2 * i]), o_[2 * i + 1] * r_ * gg[i >> 1][(2 * i + 1) & 3] * fsilu(z_[2 * i + 1])); \
            v4u* op_ = (v4u*)(OA + (tb + (size_t)(n_) * 64 + gtok) * 2048 + h * 128 + gdv); op_[0] = (v4u){w_[0], w_[1], w_[2], w_[3]}; op_[1] = (v4u){w_[4], w_[5], w_[6], w_[7]}; } while (0)
        unsigned offW[2], offQ[2], offK[2], offQK;
#pragma unroll
        for (int k = 0; k < 2; ++k) { const int r = 4 * (w + 8 * k) + r128, r2 = 8 * (w + 8 * k) + r64;
            offW[k] = (unsigned)(r * 256 + ((p128 ^ (r & 15)) << 4)); offQ[k] = (unsigned)(r * 2048 + ((p128 ^ (r & 15)) << 4)); offK[k] = (unsigned)(r2 * 128 + ((p64 ^ ((r2 >> 1) & 7)) << 4)); }
        { const int r2 = 8 * w + r64; offQK = (unsigned)(r2 * 128 + ((p64 ^ ((r2 >> 1) & 7)) << 4)); }
#define GSCAN_FILL(n_, buf_) do { const size_t t0_ = tb + (size_t)(n_) * 64; LAS unsigned char* B1 = L + (buf_) * BUF; \
            const char* bw_ = (const char*)(WB + (ubh + (n_)) * 8192); const char* bq_ = (const char*)(QN + t0_ * 1024 + hq * 128); \
            const char* bk_ = (const char*)(KTB + (ubq + (n_)) * 8192); const char* bqk_ = (const char*)(QKB + (ubh + (n_)) * 4096); \
            _Pragma("unroll") for (int k = 0; k < 2; ++k) { \
                __builtin_amdgcn_global_load_lds((const unsigned*)(bw_ + offW[k]), (LAS unsigned*)(B1 + OW + (w + 8 * k) * 1024), 16, 0, 0); \
                __builtin_amdgcn_global_load_lds((const unsigned*)(bq_ + offQ[k]), (LAS unsigned*)(B1 + OQ + (w + 8 * k) * 1024), 16, 0, 0); \
                __builtin_amdgcn_global_load_lds((const unsigned*)(bk_ + offK[k]), (LAS unsigned*)(B1 + OKT + (w + 8 * k) * 1024), 16, 0, 0); } \
            __builtin_amdgcn_global_load_lds((const unsigned*)(bqk_ + offQK), (LAS unsigned*)(B1 + OQK + w * 1024), 16, 0, 0); \
            if (w < 2) __builtin_amdgcn_global_load_lds((const unsigned*)((w ? EK : EG) + (t0_ + lane) * 16 + h), (LAS unsigned*)(B1 + OE + w * 256), 4, 0, 0);     \
            _Pragma("unroll") for (int mt = 0; mt < 4; ++mt) unext[mt] = *(const v2u*)(UTB + (ubh + (n_)) * 8192 + (size_t)(dv0 + c) * 64 + 16 * mt + 4 * gq); } while (0)
        GSCAN_FILL(0, 0);
#pragma unroll
        for (int mt = 0; mt < 4; ++mt) ucur[mt] = unext[mt];
        asm volatile("s_waitcnt vmcnt(0)" ::: "memory");
        __syncthreads();
        for (int n = 0; n < SEQ / 64; ++n) {
            const int buf = n & 1;
            if (n + 1 < SEQ / 64) GSCAN_FILL(n + 1, buf ^ 1);
            if (n > 0) GSCAN_ZLOAD(n - 1);
            const LAS unsigned char* B0 = L + buf * BUF;
            const LAS float* EGs = (const LAS float*)(B0 + OE); const LAS float* EKs = EGs + 64;
#define FR128(base_, mt_, ks_) (*(const LAS bf16x8*)(B0 + (base_) + (16 * (mt_) + c) * 256 + (((4 * (ks_) + gq) ^ c) << 4)))
#define FR64(base_, mt_, ks_)  (*(const LAS bf16x8*)(B0 + (base_) + (16 * (mt_) + c) * 128 + (((4 * (ks_) + gq) ^ ((c >> 1) & 7)) << 4)))
            bf16x8 Sb[4];
#pragma unroll
            for (int ks = 0; ks < 4; ++ks) Sb[ks] = bfrag(S[2 * ks], S[2 * ks + 1]);
            f32x4 P[4], O[4];
            bf16x8 fw[2][4], fq[2][4];
#define GS_LDW(mt_, b_) do { _Pragma("unroll") for (int ks = 0; ks < 4; ++ks) fw[b_][ks] = FR128(OW, mt_, ks); } while (0)
#define GS_LDQ(mt_, b_) do { _Pragma("unroll") for (int ks = 0; ks < 4; ++ks) fq[b_][ks] = FR128(OQ, mt_, ks); } while (0)
            GS_LDW(0, 0);
#pragma unroll
            for (int mt = 0; mt < 4; ++mt) {
                if (mt < 3) GS_LDW(mt + 1, (mt + 1) & 1); else GS_LDQ(0, 0);
                P[mt] = (f32x4){0.f, 0.f, 0.f, 0.f};
#pragma unroll
                for (int ks = 0; ks < 4; ++ks) P[mt] = __builtin_amdgcn_mfma_f32_16x16x32_bf16(fw[mt & 1][ks], Sb[ks], P[mt], 0, 0, 0);
            }
            f32x4 Vn[4], Vs[4];
#pragma unroll
            for (int mt = 0; mt < 4; ++mt) {
                const f32x4 ek = *(const LAS f32x4*)(EKs + 16 * mt + 4 * gq);
                const v2u uw = ucur[mt];
                Vn[mt][0] = bflo(uw.x) - P[mt][0]; Vn[mt][1] = bfhi(uw.x) - P[mt][1]; Vn[mt][2] = bflo(uw.y) - P[mt][2]; Vn[mt][3] = bfhi(uw.y) - P[mt][3];
                Vs[mt] = Vn[mt] * ek; }
            const bf16x8 Vb0 = bfrag(Vn[0], Vn[1]), Vb1 = bfrag(Vn[2], Vn[3]), Vs0 = bfrag(Vs[0], Vs[1]), Vs1 = bfrag(Vs[2], Vs[3]);
#pragma unroll
            for (int mt = 0; mt < 4; ++mt) {
                if (mt < 3) GS_LDQ(mt + 1, (mt + 1) & 1);
                else {
#pragma unroll
                    for (int m2 = 0; m2 < 4; ++m2) { fw[0][m2] = FR64(OQK, m2, 0); fw[1][m2] = FR64(OQK, m2, 1); }
                }
                O[mt] = (f32x4){0.f, 0.f, 0.f, 0.f};
#pragma unroll
                for (int ks = 0; ks < 4; ++ks) O[mt] = __builtin_amdgcn_mfma_f32_16x16x32_bf16(fq[mt & 1][ks], Sb[ks], O[mt], 0, 0, 0);
            }
#undef GS_LDW
#undef GS_LDQ
#pragma unroll
            for (int i = 0; i < 4; ++i) { fq[0][i] = FR64(OKT, i, 0); fq[1][i] = FR64(OKT, i, 1); }
#pragma unroll
            for (int mt = 0; mt < 4; ++mt) {
                O[mt] = O[mt] * *(const LAS f32x4*)(EGs + 16 * mt + 4 * gq);
                O[mt] = __builtin_amdgcn_mfma_f32_16x16x32_bf16(fw[0][mt], Vb0, O[mt], 0, 0, 0);
                O[mt] = __builtin_amdgcn_mfma_f32_16x16x32_bf16(fw[1][mt], Vb1, O[mt], 0, 0, 0); }
            const float gl = EGs[63];
#pragma unroll
            for (int i = 0; i < 4; ++i) { fw[0][i] = FR64(OKT, 4 + i, 0); fw[1][i] = FR64(OKT, 4 + i, 1); }
            {
                LAS bf16* ot = (LAS bf16*)(L + OOT + (n & 1) * OTS) + (4 * gq) * 136 + dv0 + c;
#pragma unroll
                for (int mt = 0; mt < 4; ++mt)
#pragma unroll
                    for (int r = 0; r < 4; ++r) ot[(16 * mt + r) * 136] = (bf16)(pk2(O[mt][r], 0.f) & 0xffffu);
            }
#pragma unroll
            for (int i = 0; i < 8; ++i) { S[i] = S[i] * gl;
                S[i] = __builtin_amdgcn_mfma_f32_16x16x32_bf16(i < 4 ? fq[0][i & 3] : fw[0][i & 3], Vs0, S[i], 0, 0, 0);
                S[i] = __builtin_amdgcn_mfma_f32_16x16x32_bf16(i < 4 ? fq[1][i & 3] : fw[1][i & 3], Vs1, S[i], 0, 0, 0); }
#undef FR128
#undef FR64
            if (n + 1 < SEQ / 64) {
#pragma unroll
                for (int mt = 0; mt < 4; ++mt) ucur[mt] = unext[mt]; }
            if (n > 0) GSCAN_NORM(n - 1);
            asm volatile("s_waitcnt vmcnt(2) lgkmcnt(0)" ::: "memory"); __builtin_amdgcn_s_barrier(); asm volatile("" ::: "memory");
        }
        GSCAN_ZLOAD(SEQ / 64 - 1); GSCAN_NORM(SEQ / 64 - 1);
        __syncthreads();
#undef GSCAN_ZLOAD
#undef GSCAN_NORM
#undef GSCAN_FILL
    }
}

constexpr int KS_STRIDE = 72, VT_STRIDE = 264;
__device__ __forceinline__ void swa_phase(const Frame& F, const int unit0, const int ustride, const bf16* PROJ, const float* sinks, const float* rel_bias, bf16* OB) {
    LAS unsigned char* L = F.lds;
    LAS bf16* Ks = (LAS bf16*)L;
    LAS bf16* VT = (LAS bf16*)(L + 256 * KS_STRIDE * 2);
    LAS float* BT = (LAS float*)(L + 256 * KS_STRIDE * 2 + 64 * VT_STRIDE * 2);
    const int tid = F.tid, lane = F.lane, w = F.wave, c = lane & 15, gq = lane >> 4;
#pragma unroll 1
    for (int i = tid; i < 32 * 384; i += 512) {
        const int hd = i / 384, d = i % 384 - 128;
        float v = -3.0e38f;
        if (d >= 0 && d < 128) { int bucket = d;
            if (d >= 16) { int lg = 16 + (int)(__logf((float)d * (1.f / 16.f)) * (16.f / 2.0794415416798357f)); bucket = lg < 31 ? lg : 31; }
            v = rel_bias[bucket * 32 + hd] * 1.4426950408889634f; }
        BT[i] = v;
    }
    __syncthreads();
    for (int unit = unit0; unit < NB * 32 * 4; unit += ustride) {
        const int kvh = unit & 3, n = (unit >> 2) & 31, b = unit >> 7;
        const size_t tok0 = (size_t)b * SEQ + (size_t)n * 128;
#pragma unroll
        for (int i = 0; i < 4; ++i) {
            const int ch = tid + 512 * i, key = ch >> 3, part = ch & 7;
            v4u kw = (v4u){0u, 0u, 0u, 0u}, vw = (v4u){0u, 0u, 0u, 0u};
            if (n > 0 || key >= 128) { const size_t t = tok0 - 128 + key; kw = *(const v4u*)(PROJ + t * NPROJ + CSK + kvh * 64 + part * 8); vw = *(const v4u*)(PROJ + t * NPROJ + CSV + kvh * 64 + part * 8); }
            *(LAS v4u*)(Ks + key * KS_STRIDE + part * 8) = kw;
            LAS bf16* vt = VT + (part * 8) * VT_STRIDE + key;
            vt[0 * VT_STRIDE] = (bf16)(vw.x & 0xffff); vt[1 * VT_STRIDE] = (bf16)(vw.x >> 16); vt[2 * VT_STRIDE] = (bf16)(vw.y & 0xffff); vt[3 * VT_STRIDE] = (bf16)(vw.y >> 16);
            vt[4 * VT_STRIDE] = (bf16)(vw.z & 0xffff); vt[5 * VT_STRIDE] = (bf16)(vw.z >> 16); vt[6 * VT_STRIDE] = (bf16)(vw.w & 0xffff); vt[7 * VT_STRIDE] = (bf16)(vw.w >> 16);
        }
        __syncthreads();
        const int kt0 = w & ~1;
        const int qi = 16 * w + c;
        const bf16* qp0 = PROJ + (tok0 + qi) * NPROJ + CSQ + kvh * 512 + 8 * gq;
        bf16x8 nq0 = *(const bf16x8*)qp0, nq1 = *(const bf16x8*)(qp0 + 32);
        for (int g = 0; g < 8; ++g) {
            const int head = kvh * 8 + g;
            const bf16x8 bq0 = nq0, bq1 = nq1;
            if (g < 7) { nq0 = *(const bf16x8*)(qp0 + (g + 1) * 64); nq1 = *(const bf16x8*)(qp0 + (g + 1) * 64 + 32); }
            f32x4 s[10];
#pragma unroll
            for (int i = 0; i < 10; ++i) {
                const LAS bf16* kp = Ks + (16 * (kt0 + i) + c) * KS_STRIDE + 8 * gq;
                const bf16x8 a0 = *(const LAS bf16x8*)kp, a1 = *(const LAS bf16x8*)(kp + 32);
                f32x4 z = (f32x4){0.f, 0.f, 0.f, 0.f};
                z = __builtin_amdgcn_mfma_f32_16x16x32_bf16(a0, bq0, z, 0, 0, 0);
                s[i] = __builtin_amdgcn_mfma_f32_16x16x32_bf16(a1, bq1, z, 0, 0, 0);
            }
            const float sink = sinks[head] * 1.4426950408889634f;
            float m = sink;
            const int d0 = qi + 128 - (16 * kt0 + 4 * gq);
            const LAS float* bt = BT + head * 384 + (d0 + 128 - 147);
#pragma unroll
            for (int i = 0; i < 10; ++i)
#pragma unroll
                for (int r = 0; r < 4; ++r) { const float x = s[i][r] * 0.18033688011112042f + bt[147 - 16 * i - r]; s[i][r] = x; }
            if (n == 0) {
                int d0m = d0; unsigned lim = (unsigned)qi; asm volatile("" : "+v"(d0m), "+v"(lim));
#pragma unroll
                for (int i = 0; i < 10; ++i)
#pragma unroll
                    for (int r = 0; r < 4; ++r) s[i][r] = ((unsigned)(d0m - (16 * i + r)) <= lim) ? s[i][r] : -3.0e38f;
            }
#pragma unroll
            for (int i = 0; i < 10; ++i) m = fmaxf(m, fmaxf(fmaxf(s[i][0], s[i][1]), fmaxf(s[i][2], s[i][3])));
            m = fmaxf(m, __shfl_xor(m, 16)); m = fmaxf(m, __shfl_xor(m, 32));
            float sum = 0.f;
#pragma unroll
            for (int i = 0; i < 10; ++i)
#pragma unroll
                for (int r = 0; r < 4; ++r) { const float p = __builtin_amdgcn_exp2f(s[i][r] - m); s[i][r] = p; sum += p; }
            sum += __shfl_xor(sum, 16); sum += __shfl_xor(sum, 32);
            const float inv = 1.f / (sum + __builtin_amdgcn_exp2f(sink - m));
            f32x4 o[4];
#pragma unroll
            for (int dt = 0; dt < 4; ++dt) o[dt] = (f32x4){0.f, 0.f, 0.f, 0.f};
#pragma unroll
            for (int ks = 0; ks < 5; ++ks) {
                v4u pw; pw.x = pk2(s[2 * ks][0], s[2 * ks][1]); pw.y = pk2(s[2 * ks][2], s[2 * ks][3]); pw.z = pk2(s[2 * ks + 1][0], s[2 * ks + 1][1]); pw.w = pk2(s[2 * ks + 1][2], s[2 * ks + 1][3]);
                const bf16x8 pb = __builtin_bit_cast(bf16x8, pw);
#pragma unroll
                for (int dt = 0; dt < 4; ++dt) {
                    const LAS bf16* vp = VT + (16 * dt + c) * VT_STRIDE + 16 * (kt0 + 2 * ks) + 4 * gq;
                    const v2u lo = *(const LAS v2u*)vp, hi = *(const LAS v2u*)(vp + 16);
                    v4u aw; aw.x = lo.x; aw.y = lo.y; aw.z = hi.x; aw.w = hi.y;
                    o[dt] = __builtin_amdgcn_mfma_f32_16x16x32_bf16(__builtin_bit_cast(bf16x8, aw), pb, o[dt], 0, 0, 0);
                }
            }
            bf16* op = OB + (tok0 + qi) * 2048 + head * 64 + 4 * gq;
#pragma unroll
            for (int dt = 0; dt < 4; ++dt) { v2u wv; wv.x = pk2(o[dt][0] * inv, o[dt][1] * inv); wv.y = pk2(o[dt][2] * inv, o[dt][3] * inv); *(v2u*)(op + 16 * dt) = wv; }
        }
        __syncthreads();
    }
}

__device__ __forceinline__ void final_phase(const Frame& F, const float* X, float* OUT, const bf16* YG, const float* topw, const int* slot, const float* gain) {
    const int gw = F.vcu * NWAVES + F.wave, NGW = F.G * NWAVES, lane = F.lane;
    int ps[9]; ps[0] = 0;
#pragma unroll
    for (int e = 0; e < 8; ++e) ps[e + 1] = ps[e] + (int)(((F.ctl[CW_CNT + e] + 255u) >> 8) << 8);
    for (int t = gw; t < T; t += NGW) {
        const int s0 = slot[2 * t], s1 = slot[2 * t + 1]; const float w0 = topw[2 * t], w1 = topw[2 * t + 1];
        int b0 = 0, b1 = 0;
#pragma unroll
        for (int k = 1; k < 8; ++k) { if ((s0 >> 16) == k) b0 = ps[k]; if ((s1 >> 16) == k) b1 = ps[k]; }
        const int r0 = b0 + (s0 & 0xffff), r1 = b1 + (s1 & 0xffff);
        const f32x4* xr = (const f32x4*)(X + (size_t)t * D) + lane; f32x4* outr = (f32x4*)(OUT + (size_t)t * D) + lane; const f32x4* gr = (const f32x4*)gain + lane;
        const v2u* y0 = (const v2u*)(YG + (size_t)r0 * D) + lane; const v2u* y1 = (const v2u*)(YG + (size_t)r1 * D) + lane;
        f32x4 v[8]; float ss = 0.f;
#pragma unroll
        for (int j = 0; j < 8; ++j) { const v2u a = y0[64 * j], bb = y1[64 * j]; f32x4 x = xr[64 * j];
            x.x += w0 * bflo(a.x) + w1 * bflo(bb.x); x.y += w0 * bfhi(a.x) + w1 * bfhi(bb.x); x.z += w0 * bflo(a.y) + w1 * bflo(bb.y); x.w += w0 * bfhi(a.y) + w1 * bfhi(bb.y);
            v[j] = x; ss += (x.x * x.x + x.y * x.y) + (x.z * x.z + x.w * x.w); }
        const float r = __builtin_amdgcn_rsqf(wave_sum(ss) * (1.f / D) + NORM_EPS);
#pragma unroll
        for (int j = 0; j < 8; ++j) outr[64 * j] = v[j] * r * gr[64 * j];
    }
}

constexpr int N_PHASES = 23;
typedef __attribute__((address_space(4))) const Args CArgs;
__device__ __forceinline__ CArgs* get_args() { CArgs* p = (CArgs*)__builtin_amdgcn_kernarg_segment_ptr(); asm volatile("" : "+s"(p)); return p; }
#define WSP(T_, off) ((T_*)(ws + (off)))
__device__ __forceinline__ Frame refresh(const Frame& F0) { Frame F = F0; int t = threadIdx.x; asm volatile("" : "+v"(t)); F.tid = t; F.lane = t & 63; return F; }

__device__ __forceinline__ void phase_prologue(const Frame& F0) {
    const Frame F = refresh(F0);
    CArgs* A = get_args(); unsigned char* ws = A->ws;
    const int gw = F.vcu * NWAVES + F.wave, NGW = F.G * NWAVES;
    LAS float* scr = (LAS float*)(F.lds + RING_OFF + F.wave * 16384);
    constexpr int I_IN = (D / 64) * (NPROJ / 32), I_SQ = (D / 64) * (D / 32), I_GU = (D / 64) * (FFD2 / 32), I_DN = (FFD / 64) * (D / 32);
    constexpr int NITEMS = 3 * I_SQ + I_DN;
    for (int it = F.vcu; it < NPROJ / 32 + FFD2 / 32; it += F.G) {
        LAS float* mxs = (LAS float*)(F.lds + RING_OFF + 12288);
        if (it < NPROJ / 32) win_i8_item(F, A->in[2], (unsigned char*)(ws + WS_WIN), WSP(float, WS_CS), it, mxs);
        else wgu_i8_item(F, A->in[13], A->in[14], FFD, (unsigned char*)(ws + WS_WGU), WSP(float, WS_CSF), it - NPROJ / 32, mxs); }
    for (int it = gw; it < NITEMS; it += NGW) {
        int r = it;
        if (r < 3 * I_SQ) { const int which = r / I_SQ;
            const float* src = (which == 0 ? A->in[9] : which == 1 ? A->in[10] : A->in[11]); bf16* dst = (bf16*)(ws + (which == 0 ? WS_WPG : which == 1 ? WS_WPS : WS_WO));
            tr_plain(src, D, D, dst, r % I_SQ, scr, F.lane); continue; } r -= 3 * I_SQ;
        tr_plain(A->in[15], FFD, D, (bf16*)(ws + WS_WDN), r, scr, F.lane);
    }
    const float* x_in = A->in[0]; const float* gain = A->in[1]; bf16* Hb = WSP(bf16, WS_H);
    for (int m = gw; m < T; m += NGW) rms_row<false, true>(F, x_in + (size_t)m * D, gain, (bf16*)((unsigned char*)Hb + (size_t)m * D), nullptr, m, nullptr, nullptr, WSP(float, WS_RS), nullptr);
}
__device__ __forceinline__ void moe_convert(const Frame& F, int e_lo, int e_hi, int wk, int nwk, int part) {
    CArgs* A = get_args(); unsigned char* ws = A->ws;
    LAS float* scr = (LAS float*)(F.lds + RING_OFF + F.wave * 16384);
    constexpr int I_MGU = (D / 64) * (FFE2 / 32), I_MDN = (FFE / 64) * (D / 32);
    const int gw = wk * NWAVES + F.wave, NGW = nwk * NWAVES, nit = (e_hi - e_lo) * (I_MGU + I_MDN);
    const int n1 = nit - nit / 8, it_lo = part == 1 ? n1 : 0, it_hi = part == 0 ? n1 : nit;
    if (e_lo == 0 && part != 1) {
        LAS float* mxs = (LAS float*)(F.lds + RING_OFF + 12288);
        for (int it = wk; it < NPROJ / 32; it += nwk) win_i8_item(F, A->in[2] + (size_t)D * D_IN, (unsigned char*)(ws + WS_WIN + SZ_WIN), WSP(float, WS_CS) + NPROJ, it, mxs);
        constexpr int I_SQ = (D / 64) * (D / 32);
        for (int it = gw; it < 3 * I_SQ; it += NGW) { const int which = it / I_SQ;
            const float* src = (which == 0 ? A->in[9] : which == 1 ? A->in[10] : A->in[11]) + (size_t)D * D; bf16* dst = (bf16*)(ws + (which == 0 ? WS_WPG : which == 1 ? WS_WPS : WS_WO) + SZ_SQ);
            tr_plain(src, D, D, dst, it % I_SQ, scr, F.lane); }
    }
    for (int it = it_lo + gw; it < it_hi; it += NGW) {
        int r = it;
        if (r < (e_hi - e_lo) * I_MGU) { const int e = e_lo + r / I_MGU; tr_gu_f8(A->in[17] + (size_t)e * D * FFE, A->in[18] + (size_t)e * D * FFE, D, FFE, (unsigned char*)(ws + WS_MGU) + (size_t)e * FFE2 * D, r % I_MGU, scr, F.lane); continue; }
        r -= (e_hi - e_lo) * I_MGU;
        { const int e = e_lo + r / I_MDN; tr_plain_f8(A->in[19] + (size_t)e * FFE * D, FFE, D, (unsigned char*)(ws + WS_MDN) + (size_t)e * D * FFE, r % I_MDN, scr, F.lane); }
    }
}
template <int LYR> __device__ __forceinline__ void phase_inproj(const Frame& F0) {
    const Frame F = refresh(F0);
    CArgs* A = get_args(); unsigned char* ws = A->ws;
    pg8::Gemm g{WSP(const bf16, WS_H), WSP(const bf16, WS_WIN + LYR * SZ_WIN), T, NPROJ, D / 2}; pg8::StaticOrder S; S.init(T, NPROJ, F.G, (int)blockIdx.x);
    pg8::EpiStoreBf16I8 E{WSP(bf16, WS_R1), NPROJ, WSP(const float, WS_RS), WSP(const float, WS_CS) + LYR * NPROJ};
    pg8::gemm_phase<pg8::EpiStoreBf16I8, pg8::StaticOrder, PG8_ALIGN, PG8_SP2, 2>(F.lds + RING_OFF, g, S, E);
}
template <int LYR> __device__ __forceinline__ void phase_prep(const Frame& F0) {
    const Frame F = refresh(F0);
    CArgs* A = get_args(); unsigned char* ws = A->ws;
    gdn_prep_phase(F, WSP(const bf16, WS_R1), A->in[3] + (size_t)LYR * 4 * 4096, A->in[4] + LYR * 16, A->in[5] + LYR * 16,
                   WSP(bf16, WS_QN), WSP(bf16, WS_WB), WSP(bf16, WS_UTB), WSP(bf16, WS_QKB), WSP(bf16, WS_KTB), WSP(float, WS_EG), WSP(float, WS_EK));
    PROF_MARK(30 + 10 * LYR);
    if (F.G < 256) { CArgs* A2 = get_args(); unsigned char* ws2 = A2->ws;
      swa_phase(F, F.vcu, F.G, (const bf16*)(ws2 + WS_R1), A2->in[7] + LYR * 32, A2->in[8], (bf16*)(ws2 + WS_OB)); }
}
template <int LYR> __device__ __forceinline__ void phase_scan(const Frame& F0) {
    const Frame F = refresh(F0);
    const bool split = F.G >= 128; const int bx = (int)blockIdx.x;
    if (!split || bx < NB * 16) { CArgs* A = get_args(); unsigned char* ws = A->ws;
      gdn_scan_phase(F, split ? bx : F.vcu, split ? NB * 16 : F.G, WSP(const bf16, WS_QN), WSP(const bf16, WS_WB), WSP(const bf16, WS_UTB), WSP(const bf16, WS_QKB), WSP(const bf16, WS_KTB), WSP(const float, WS_EG), WSP(const float, WS_EK),
                     WSP(const bf16, WS_R1), A->in[6] + LYR * 128, WSP(bf16, WS_OA)); }
    const int cwn = (F.G - NB * 16 < CONV_WGS) ? F.G - NB * 16 : CONV_WGS;
    if (!split || (bx >= NB * 16 && bx < NB * 16 + cwn)) { const int nwk = split ? cwn : F.G, wk = split ? bx - NB * 16 : bx;
      moe_convert(F, LYR * (NE / 2), (LYR + 1) * (NE / 2), wk, nwk, (F.G >= 256 && F.G > NB * 16 + CONV_WGS) ? 0 : -1); }
    constexpr int CW = CONV_WGS;
    if (F.G >= 256 && bx >= NB * 16 + CW) { CArgs* A2 = get_args(); unsigned char* ws2 = A2->ws;
      swa_phase(F, bx - (NB * 16 + CW), F.G - (NB * 16 + CW), (const bf16*)(ws2 + WS_R1), A2->in[7] + LYR * 32, A2->in[8], (bf16*)(ws2 + WS_OB));
      __syncthreads();
      moe_convert(F, LYR * (NE / 2), (LYR + 1) * (NE / 2), bx - (NB * 16 + CW), F.G - (NB * 16 + CW), 1); }
    PROF_MARK(31 + 10 * LYR);
}
template <int LYR> __device__ __forceinline__ void phase_proj(const Frame& F0) {
    const Frame F = refresh(F0);
    { CArgs* A = get_args(); unsigned char* ws = A->ws;
      pg8::Gemm g{WSP(const bf16, WS_OA), WSP(const bf16, WS_WPG + LYR * SZ_SQ), T, D, D}; pg8::StaticOrder S; S.init(T, D, F.G, (int)blockIdx.x);
      pg8::EpiGateA E{WSP(bf16, WS_Y), D, WSP(const bf16, WS_R1) + CGA, NPROJ};
      pg8::gemm_phase<pg8::EpiGateA, pg8::StaticOrder, PG8_ALIGN, PG8_SP2>(F.lds + RING_OFF, g, S, E); }
    { CArgs* A = get_args(); unsigned char* ws = A->ws;
      pg8::Gemm g{WSP(const bf16, WS_OB), WSP(const bf16, WS_WPS + LYR * SZ_SQ), T, D, D}; pg8::StaticOrder S; S.init(T, D, F.G, (int)blockIdx.x);
      pg8::EpiGateB E{WSP(bf16, WS_Y), D, WSP(const bf16, WS_R1) + CGB, NPROJ};
      pg8::gemm_phase<pg8::EpiGateB, pg8::StaticOrder, PG8_ALIGN, PG8_SP2>(F.lds + RING_OFF, g, S, E); }
}
template <int LYR> __device__ __forceinline__ void phase_out(const Frame& F0) {
    const Frame F = refresh(F0);
    CArgs* A = get_args(); unsigned char* ws = A->ws;
    pg8::Gemm g{WSP(const bf16, WS_Y), WSP(const bf16, WS_WO + LYR * SZ_SQ), T, D, D}; pg8::StaticOrder S; S.init(T, D, F.G, (int)blockIdx.x);
    pg8::EpiResF32 E{LYR == 0 ? A->in[0] : (const float*)A->out, A->pad == 3 ? WSP(float, WS_YP) : A->out, D};
    pg8::gemm_phase<pg8::EpiResF32, pg8::StaticOrder, PG8_ALIGN, PG8_SP2>(F.lds + RING_OFF, g, S, E);
}
template <int LYR> __device__ __forceinline__ void phase_norm2(const Frame& F0) {
    const Frame F = refresh(F0);
    CArgs* A = get_args(); unsigned char* ws = A->ws;
    const int gw = F.vcu * NWAVES + F.wave, NGW = F.G * NWAVES;
    const float* gain = A->in[12] + (size_t)LYR * D; const float* X = A->out; bf16* Hb = WSP(bf16, WS_H);
    if constexpr (LYR == 0) { for (int m = gw; m < T; m += NGW) rms_row<false, true>(F, X + (size_t)m * D, gain, (bf16*)((unsigned char*)Hb + (size_t)m * D), nullptr, m, nullptr, nullptr, WSP(float, WS_RSF), nullptr); }
    else {
        LAS float* rwT = (LAS float*)(F.lds + RING_OFF); const float* rw = A->in[16];
        for (int i = F.tid; i < D * NE; i += NWAVES * 64) { const int cc = i >> 3, e = i & 7; rwT[e * D + cc] = rw[i]; }
        __syncthreads();
        unsigned* CNT = F.ctl + CW_CNT; int* IDX = WSP(int, WS_IDX); float* TOPW = WSP(float, WS_TOPW); int* SLOT = WSP(int, WS_SLOT);
        LAS unsigned* lcnt = (LAS unsigned*)(F.lds + RING_OFF + 65536);
        LAS int* lrec = (LAS int*)lcnt + 16;
        if (F.tid < 16) lcnt[F.tid] = 0u;
        __syncthreads();
        int nrow = 0;
        for (int m = gw; m < T; m += NGW, ++nrow) rms_row<true>(F, X + (size_t)m * D, gain, Hb + (size_t)m * D, rwT, m, CNT, IDX, TOPW, SLOT, (LAS void*)lcnt, nrow * NWAVES + F.wave);
        __syncthreads();
        const bool dry = (A->pad == 3);
        if (F.tid < 8) lcnt[8 + F.tid] = dry ? 0u : atomicAdd(CNT + F.tid, lcnt[F.tid]);
        __syncthreads();
        unsigned char* XG = ws + WS_XG; const LAS float* lrs = (const LAS float*)lcnt + 2048;
        nrow = 0;
        if (!dry) for (int m = gw; m < T; m += NGW, ++nrow) { const int rec = nrow * NWAVES + F.wave;
            const float r = lrs[rec]; const int rc0 = lrec[2 * rec], rc1 = lrec[2 * rec + 1], e0 = rc0 >> 16, e1 = rc1 >> 16;
            const int p0 = (int)lcnt[8 + e0] + (rc0 & 0xffff), p1 = (int)lcnt[8 + e1] + (rc1 & 0xffff);
            if (F.lane == 0) { SLOT[2 * m] = (e0 << 16) | p0; SLOT[2 * m + 1] = (e1 << 16) | p1; }
            const f32x4* xr = (const f32x4*)(X + (size_t)m * D) + F.lane; const f32x4* gr = (const f32x4*)gain + F.lane;
            unsigned* d0 = (unsigned*)(XG + ((size_t)e0 * T + p0) * D) + F.lane; unsigned* d1 = (unsigned*)(XG + ((size_t)e1 * T + p1) * D) + F.lane;
#pragma unroll
            for (int j = 0; j < 8; ++j) { const f32x4 v = xr[64 * j] * (r * X8_SCALE) * gr[64 * j]; const unsigned o = pg8::pk4_fp8(v.x, v.y, v.z, v.w); d0[64 * j] = o; d1[64 * j] = o; } }
        __syncthreads();
    }
}
template <int LYR> __device__ __forceinline__ void phase_up(const Frame& F0) {
    const Frame F = refresh(F0);
    CArgs* A = get_args(); unsigned char* ws = A->ws;
    if constexpr (LYR == 0) {
        pg8::Gemm g{WSP(const bf16, WS_H), WSP(const bf16, WS_WGU), T, FFD2, D / 2}; pg8::StaticOrder S; S.init(T, FFD2, F.G, (int)blockIdx.x);
        pg8::EpiSwiGLUI8<false> E{WSP(void, WS_R1), FFD, WSP(const float, WS_RSF), WSP(const float, WS_CSF), 1.f};
        pg8::gemm_phase<pg8::EpiSwiGLUI8<false>, pg8::StaticOrder, PG8_ALIGN, PG8_SP2, 2>(F.lds + RING_OFF, g, S, E);
    } else {
        pg8::Gemm g{WSP(const bf16, WS_XG), WSP(const bf16, WS_MGU), MOE_ROWS, FFE2, D / 2}; pg8::MoeOrder<T / 256> S; S.init(F.ctl + CW_CNT, FFE2 / 256, F.G, F.vcu, (LAS int*)(F.lds + LDSCTL_OFF + 1024));
        pg8::EpiSwiGLUF8 E{WSP(unsigned char, WS_R1), FFE, H8_SCALE, (const LAS int*)(F.lds + LDSCTL_OFF + 1024)};
        pg8::gemm_phase<pg8::EpiSwiGLUF8, pg8::MoeOrder<T / 256>, PG8_ALIGN, PG8_SP2, 1>(F.lds + RING_OFF, g, S, E, W8_E8M0, X8_E8M0);
    }
}
__device__ __forceinline__ void down_reduce(const Frame& F0) {
    const Frame F = refresh(F0);
    CArgs* A = get_args(); unsigned char* ws = A->ws;
    const LAS int* tab = (const LAS int*)(F.lds + LDSCTL_OFF + 1024); LAS unsigned* flag = (LAS unsigned*)(F.lds + LDSCTL_OFF + 1024 + 128);
    const int nbt = tab[9], q = F.vcu;
    if (q < 4 * nbt * (D / 256)) {
        __syncthreads();
        if (F.tid == 0) { __builtin_amdgcn_fence(__ATOMIC_RELEASE, "agent");
            *flag = __hip_atomic_fetch_add(F.ctl + CW_KS + (q >> 2), 1u, __ATOMIC_RELAXED, __HIP_MEMORY_SCOPE_AGENT);
            __builtin_amdgcn_fence(__ATOMIC_ACQUIRE, "agent"); }
        __syncthreads();
        if (*flag == 3u) {
            const int u4 = q >> 2, tb = u4 / (D / 256), pn = u4 % (D / 256), pm = tab[24] + tb;
            const f32x4* P0 = (const f32x4*)(WSP(const float, WS_PT) + (size_t)(u4 * 4) * 65536); bf16* Y = WSP(bf16, WS_YG) + (size_t)pm * 256 * D + pn * 256;
#pragma unroll 8
            for (int k = 0; k < 32; ++k) { const int idx = k * (NWAVES * 64) + F.tid, row = idx >> 6, c4 = idx & 63;
                const f32x4* p = P0 + idx; const f32x4 sm = (p[0] + p[16384]) + (p[32768] + p[49152]);
                v2u w; w.x = pk2(sm.x, sm.y); w.y = pk2(sm.z, sm.w); *(v2u*)(Y + (size_t)row * D + c4 * 4) = w; }
        }
    }
}
template <int LYR> __device__ __forceinline__ void phase_down(const Frame& F0) {
    const Frame F = refresh(F0);
    CArgs* A = get_args(); unsigned char* ws = A->ws;
    if constexpr (LYR == 0) {
        pg8::Gemm g{WSP(const bf16, WS_R1), WSP(const bf16, WS_WDN), T, D, FFD}; pg8::StaticOrder S; S.init(T, D, F.G, (int)blockIdx.x);
        pg8::EpiResF32 E{A->out, A->pad == 3 ? WSP(float, WS_YP) : A->out, D};
        pg8::gemm_phase<pg8::EpiResF32, pg8::StaticOrder, PG8_ALIGN, PG8_SP2>(F.lds + RING_OFF, g, S, E);
    } else {
        pg8::Gemm g{WSP(const bf16, WS_R1), WSP(const bf16, WS_MDN), MOE_ROWS, D, FFE / 2}; pg8::MoeOrder<0, true> S; S.ntf = FFE / 128; S.kq = FFE / 4; S.init(F.ctl + CW_CNT, D / 256, F.G, F.vcu, (LAS int*)(F.lds + LDSCTL_OFF + 1024));
        pg8::EpiDownSplit E{WSP(bf16, WS_YG), D, WSP(float, WS_PT)};
        pg8::gemm_phase<pg8::EpiDownSplit, pg8::MoeOrder<0, true>, PG8_ALIGN, PG8_SP2, 1>(F.lds + RING_OFF, g, S, E, W8_E8M0, H8_E8M0);
    }
}
template <int LYR> __device__ __forceinline__ void phase_tail(const Frame& F0) {
    const Frame F = refresh(F0);
    CArgs* A = get_args(); unsigned char* ws = A->ws;
    if constexpr (LYR == 0) {
        const int gw = F.vcu * NWAVES + F.wave, NGW = F.G * NWAVES; const float* X = A->out; const float* gain = A->in[1] + D; bf16* Hb = WSP(bf16, WS_H);
        for (int m = gw; m < T; m += NGW) rms_row<false, true>(F, X + (size_t)m * D, gain, (bf16*)((unsigned char*)Hb + (size_t)m * D), nullptr, m, nullptr, nullptr, WSP(float, WS_RS), nullptr);
    } else final_phase(F, A->out, A->pad == 3 ? WSP(float, WS_YP) : A->out, WSP(const bf16, WS_YG), WSP(const float, WS_TOPW), WSP(const int, WS_SLOT), A->in[20]);
}

#define IN(k) (lo <= (k) && (k) < hi)
#define SEAM(k) do { if (IN(k) && IN((k) + 1)) xcd_barrier(bar); PROF_MARK(k); } while (0)
template <int LYR> __device__ __forceinline__ void layer_body(const Frame& F, const XcdBarrier& bar, const int lo, const int hi) {
    constexpr int pb = 1 + 11 * LYR;
    if (IN(pb + 0)) DUP(1, phase_inproj<LYR>(F));
    SEAM(pb + 0);
    if (IN(pb + 1)) DUP(2, phase_prep<LYR>(F));
    SEAM(pb + 1);
    if (IN(pb + 2)) DUP(3, phase_scan<LYR>(F));
    SEAM(pb + 2);
    if (IN(pb + 4)) DUP(5, phase_proj<LYR>(F));
    SEAM(pb + 4);
    if (IN(pb + 5)) phase_out<LYR>(F);
    SEAM(pb + 5);
    if (IN(pb + 6)) { phase_norm2<LYR>(F); if constexpr (LYR == 0) { if ((DUPMASK >> 6) & 1) phase_norm2<LYR>(F); } }
    SEAM(pb + 6);
    if (IN(pb + 8)) DUP(9 + LYR, phase_up<LYR>(F));
    SEAM(pb + 8);
    if (IN(pb + 9)) { phase_down<LYR>(F); if constexpr (LYR == 1) down_reduce(F); }
    SEAM(pb + 9);
    if (IN(pb + 10)) { phase_tail<LYR>(F); if constexpr (LYR == 0) { if ((DUPMASK >> 14) & 1) phase_tail<LYR>(F); } }
    if constexpr (LYR == 0) SEAM(pb + 10);
}

__global__ void __launch_bounds__(NWAVES * 64, 2) hybrid_fwd(Args args) {
    extern __shared__ __attribute__((aligned(16))) unsigned char lds[];
    Frame F;
    F.lds = (LAS unsigned char*)lds;
    F.MISC = (volatile LAS unsigned*)(F.lds + MISC_OFF);
    F.tid = threadIdx.x; F.lane = F.tid & 63; F.wave = __builtin_amdgcn_readfirstlane(F.tid >> 6);
    F.G = gridDim.x; { const int bx = blockIdx.x; F.vcu = (F.G % 8 == 0) ? (bx % 8) * (F.G / 8) + bx / 8 : bx; }
    F.ctl = (unsigned*)(args.ws + WS_CTL);
    for (int u = F.tid; u < (LDS_BYTES - LDSCTL_OFF) / 4; u += NWAVES * 64) ((LAS unsigned*)(F.lds + LDSCTL_OFF))[u] = 0u;
    __syncthreads();
    const int lo = args.ph_lo, hi = args.ph_hi;
    XcdBarrier bar; bar.bar = F.ctl + CW_BAR; bar.x = 0; bar.st = nullptr;
    if (hi - lo > 1) bar = xcd_barrier_post(F.ctl + CW_BAR, F.MISC + 8);
    PROF_MARK(-2);
    if (IN(0)) DUP(0, phase_prologue(F));
    SEAM(0);
    layer_body<0>(F, bar, lo, hi);
    layer_body<1>(F, bar, lo, hi);
    PROF_MARK(22);
    if (PROF_PHASE >= 0 && blockIdx.x == 0 && threadIdx.x == 0) { volatile LAS unsigned* pm_ = F.MISC + 16; const unsigned long long d_ = (((unsigned long long)pm_[3] << 32) | pm_[2]) * (unsigned long long)PROF_MULT;
        const unsigned long long t0_ = __builtin_amdgcn_s_memrealtime(); while (__builtin_amdgcn_s_memrealtime() - t0_ < d_) __builtin_amdgcn_s_sleep(64); }
}
#undef IN
#undef SEAM

extern "C" void kernel_launch(void* const* d_in, const int* in_sizes, int n_in, void* d_out, int out_size, void* d_ws, size_t ws_size, hipStream_t stream) {
    static int grid = 0;
    if (grid == 0) {
        if (n_in != 21 || out_size != T * D || ws_size < WS_END) { fprintf(stderr, "kernel_launch: unexpected shapes (n_in %d out %d ws %zu need %zu)\n", n_in, out_size, ws_size, (size_t)WS_END); grid = -1; return; }
        int dev = 0, cus = 0, per_cu = 0;
        if (hipGetDevice(&dev) != hipSuccess || hipDeviceGetAttribute(&cus, hipDeviceAttributeMultiprocessorCount, dev) != hipSuccess) { grid = -1; return; }
        if (hipFuncSetAttribute((const void*)hybrid_fwd, hipFuncAttributeMaxDynamicSharedMemorySize, LDS_BYTES) != hipSuccess) { fprintf(stderr, "kernel_launch: hipFuncSetAttribute failed\n"); grid = -1; return; }
        if (hipOccupancyMaxActiveBlocksPerMultiprocessor(&per_cu, (const void*)hybrid_fwd, NWAVES * 64, LDS_BYTES) != hipSuccess || per_cu < 1) { fprintf(stderr, "kernel_launch: occupancy query says %d\n", per_cu); }
        (void)hipGetLastError();
        grid = cus;
    }
    if (grid < 0) return;
    if (hipMemsetAsync((char*)d_ws + WS_CTL, 0, CTL_ZERO_BYTES, stream) != hipSuccess) return;
    Args a{};
    for (int i = 0; i < 21; ++i) a.in[i] = (const float*)d_in[i];
    a.out = (float*)d_out; a.ws = (unsigned char*)d_ws; a.pad = 0;
#if MK_ONE_LAUNCH
    a.ph_lo = 0; a.ph_hi = N_PHASES; a.li = 0;
    hipLaunchKernelGGL(hybrid_fwd, dim3(grid), dim3(NWAVES * 64), LDS_BYTES, stream, a);
#else
    for (int p = 0; p < N_PHASES; ++p) {
        if (p == 8 || p == 4 || p == 15 || p == 19) continue;
        a.ph_lo = p; a.ph_hi = p + 1; a.li = 0; a.pad = 0;
        if (p == PROBE_PHASE) { if (p == 10 || p == 17 || p == 18 || p == 22) { a.pad = 3; hipLaunchKernelGGL(hybrid_fwd, dim3(grid), dim3(NWAVES * 64), LDS_BYTES, stream, a); a.pad = 0; }
                                else hipLaunchKernelGGL(hybrid_fwd, dim3(grid), dim3(NWAVES * 64), LDS_BYTES, stream, a); }
        hipLaunchKernelGGL(hybrid_fwd, dim3(grid), dim3(NWAVES * 64), LDS_BYTES, stream, a);
    }
#endif
}
```
